# Optimizing an MI355X kernel written in HIP

```python
import math
import jax
import jax.numpy as jnp
from jax import lax
import numpy as np

D_MODEL = 1024
BATCH = 4
SEQ = 4096
DEPTH = 4

GRID_W = 64
CTX_LEN = 256
DA_HEADS = 4
DA_HEAD_DIM = 64
GQ_HEADS = 8
GQ_KV_HEADS = 2
GQ_HEAD_DIM = 64
DN_HEADS = 4
DN_HEAD_DIM = 128
DN_CHUNK = 64
DN_CONV_W = 3
N_BRANCH = 3
D_FF = 2816
FFN_CONV_W = 3
Q_BLOCK = 128
ROPE_DIM = 64
ROPE_THETA = 10000.0
NORM_EPS = 1e-6

DA_QK_COLS = DA_HEADS * 2 * DA_HEAD_DIM
DA_V_COLS = DA_HEADS * 2 * DA_HEAD_DIM
GQ_Q_COLS = GQ_HEADS * GQ_HEAD_DIM
GQ_KV_COLS = GQ_KV_HEADS * GQ_HEAD_DIM
DN_WIDTH = DN_HEADS * DN_HEAD_DIM
DN_DIR_COLS = 2 * DN_HEADS
GATE_COLS = N_BRANCH * D_MODEL
IN_SPLITS = (DA_QK_COLS, DA_QK_COLS, DA_V_COLS, GQ_Q_COLS, GQ_KV_COLS, GQ_KV_COLS, 3 * DN_WIDTH, DN_DIR_COLS, DN_DIR_COLS, DN_WIDTH, GATE_COLS)
N_IN = sum(IN_SPLITS)

kernel_name = 'hybrid_diffattn_gqa_deltanet_prefix_trunk'


def rms_norm(x, g):
    xf = x.astype(jnp.float32)
    y = xf * lax.rsqrt(jnp.mean(xf * xf, axis=-1, keepdims=True) + NORM_EPS)
    return (y * g.astype(jnp.float32)).astype(x.dtype)


def l2_normalize(x):
    xf = x.astype(jnp.float32)
    return xf * lax.rsqrt(jnp.sum(xf * xf, axis=-1, keepdims=True) + NORM_EPS)


def modulate(x, g, shift, scale):
    return rms_norm(x, g) * (1.0 + scale) + shift


def split_in_proj(y):
    offsets = np.cumsum(np.array(IN_SPLITS))[:-1].tolist()
    return jnp.split(y, offsets, axis=-1)


def axial_rope_tables(rows):
    row = jnp.repeat(jnp.arange(rows, dtype=jnp.int32), GRID_W).astype(jnp.float32)
    col = jnp.tile(jnp.arange(GRID_W, dtype=jnp.int32), rows).astype(jnp.float32)
    d_axis = ROPE_DIM // 2
    inv_freq = ROPE_THETA ** (-jnp.arange(0, d_axis, 2, dtype=jnp.float32) / d_axis)
    ang_r = row[:, None] * inv_freq[None, :]
    ang_c = col[:, None] * inv_freq[None, :]
    return (jnp.cos(ang_r), jnp.sin(ang_r), jnp.cos(ang_c), jnp.sin(ang_c))


def _rotate(x, cos, sin):
    x1, x2 = jnp.split(x, 2, axis=-1)
    return jnp.concatenate([x1 * cos - x2 * sin, x1 * sin + x2 * cos], axis=-1)


def apply_axial_rope(x, tables):
    shape = (x.shape[1],) + (1,) * (x.ndim - 3) + (-1,)
    cr, sr, cc, sc = (t.reshape(shape) for t in tables)
    xr, xcol = jnp.split(x.astype(jnp.float32), 2, axis=-1)
    return jnp.concatenate([_rotate(xr, cr, sr), _rotate(xcol, cc, sc)], axis=-1).astype(x.dtype)


def dwconv_centred(x, w):
    width = w.shape[0]
    pad = width // 2
    t = x.shape[1]
    xp = jnp.pad(x, ((0, 0), (pad, pad), (0, 0)))
    y = xp[:, 0:t] * w[0]
    for j in range(1, width):
        y = y + xp[:, j:j + t] * w[j]
    return y


def sweep_query_blocks(attend, queries):
    b, t = queries[0].shape[:2]
    nb = t // Q_BLOCK

    def to_blocks(a):
        return jnp.moveaxis(a.reshape((b, nb, Q_BLOCK) + a.shape[2:]), 1, 0)

    out = lax.map(lambda blk: attend(*blk), tuple(to_blocks(a) for a in queries))
    out = jnp.moveaxis(out, 0, 1)
    return out.reshape((b, t) + out.shape[3:])


def diff_heads(q, k, v, qn_g, kn_g, rope):
    b, t = q.shape[:2]
    q = rms_norm(q.reshape(b, t, DA_HEADS, 2, DA_HEAD_DIM), qn_g)
    k = rms_norm(k.reshape(b, t, DA_HEADS, 2, DA_HEAD_DIM), kn_g)
    if rope is not None:
        q = apply_axial_rope(q, rope)
        k = apply_axial_rope(k, rope)
    v = v.reshape(b, t, DA_HEADS, 2 * DA_HEAD_DIM)
    return (q[..., 0, :], q[..., 1, :], k[..., 0, :], k[..., 1, :], v)


def diff_lambda(lp, lam_init):
    lp = lp.astype(jnp.float32)
    return jnp.exp(jnp.sum(lp[0] * lp[1])) - jnp.exp(jnp.sum(lp[2] * lp[3])) + lam_init


def diff_attend(q1, q2, k1, k2, v, lam):
    scale = DA_HEAD_DIM ** -0.5
    p1 = jax.nn.softmax(jnp.einsum('bqhd,bshd->bhqs', q1, k1).astype(jnp.float32) * scale, axis=-1)
    p2 = jax.nn.softmax(jnp.einsum('bqhd,bshd->bhqs', q2, k2).astype(jnp.float32) * scale, axis=-1)
    return jnp.einsum('bhqs,bshe->bqhe', (p1 - lam * p2).astype(v.dtype), v)


def diff_out(o, subln_g, lam_init):
    b, t = o.shape[:2]
    return (rms_norm(o, subln_g) * (1.0 - lam_init)).reshape(b, t, DA_V_COLS)


def gqa_heads(q, k, v, qn_g, kn_g, rope):
    b, t = q.shape[:2]
    q = rms_norm(q.reshape(b, t, GQ_HEADS, GQ_HEAD_DIM), qn_g)
    k = rms_norm(k.reshape(b, t, GQ_KV_HEADS, GQ_HEAD_DIM), kn_g)
    if rope is not None:
        q = apply_axial_rope(q, rope)
        k = apply_axial_rope(k, rope)
    v = v.reshape(b, t, GQ_KV_HEADS, GQ_HEAD_DIM)
    return (q, k, v)


def gqa_attend(q, k, v):
    b, nq = q.shape[:2]
    group = GQ_HEADS // GQ_KV_HEADS
    qg = q.reshape(b, nq, GQ_KV_HEADS, group, GQ_HEAD_DIM)
    s = jnp.einsum('bqhgd,bshd->bhgqs', qg, k).astype(jnp.float32) * (GQ_HEAD_DIM ** -0.5)
    p = jax.nn.softmax(s, axis=-1).astype(v.dtype)
    o = jnp.einsum('bhgqs,bshd->bqhgd', p, v)
    return o.reshape(b, nq, GQ_HEADS, GQ_HEAD_DIM)


def deltanet_inputs(qkv, b_raw, a_raw, conv_w, a_log, dt_bias):
    b, t = qkv.shape[:2]
    qkv = jax.nn.silu(dwconv_centred(qkv, conv_w))
    q, k, v = jnp.split(qkv, 3, axis=-1)
    q = l2_normalize(q.reshape(b, t, DN_HEADS, DN_HEAD_DIM))
    k = l2_normalize(k.reshape(b, t, DN_HEADS, DN_HEAD_DIM))
    v = v.reshape(b, t, DN_HEADS, DN_HEAD_DIM)
    beta = jax.nn.sigmoid(b_raw.astype(jnp.float32)).reshape(b, t, 2, DN_HEADS)
    g = -jnp.exp(a_log.astype(jnp.float32)) * jax.nn.softplus(
        a_raw.astype(jnp.float32).reshape(b, t, 2, DN_HEADS) + dt_bias.astype(jnp.float32))
    return (q, k, v, g, beta)


def gated_delta_chunked(q, k, v, g, beta, s0, with_output):
    dtype = v.dtype
    b, t, h, dk = k.shape
    dv = v.shape[-1]
    n = t // DN_CHUNK

    def to_chunks(a):
        a = jnp.moveaxis(a.astype(jnp.float32), 2, 1)
        return a.reshape((b, h, n, DN_CHUNK) + a.shape[3:])

    kc, vc, gch, bc = to_chunks(k), to_chunks(v), to_chunks(g), to_chunks(beta)
    gcum = jnp.cumsum(gch, axis=-1)
    idx = jnp.arange(DN_CHUNK)
    incl = idx[:, None] >= idx[None, :]
    strict = idx[:, None] > idx[None, :]
    decay = jnp.where(incl, jnp.exp(jnp.where(incl, gcum[..., :, None] - gcum[..., None, :], 0.0)), 0.0)
    kb = kc * bc[..., None]
    a_low = jnp.where(strict, jnp.einsum('bhncd,bhnsd->bhncs', kb, kc) * decay, 0.0)
    eye = jnp.eye(DN_CHUNK, dtype=jnp.float32)
    tmat = lax.linalg.triangular_solve(a_low + eye, jnp.broadcast_to(eye, a_low.shape),
                                       left_side=True, lower=True, unit_diagonal=True)
    u = tmat @ (vc * bc[..., None])
    w = tmat @ (kb * jnp.exp(gcum)[..., None])
    g_last = gcum[..., -1]
    k_tail = kc * jnp.exp(g_last[..., None] - gcum)[..., None]
    xs = [u, w, k_tail, jnp.exp(g_last)]
    if with_output:
        qc = to_chunks(q) * (dk ** -0.5)
        xs += [jnp.einsum('bhncd,bhnsd->bhncs', qc, kc) * decay, qc * jnp.exp(gcum)[..., None]]
    xs = tuple(jnp.moveaxis(a_, 2, 0) for a_ in xs)

    def step(s, inp):
        u_i, w_i, kt_i, gl_i = inp[:4]
        v_new = u_i - jnp.einsum('bhcd,bhde->bhce', w_i, s)
        s_next = s * gl_i[..., None, None] + jnp.einsum('bhcd,bhce->bhde', kt_i, v_new)
        if with_output:
            qk_i, qd_i = inp[4], inp[5]
            o_i = jnp.einsum('bhcd,bhde->bhce', qd_i, s) + jnp.einsum('bhcs,bhse->bhce', qk_i, v_new)
            return s_next, o_i
        return s_next, None

    s_fin, o = lax.scan(step, s0.astype(jnp.float32), xs)
    if not with_output:
        return None, s_fin
    o = jnp.transpose(o, (1, 0, 3, 2, 4)).reshape(b, t, h, dv)
    return o.astype(dtype), s_fin


def bidir_delta(q, k, v, g, beta, s0_fwd, s0_bwd, with_output):
    flip = lambda a: jnp.flip(a, axis=1)
    o_f, s_f = gated_delta_chunked(q, k, v, g[:, :, 0], beta[:, :, 0], s0_fwd, with_output)
    o_b, s_b = gated_delta_chunked(flip(q), flip(k), flip(v), flip(g[:, :, 1]), flip(beta[:, :, 1]), s0_bwd, with_output)
    o = o_f + flip(o_b) if with_output else None
    return o, s_f, s_b


def deltanet_out(o, z, g):
    b, t = z.shape[:2]
    z = z.reshape(b, t, DN_HEADS, DN_HEAD_DIM)
    return (rms_norm(o, g) * jax.nn.silu(z)).reshape(b, t, DN_WIDTH)


def merge_branches(gate_cols, o_a, o_b, o_c, w_a, w_b, w_c, w_out):
    g_a, g_b, g_c = jnp.split(jax.nn.sigmoid(gate_cols), 3, axis=-1)
    return (g_a * (o_a @ w_a) + g_b * (o_b @ w_b) + g_c * (o_c @ w_c)) @ w_out


def conv_glu(h, w1, conv_w, conv_b, w2):
    a, u = jnp.split(h @ w1, 2, axis=-1)
    a = dwconv_centred(a, conv_w) + conv_b
    return (jax.nn.silu(a) * u) @ w2


def setup_inputs(seed: int = 0) -> dict:
    key = jax.random.key(seed)
    ks = jax.random.split(key, 32)
    nrm = lambda k, shape, s: jax.random.normal(k, shape, jnp.float32) * s
    gain = lambda k, shape: 1.0 + 0.02 * jax.random.normal(k, shape, jnp.float32)
    dt = jnp.exp(jax.random.uniform(ks[15], (DEPTH, 2, DN_HEADS), jnp.float32, math.log(1e-3), math.log(1e-1)))
    return {
        'x': nrm(ks[0], (BATCH, SEQ, D_MODEL), 1.0),
        'c': nrm(ks[1], (BATCH, D_MODEL), 1.0),
        'ctx': nrm(ks[2], (BATCH, CTX_LEN, D_MODEL), 1.0),
        'c_ctx': nrm(ks[3], (D_MODEL,), 1.0),
        'w_mod': nrm(ks[4], (DEPTH, D_MODEL, 6 * D_MODEL), 0.5 * D_MODEL ** -0.5),
        'b_mod': nrm(ks[5], (DEPTH, 6 * D_MODEL), 0.01),
        'norm1_g': gain(ks[6], (DEPTH, D_MODEL)),
        'w_in': nrm(ks[7], (DEPTH, D_MODEL, N_IN), D_MODEL ** -0.5),
        'da_qn_g': gain(ks[8], (DEPTH, DA_HEAD_DIM)),
        'da_kn_g': gain(ks[9], (DEPTH, DA_HEAD_DIM)),
        'da_lambda': nrm(ks[10], (DEPTH, 4, DA_HEAD_DIM), 0.1),
        'da_subln_g': gain(ks[11], (DEPTH, 2 * DA_HEAD_DIM)),
        'gq_qn_g': gain(ks[12], (DEPTH, GQ_HEAD_DIM)),
        'gq_kn_g': gain(ks[13], (DEPTH, GQ_HEAD_DIM)),
        'dn_conv_w': nrm(ks[14], (DEPTH, DN_CONV_W, 3 * DN_WIDTH), DN_CONV_W ** -0.5),
        'dn_a_log': jnp.log(jax.random.uniform(ks[16], (DEPTH, 2, DN_HEADS), jnp.float32, 1.0, 16.0)),
        'dn_dt_bias': dt + jnp.log(-jnp.expm1(-dt)),
        'dn_norm_g': gain(ks[17], (DEPTH, DN_HEAD_DIM)),
        'w_br_a': nrm(ks[18], (DEPTH, DA_V_COLS, D_MODEL), DA_V_COLS ** -0.5),
        'w_br_b': nrm(ks[19], (DEPTH, GQ_Q_COLS, D_MODEL), GQ_Q_COLS ** -0.5),
        'w_br_c': nrm(ks[20], (DEPTH, DN_WIDTH, D_MODEL), DN_WIDTH ** -0.5),
        'w_o': nrm(ks[21], (DEPTH, D_MODEL, D_MODEL), D_MODEL ** -0.5),
        'norm2_g': gain(ks[22], (DEPTH, D_MODEL)),
        'ffn_w1': nrm(ks[23], (DEPTH, D_MODEL, 2 * D_FF), D_MODEL ** -0.5),
        'ffn_conv_w': nrm(ks[24], (DEPTH, FFN_CONV_W, D_FF), FFN_CONV_W ** -0.5),
        'ffn_conv_b': nrm(ks[25], (DEPTH, D_FF), 0.01),
        'ffn_w2': nrm(ks[26], (DEPTH, D_FF, D_MODEL), D_FF ** -0.5),
    }


def reference(x, c, ctx, c_ctx, w_mod, b_mod, norm1_g, w_in, da_qn_g, da_kn_g, da_lambda, da_subln_g,
              gq_qn_g, gq_kn_g, dn_conv_w, dn_a_log, dn_dt_bias, dn_norm_g, w_br_a, w_br_b, w_br_c, w_o,
              norm2_g, ffn_w1, ffn_conv_w, ffn_conv_b, ffn_w2):
    b, n_lat = x.shape[0], x.shape[1]
    n_ctx = ctx.shape[1]
    rows = n_lat // GRID_W
    rope = axial_rope_tables(rows)
    cond_lat = jax.nn.silu(c)[:, None, :]
    cond_ctx = jax.nn.silu(c_ctx)[None, None, :]
    s_zero = jnp.zeros((b, DN_HEADS, DN_HEAD_DIM, DN_HEAD_DIM), jnp.float32)
    xl, xc = x, ctx
    for l in range(DEPTH):
        last = l == DEPTH - 1
        lam_init = 0.8 - 0.6 * math.exp(-0.3 * l)
        mod_l = jnp.split(cond_lat @ w_mod[l] + b_mod[l], 6, axis=-1)
        mod_c = jnp.split(cond_ctx @ w_mod[l] + b_mod[l], 6, axis=-1)

        hl = modulate(xl, norm1_g[l], mod_l[0], mod_l[1])
        hc = modulate(xc, norm1_g[l], mod_c[0], mod_c[1])
        pl = split_in_proj(hl @ w_in[l])
        pc = split_in_proj(hc @ w_in[l])

        lam = diff_lambda(da_lambda[l], lam_init)
        al = diff_heads(pl[0], pl[1], pl[2], da_qn_g[l], da_kn_g[l], rope)
        ac = diff_heads(pc[0], pc[1], pc[2], da_qn_g[l], da_kn_g[l], None)
        k1_all = jnp.concatenate([ac[2], al[2]], axis=1)
        k2_all = jnp.concatenate([ac[3], al[3]], axis=1)
        va_all = jnp.concatenate([ac[4], al[4]], axis=1)
        oa_l = sweep_query_blocks(lambda q1, q2: diff_attend(q1, q2, k1_all, k2_all, va_all, lam), (al[0], al[1]))
        oa_l = diff_out(oa_l, da_subln_g[l], lam_init)

        bl = gqa_heads(pl[3], pl[4], pl[5], gq_qn_g[l], gq_kn_g[l], rope)
        bc = gqa_heads(pc[3], pc[4], pc[5], gq_qn_g[l], gq_kn_g[l], None)
        kb_all = jnp.concatenate([bc[1], bl[1]], axis=1)
        vb_all = jnp.concatenate([bc[2], bl[2]], axis=1)
        ob_l = sweep_query_blocks(lambda q: gqa_attend(q, kb_all, vb_all), (bl[0],))
        ob_l = ob_l.reshape(b, n_lat, GQ_Q_COLS)

        dl = deltanet_inputs(pl[6], pl[7], pl[8], dn_conv_w[l], dn_a_log[l], dn_dt_bias[l])
        dc = deltanet_inputs(pc[6], pc[7], pc[8], dn_conv_w[l], dn_a_log[l], dn_dt_bias[l])
        oc_ctx, s_fwd, s_bwd = bidir_delta(dc[0], dc[1], dc[2], dc[3], dc[4], s_zero, s_zero, not last)
        oc_l, _, _ = bidir_delta(dl[0], dl[1], dl[2], dl[3], dl[4], s_fwd, s_bwd, True)
        oc_l = deltanet_out(oc_l, pl[9], dn_norm_g[l])

        xl = xl + mod_l[2] * merge_branches(pl[10], oa_l, ob_l, oc_l, w_br_a[l], w_br_b[l], w_br_c[l], w_o[l])
        if not last:
            oa_c = diff_out(diff_attend(ac[0], ac[1], ac[2], ac[3], ac[4], lam), da_subln_g[l], lam_init)
            ob_c = gqa_attend(bc[0], bc[1], bc[2]).reshape(b, n_ctx, GQ_Q_COLS)
            oc_c = deltanet_out(oc_ctx, pc[9], dn_norm_g[l])
            xc = xc + mod_c[2] * merge_branches(pc[10], oa_c, ob_c, oc_c, w_br_a[l], w_br_b[l], w_br_c[l], w_o[l])

        hl = modulate(xl, norm2_g[l], mod_l[3], mod_l[4])
        xl = xl + mod_l[5] * conv_glu(hl, ffn_w1[l], ffn_conv_w[l], ffn_conv_b[l], ffn_w2[l])
        if not last:
            hc = modulate(xc, norm2_g[l], mod_c[3], mod_c[4])
            xc = xc + mod_c[5] * conv_glu(hc, ffn_w1[l], ffn_conv_w[l], ffn_conv_b[l], ffn_w2[l])
    return xl
```

```cpp
#include <hip/hip_runtime.h>
#include <hip/hip_cooperative_groups.h>
#include <hip/hip_bf16.h>
#include <cstdio>
#include <cstdint>
#include <cmath>
namespace cg = cooperative_groups;
namespace pg8 {
#define PG8_LAS __attribute__((address_space(3)))
typedef unsigned short bf16_t;
typedef short bf16x8 __attribute__((ext_vector_type(8)));
typedef float f32x4 __attribute__((ext_vector_type(4)));
typedef unsigned u32x4 __attribute__((ext_vector_type(4)));
constexpr int BM = 256, BK = 64, HALF = 128, HTB = HALF * BK * 2  , STAGE_BYTES = 8 * HTB, NXCD = 8, WGM = 8;

__host__ __device__ __forceinline__ int lds_byte(int r, int c) { const int st = (r >> 4) * 2 + (c >> 5), rr = r & 15, cc = c & 31, ob = rr * 64 + cc * 2; return st * 1024 + (ob ^ (((ob >> 9) & 1) << 5)); }
__host__ __device__ __forceinline__ void stage_rc(int b, int& R, int& C) { const int st = b / 1024, sb = b % 1024, swz = sb ^ (((sb >> 9) & 1) << 5); R = (st >> 1) * 16 + swz / 64; C = (st & 1) * 32 + (swz % 64) / 2; }
__host__ __device__ __forceinline__ int perm32(int rho) { const int n = rho >> 4, i = rho & 15; return 8 * (i >> 2) + 4 * n + (i & 3); }

struct Unit { int pm, pn; };
struct Gemm { const bf16_t* A; const bf16_t* Bt; int M, N, K, lda; };

struct StaticOrder {
    int nM, nN, nwg, G, c;
    __host__ __device__ void init(int M, int N, int G_, int c_) { nM = M / BM; nN = N / BM; nwg = nM * nN; G = G_; c = c_; }
    __host__ __device__ bool next(int i, Unit& u) const {
        const long L = (long)i * G + c; if (L >= nwg) return false;
        int wgid = (int)L; { const int q = nwg / NXCD, r = nwg % NXCD, xcd = wgid % NXCD, off = wgid / NXCD; wgid = (xcd < r ? xcd * (q + 1) : r * (q + 1) + (xcd - r) * q) + off; }
        const int nig = WGM * nN, gid = wgid / nig, fm = gid * WGM, gsz = (nM - fm) < WGM ? (nM - fm) : WGM;
        u.pm = fm + ((wgid % nig) % gsz); u.pn = (wgid % nig) / gsz; return true;
    }
    __device__ __forceinline__ void a_ready(const Unit&) const {}
    __device__ __forceinline__ void done(const Unit&) const {}
};
__device__ __forceinline__ unsigned pkbf(float lo, float hi) { typedef float f2_t __attribute__((ext_vector_type(2))); typedef __bf16 b2_t __attribute__((ext_vector_type(2))); f2_t v = {lo, hi}; b2_t b = __builtin_convertvector(v, b2_t); return __builtin_bit_cast(unsigned, b); }
__device__ __forceinline__ float bflo(unsigned w) { return __uint_as_float(w << 16); }
__device__ __forceinline__ float bfhi(unsigned w) { return __uint_as_float(w & 0xffff0000u); }
__device__ __forceinline__ float sigm(float x) { return 1.0f / (1.0f + __expf(-x)); }
template <int MODE, int SUB> struct Epi {
    static constexpr bool PERM = true, AFTER_DRAIN = false;
    bf16_t* O; int ldc; bf16_t* O1; const bf16_t* G; int ldg; int gcol; float* F; const float* mod; float* OUT;
    __device__ __forceinline__ void operator()(const f32x4 (&acc)[2][2][4][2], const Unit& u, int wr, int wc, int fr, int fq) const {
        const int rl0 = wr * 64 + fr;
        const int rt = u.pm * BM + rl0;
        const int ct = u.pn * BM + wc * 32 + 8 * fq;
        if constexpr (MODE == 0 || MODE == 1 || MODE == 2) {
            bf16_t* base = O; int ld = ldc; int c0 = ct;
            if constexpr (MODE == 1) { if (u.pn >= 11) { base = O1; ld = 1792; c0 = ct - 2816; } else { ld = 2816; } }
#pragma unroll
            for (int ai = 0; ai < 2; ++ai)
#pragma unroll
                for (int m = 0; m < 4; ++m) { bf16_t* rowp = base + (size_t)(rt + ai * HALF + m * 16) * ld + c0;
#pragma unroll
                    for (int bj = 0; bj < 2; ++bj) { f32x4 v0 = acc[ai][bj][m][0], v1 = acc[ai][bj][m][1];
                        if constexpr (MODE == 2) { v0 = (f32x4){sigm(v0[0]), sigm(v0[1]), sigm(v0[2]), sigm(v0[3])}; v1 = (f32x4){sigm(v1[0]), sigm(v1[1]), sigm(v1[2]), sigm(v1[3])}; }
                        u32x4 w; w.x = pkbf(v0[0], v0[1]); w.y = pkbf(v0[2], v0[3]); w.z = pkbf(v1[0], v1[1]); w.w = pkbf(v1[2], v1[3]);
                        *(u32x4*)(rowp + bj * HALF) = w; } }
        } else if constexpr (MODE == 3) {
#pragma unroll
            for (int ai = 0; ai < 2; ++ai)
#pragma unroll
                for (int m = 0; m < 4; ++m) { const size_t row = (size_t)(rt + ai * HALF + m * 16);
#pragma unroll
                    for (int bj = 0; bj < 2; ++bj) { const int col = ct + bj * HALF;
                        const u32x4 gw = *(const u32x4*)(G + row * ldg + gcol + col);
                        f32x4 v0 = acc[ai][bj][m][0], v1 = acc[ai][bj][m][1];
                        v0 = v0 * (f32x4){bflo(gw.x), bfhi(gw.x), bflo(gw.y), bfhi(gw.y)}; v1 = v1 * (f32x4){bflo(gw.z), bfhi(gw.z), bflo(gw.w), bfhi(gw.w)};
                        float* fp = F + row * 1024 + col;
                        if constexpr (SUB == 0) { *(f32x4*)fp = v0; *(f32x4*)(fp + 4) = v1; }
                        else { v0 = v0 + *(const f32x4*)fp; v1 = v1 + *(const f32x4*)(fp + 4);
                            if constexpr (SUB == 1) { *(f32x4*)fp = v0; *(f32x4*)(fp + 4) = v1; }
                            else { u32x4 w; w.x = pkbf(v0[0], v0[1]); w.y = pkbf(v0[2], v0[3]); w.z = pkbf(v1[0], v1[1]); w.w = pkbf(v1[2], v1[3]); *(u32x4*)(O + row * ldc + col) = w; } } } }
        } else {
            const int b = u.pm / 17, ti = u.pm % 17, msel = (ti == 0) ? 4 : b;
            const float* mp = mod + msel * 6144 + ct;
            f32x4 mv[2][2];
#pragma unroll
            for (int bj = 0; bj < 2; ++bj)
#pragma unroll
                for (int n = 0; n < 2; ++n) mv[bj][n] = *(const f32x4*)(mp + bj * HALF + 4 * n);
#pragma unroll
            for (int ai = 0; ai < 2; ++ai)
#pragma unroll
                for (int m = 0; m < 4; ++m) { const int rl = rl0 + ai * HALF + m * 16; const size_t row = (size_t)(u.pm * BM + rl);
#pragma unroll
                    for (int bj = 0; bj < 2; ++bj) { const int col = ct + bj * HALF; float* xp = F + row * 1024 + col;
                        const f32x4 r0 = *(const f32x4*)xp + mv[bj][0] * acc[ai][bj][m][0], r1 = *(const f32x4*)(xp + 4) + mv[bj][1] * acc[ai][bj][m][1];
                        if constexpr (SUB == 0) { *(f32x4*)xp = r0; *(f32x4*)(xp + 4) = r1; }
                        else { if (ti != 0) { float* op = OUT + ((size_t)b * 4096 + (size_t)(ti - 1) * 256 + rl) * 1024 + col; *(f32x4*)op = r0; *(f32x4*)(op + 4) = r1; } } } }
        }
    }
};
template <class Epi, class Sched, bool ALIGN_EPI = false, bool SP2 = false>
__device__ __forceinline__ void gemm_phase(PG8_LAS unsigned char* lds, const Gemm g, const Sched& S, const Epi& E) {
    int tid = threadIdx.x; asm volatile("" : "+v"(tid)); const int wid = __builtin_amdgcn_readfirstlane(tid >> 6), lane = tid & 63, wr = wid >> 2, wc = wid & 3, fr = lane & 15, fq = lane >> 4;
    const int K = g.K, nt = K / BK;
    unsigned voffA[2], voffB[2];
#pragma unroll
    for (int i = 0; i < 2; ++i) { int R, C; stage_rc(tid * 16 + i * 8192, R, C); const int Rb = Epi::PERM ? ((R & ~31) + perm32(R & 31)) : R;
        voffA[i] = (unsigned)(R * g.lda + C) * 2u; voffB[i] = (unsigned)(Rb * K + C) * 2u; }
    const size_t kstep = (size_t)(BK * 2);
    const size_t hstepA = (size_t)HALF * g.lda * 2, hstepB = (size_t)HALF * K * 2;
    const size_t tstepA = 2 * hstepA, tstepB = 2 * hstepB;
    const unsigned ldsw = (unsigned)wid * 1024u;
    const int aoff = lds_byte(wr * 64 + fr, fq * 8), boff = lds_byte(wc * 32 + fr, fq * 8);
#define PG8_SA(b, h) (((b) * 2 + (h)) * HTB)
#define PG8_SB(b, h) ((4 + (b) * 2 + (h)) * HTB)
#define PG8_STAGE(bufoff, gbase, voff) do { _Pragma("unroll") for (int _i = 0; _i < 2; ++_i) \
        __builtin_amdgcn_global_load_lds((const unsigned*)((const char*)(gbase) + (voff)[_i]), (PG8_LAS unsigned*)(lds + (bufoff) + ldsw + _i * 8192), 16, 0, 0); } while (0)
#define PG8_LDA(dst, b, h) do { _Pragma("unroll") for (int m = 0; m < 4; ++m) _Pragma("unroll") for (int k = 0; k < 2; ++k) dst[m][k] = *(const PG8_LAS bf16x8*)(lds + PG8_SA(b, h) + aoff + m * 2048 + k * 1024); } while (0)
#define PG8_LDB(dst, b, h) do { _Pragma("unroll") for (int n = 0; n < 2; ++n) _Pragma("unroll") for (int k = 0; k < 2; ++k) dst[n][k] = *(const PG8_LAS bf16x8*)(lds + PG8_SB(b, h) + boff + n * 2048 + k * 1024); } while (0)
#define PG8_MMA(ai, bj, At, Bt) do { __builtin_amdgcn_s_setprio(1); _Pragma("unroll") for (int m = 0; m < 4; ++m) _Pragma("unroll") for (int n = 0; n < 2; ++n) _Pragma("unroll") for (int k = 0; k < 2; ++k) \
        acc[ai][bj][m][n] = __builtin_amdgcn_mfma_f32_16x16x32_bf16(Bt[n][k], At[m][k], acc[ai][bj][m][n], 0, 0, 0); __builtin_amdgcn_s_setprio(0); } while (0)
#define PG8_WAIT_V(n) asm volatile("s_waitcnt vmcnt(" #n ")" ::: "memory")
#define PG8_WAIT_L(n) asm volatile("s_waitcnt lgkmcnt(" #n ")" ::: "memory")
#define PG8_BAR __builtin_amdgcn_s_barrier()
#define PG8_SCHED __builtin_amdgcn_sched_barrier(0)
    Unit cur, nxt; int ui = 0;
    if (!S.next(0, cur)) return;
    f32x4 acc[2][2][4][2];
#pragma unroll
    for (int a = 0; a < 2; ++a)
#pragma unroll
        for (int b = 0; b < 2; ++b)
#pragma unroll
            for (int m = 0; m < 4; ++m)
#pragma unroll
                for (int n = 0; n < 2; ++n) acc[a][b][m][n] = (f32x4){0.f, 0.f, 0.f, 0.f};
    bf16x8 At[4][2], B0[2][2], B1[2][2];
    const char* cA = (const char*)g.A + (size_t)cur.pm * tstepA; const char* cB = (const char*)g.Bt + (size_t)cur.pn * tstepB;
    S.a_ready(cur);
    if constexpr (SP2) {
        PG8_STAGE(PG8_SB(0, 0), cB, voffB); PG8_STAGE(PG8_SB(0, 1), cB + hstepB, voffB); PG8_STAGE(PG8_SA(0, 0), cA, voffA); PG8_STAGE(PG8_SA(0, 1), cA + hstepA, voffA);
        if (wr == 1) PG8_BAR;
        PG8_WAIT_V(2); PG8_BAR;
        PG8_STAGE(PG8_SB(1, 0), cB + kstep, voffB); PG8_STAGE(PG8_SA(1, 0), cA + kstep, voffA); PG8_STAGE(PG8_SB(1, 1), cB + hstepB + kstep, voffB);
        PG8_WAIT_V(6); PG8_BAR;
    } else {
        PG8_STAGE(PG8_SB(0, 0), cB, voffB); PG8_STAGE(PG8_SA(0, 0), cA, voffA); PG8_STAGE(PG8_SB(0, 1), cB + hstepB, voffB); PG8_STAGE(PG8_SA(0, 1), cA + hstepA, voffA);
        if (wr == 1) PG8_BAR;
        PG8_WAIT_V(4); PG8_BAR;
        PG8_STAGE(PG8_SB(1, 0), cB + kstep, voffB); PG8_STAGE(PG8_SA(1, 0), cA + kstep, voffA); PG8_STAGE(PG8_SB(1, 1), cB + hstepB + kstep, voffB);
        PG8_WAIT_V(6); PG8_BAR;
    }
    for (;;) {
        const bool has_next = S.next(ui + 1, nxt);
        const char* nA = has_next ? (const char*)g.A + (size_t)nxt.pm * tstepA : cA; const char* nB = has_next ? (const char*)g.Bt + (size_t)nxt.pn * tstepB : cB;
        for (int t = 0; t < nt; t += 2) {
            const bool last = (t == nt - 2);
            const char* a1 = cA + (size_t)(t + 1) * kstep;
            const char* a2 = last ? nA : cA + (size_t)(t + 2) * kstep; const char* b2 = last ? nB : cB + (size_t)(t + 2) * kstep;
            const char* a3 = a2 + kstep; const char* b3 = b2 + kstep;
            if (last && has_next) S.a_ready(nxt);
            if constexpr (SP2) {
            PG8_LDB(B0, 0, 0); PG8_LDB(B1, 0, 1); PG8_SCHED; PG8_LDA(At, 0, 0); PG8_STAGE(PG8_SA(1, 1), a1 + hstepA, voffA);
            PG8_WAIT_V(8); PG8_WAIT_L(0); PG8_BAR; PG8_MMA(0, 0, At, B0); PG8_MMA(0, 1, At, B1); PG8_BAR; PG8_SCHED;
            PG8_LDA(At, 0, 1); PG8_STAGE(PG8_SB(0, 0), b2, voffB); PG8_STAGE(PG8_SB(0, 1), b2 + hstepB, voffB); PG8_STAGE(PG8_SA(0, 0), a2, voffA);
            PG8_WAIT_V(8); PG8_WAIT_L(0); PG8_BAR; PG8_MMA(1, 0, At, B0); PG8_MMA(1, 1, At, B1); PG8_BAR; PG8_SCHED;
            PG8_LDB(B0, 1, 0); PG8_LDB(B1, 1, 1); PG8_SCHED; PG8_LDA(At, 1, 0); PG8_STAGE(PG8_SA(0, 1), a2 + hstepA, voffA);
            PG8_WAIT_V(8); PG8_WAIT_L(0); PG8_BAR; PG8_MMA(0, 0, At, B0); PG8_MMA(0, 1, At, B1); PG8_BAR; PG8_SCHED;
            PG8_LDA(At, 1, 1); PG8_STAGE(PG8_SB(1, 0), b3, voffB); PG8_STAGE(PG8_SB(1, 1), b3 + hstepB, voffB); PG8_STAGE(PG8_SA(1, 0), a3, voffA);
            PG8_WAIT_V(8); PG8_WAIT_L(0); PG8_BAR; PG8_MMA(1, 0, At, B0); PG8_MMA(1, 1, At, B1); PG8_BAR; PG8_SCHED;
            } else {
            PG8_LDB(B0, 0, 0); PG8_SCHED; PG8_LDA(At, 0, 0); PG8_STAGE(PG8_SA(1, 1), a1 + hstepA, voffA);
            PG8_WAIT_L(8); PG8_BAR; PG8_WAIT_L(0); PG8_MMA(0, 0, At, B0); PG8_BAR; PG8_SCHED;
            PG8_LDB(B1, 0, 1); PG8_STAGE(PG8_SB(0, 0), b2, voffB);
            PG8_BAR; PG8_WAIT_L(0); PG8_MMA(0, 1, At, B1); PG8_BAR;
            PG8_LDA(At, 0, 1); PG8_STAGE(PG8_SA(0, 0), a2, voffA);
            PG8_BAR; PG8_WAIT_L(0); PG8_MMA(1, 0, At, B0); PG8_BAR; PG8_SCHED;
            PG8_STAGE(PG8_SB(0, 1), b2 + hstepB, voffB);
            PG8_WAIT_V(6); PG8_BAR; PG8_MMA(1, 1, At, B1); PG8_BAR;
            PG8_LDB(B0, 1, 0); PG8_SCHED; PG8_LDA(At, 1, 0); PG8_STAGE(PG8_SA(0, 1), a2 + hstepA, voffA);
            PG8_WAIT_L(8); PG8_BAR; PG8_WAIT_L(0); PG8_MMA(0, 0, At, B0); PG8_BAR; PG8_SCHED;
            PG8_LDB(B1, 1, 1); PG8_STAGE(PG8_SB(1, 0), b3, voffB);
            PG8_BAR; PG8_WAIT_L(0); PG8_MMA(0, 1, At, B1); PG8_BAR;
            PG8_LDA(At, 1, 1); PG8_STAGE(PG8_SA(1, 0), a3, voffA);
            PG8_BAR; PG8_WAIT_L(0); PG8_MMA(1, 0, At, B0); PG8_BAR; PG8_SCHED;
            PG8_STAGE(PG8_SB(1, 1), b3 + hstepB, voffB);
            PG8_WAIT_V(6); PG8_BAR; PG8_MMA(1, 1, At, B1); PG8_BAR;
            }
        }
        if constexpr (ALIGN_EPI) { if (wr == 0) PG8_BAR; }
        if constexpr (!Epi::AFTER_DRAIN) { E(acc, cur, wr, wc, fr, fq); S.done(cur); }
        if (!has_next) break;
#pragma unroll
        for (int a = 0; a < 2; ++a)
#pragma unroll
            for (int b = 0; b < 2; ++b)
#pragma unroll
                for (int m = 0; m < 4; ++m)
#pragma unroll
                    for (int n = 0; n < 2; ++n) acc[a][b][m][n] = (f32x4){0.f, 0.f, 0.f, 0.f};
        cur = nxt; cA = nA; cB = nB; ++ui;
        if constexpr (ALIGN_EPI) { if (wr == 1) PG8_BAR; }
    }
    PG8_WAIT_V(0);
    if constexpr (!ALIGN_EPI) { if (wr == 0) PG8_BAR; }
    PG8_BAR;
    if constexpr (Epi::AFTER_DRAIN) { E.fused(acc, cur, wr, wc, fr, fq, lds, wid, lane); S.done(cur); }
#undef PG8_SA
#undef PG8_SB
#undef PG8_STAGE
#undef PG8_LDA
#undef PG8_LDB
#undef PG8_MMA
#undef PG8_WAIT_V
#undef PG8_WAIT_L
#undef PG8_BAR
#undef PG8_SCHED
}
}
#include <hip/hip_bf16.h>
#include <cmath>
namespace attn_body {
using bf16=__hip_bfloat16;
using bf16x8=__attribute__((ext_vector_type(8)))short;
using s16x4=__attribute__((ext_vector_type(4)))short;
using f32x16=__attribute__((ext_vector_type(16)))float;
using u32x4=__attribute__((ext_vector_type(4)))unsigned;
constexpr int D=64;
constexpr int NW=8,QBLK=32,QB=QBLK*NW,KVBLK=64;
constexpr int ATTN_UNIT_ROWS=QB;
__device__ __forceinline__ int crow(int r,int hi){return (r&3)+8*(r>>2)+4*hi;}
#define SBAR() __builtin_amdgcn_sched_barrier(0)
__device__ __forceinline__ void cmask(f32x16&p0,f32x16&p1,int jb,int qrel,int hi){
  const float NEG=-INFINITY; int kb=64*jb+4*hi;
  #pragma unroll
  for(int r=0;r<16;++r){int kv=kb+(r&3)+8*(r>>2); if(kv>qrel)p0[r]=NEG; if(kv+32>qrel)p1[r]=NEG;}
}

constexpr int NSLOT=3, SLOTB=8192;
constexpr int LDS_K=0, LDS_V=NSLOT*SLOTB, LDS_WS=2*NSLOT*SLOTB, LDS_OST=LDS_WS+NW*64*4, LDS_BYTES=LDS_OST+NW*4096;
constexpr float C2=0.125f*1.4426950408889634f;
__device__ __forceinline__ void glds16(const void*gsrc,unsigned lds_dst){unsigned keep;
  asm volatile("s_mov_b32 %0, m0\n\ts_mov_b32 m0, %2\n\ts_nop 0\n\tglobal_load_lds_dwordx4 %1, off\n\ts_mov_b32 m0, %0":"=&s"(keep):"v"(gsrc),"s"(lds_dst):"memory");}
__device__ __forceinline__ float max3f(float a,float b,float c){float r;asm("v_max3_f32 %0, %1, %2, %3":"=v"(r):"v"(a),"v"(b),"v"(c));return r;}
__device__ __forceinline__ float max2f(float a,float b){float r;asm("v_max_f32_e32 %0, %1, %2":"=v"(r):"v"(a),"v"(b));return r;}
__device__ __forceinline__ float fadd_s(float a,float b){float r;asm("v_add_f32_e32 %0, %1, %2":"=v"(r):"v"(a),"v"(b));return r;}
__device__ __forceinline__ float fsub_s(float a,float b){float r;asm("v_sub_f32_e32 %0, %1, %2":"=v"(r):"v"(a),"v"(b));return r;}
typedef float f32x2_t __attribute__((ext_vector_type(2))); typedef __bf16 bf16x2_t __attribute__((ext_vector_type(2)));
__device__ __forceinline__ unsigned cvtpk_s(float lo,float hi){f32x2_t v={lo,hi};bf16x2_t b=__builtin_convertvector(v,bf16x2_t);return __builtin_bit_cast(unsigned,b);}
#define WAIT_BAR(N) asm volatile("s_waitcnt vmcnt(" #N ") lgkmcnt(0)\n\ts_barrier":::"memory")

__device__ __forceinline__ void qkt(f32x16&p0,f32x16&p1,const char*Kslot,const bf16x8*qr,const f32x16&negm,int r32,int hi){
  const char*kb=Kslot+hi*1024+r32*16;
  #pragma unroll
  for(int d0=0;d0<4;++d0){
    const bf16x8 b0=*reinterpret_cast<const bf16x8*>(kb+d0*2048);
    const bf16x8 b1=*reinterpret_cast<const bf16x8*>(kb+d0*2048+512);
    if(d0==0){p0=__builtin_amdgcn_mfma_f32_32x32x16_bf16(b0,qr[0],negm,0,0,0);p1=__builtin_amdgcn_mfma_f32_32x32x16_bf16(b1,qr[0],negm,0,0,0);}
    else{p0=__builtin_amdgcn_mfma_f32_32x32x16_bf16(b0,qr[d0],p0,0,0,0);p1=__builtin_amdgcn_mfma_f32_32x32x16_bf16(b1,qr[d0],p1,0,0,0);}}
}
typedef __attribute__((address_space(3))) const char* lds_cptr;
typedef short v4i16_t __attribute__((ext_vector_type(4)));
__device__ __forceinline__ void kload8(bf16x8*kf,lds_cptr kp){
  kf[0]=*(const __attribute__((address_space(3))) bf16x8*)(kp);      kf[1]=*(const __attribute__((address_space(3))) bf16x8*)(kp+512);
  kf[2]=*(const __attribute__((address_space(3))) bf16x8*)(kp+2048); kf[3]=*(const __attribute__((address_space(3))) bf16x8*)(kp+2560);
  kf[4]=*(const __attribute__((address_space(3))) bf16x8*)(kp+4096); kf[5]=*(const __attribute__((address_space(3))) bf16x8*)(kp+4608);
  kf[6]=*(const __attribute__((address_space(3))) bf16x8*)(kp+6144); kf[7]=*(const __attribute__((address_space(3))) bf16x8*)(kp+6656);
}
__device__ __forceinline__ void kload2(bf16x8*kf,lds_cptr kp,int j){ kf[2*j]=*(const __attribute__((address_space(3))) bf16x8*)(kp+j*2048); kf[2*j+1]=*(const __attribute__((address_space(3))) bf16x8*)(kp+j*2048+512); }
__device__ __forceinline__ s16x4 vtr(lds_cptr p){ return __builtin_bit_cast(s16x4,__builtin_amdgcn_ds_read_tr16_b64_v4i16((__attribute__((address_space(3))) v4i16_t*)p)); }
__device__ __forceinline__ float rowmax(const f32x16&p0,const f32x16&p1){
  float a=max3f(p0[0],p0[1],p1[0]),b=max3f(p0[2],p0[3],p1[1]);a=max3f(a,p1[2],p1[3]);
  #pragma unroll
  for(int r=4;r<16;r+=4){a=max3f(a,p0[r],p0[r+1]);b=max3f(b,p0[r+2],p0[r+3]);a=max3f(a,p1[r],p1[r+1]);b=max3f(b,p1[r+2],p1[r+3]);}
  const float m=max2f(a,b);
  auto rr=__builtin_amdgcn_permlane32_swap(__float_as_uint(m),__float_as_uint(m),false,false);
  return max2f(__uint_as_float(rr[0]),__uint_as_float(rr[1]));
}
__device__ __forceinline__ void pv(f32x16*o,int vb,bf16x8 pa0,bf16x8 pa1,bf16x8 pa2,bf16x8 pa3){
  #pragma unroll
  for(int d0=0;d0<2;++d0){s16x4 lo[4],hi[4];
    #pragma unroll
    for(int ks=0;ks<4;++ks){
      asm volatile("ds_read_b64_tr_b16 %0,%1 offset:%c2":"=&v"(lo[ks]):"v"(vb),"i"(d0*4096+ks*1024):"memory");
      asm volatile("ds_read_b64_tr_b16 %0,%1 offset:%c2":"=&v"(hi[ks]):"v"(vb),"i"(d0*4096+ks*1024+512):"memory");}
    asm volatile("s_waitcnt lgkmcnt(0)":::"memory");SBAR();
    #define PK(k) (bf16x8){lo[k][0],lo[k][1],lo[k][2],lo[k][3],hi[k][0],hi[k][1],hi[k][2],hi[k][3]}
    o[d0]=__builtin_amdgcn_mfma_f32_32x32x16_bf16(pa0,PK(0),o[d0],0,0,0);
    o[d0]=__builtin_amdgcn_mfma_f32_32x32x16_bf16(pa1,PK(1),o[d0],0,0,0);
    o[d0]=__builtin_amdgcn_mfma_f32_32x32x16_bf16(pa2,PK(2),o[d0],0,0,0);
    o[d0]=__builtin_amdgcn_mfma_f32_32x32x16_bf16(pa3,PK(3),o[d0],0,0,0);
    #undef PK
  }
}

#ifndef ATTN_STORE16
#define ATTN_STORE16(p,v) (*(u32x4*)(p)=(v))
#endif
template<int THRL> __device__ __forceinline__ void attn_unit(const bf16*Qb,const bf16*__restrict__ Kh,const bf16*__restrict__ Vh,bf16*Ob,const int PQ,const int PK,const int PV,const int PO,const int NT,char*shm){
  int tid=threadIdx.x; asm volatile("":"+v"(tid)); const int lane=tid&63,r32=lane&31,hi=lane>>5; const int wid=__builtin_amdgcn_readfirstlane(tid>>6);
  const bf16*Qw=Qb+(long)(wid*QBLK)*PQ;
  const unsigned lds0=(unsigned)(uintptr_t)shm;
  float*wsf=(float*)(shm+LDS_WS)+wid*64;
  const bf16*ksrc=Kh+(long)lane*PK+wid*8;
  const bf16*vsrc=Vh+(long)(16*(wid&3)+(lane>>2))*PV+(wid>>2)*32+(lane&3)*8;
  const unsigned kdst=lds0+LDS_K+wid*1024, vdst=lds0+LDS_V+wid*1024;
  #define DMA_K(t,slot) glds16(ksrc+(long)(t)*KVBLK*PK,(unsigned)__builtin_amdgcn_readfirstlane(kdst+(slot)))
  #define DMA_V(t,slot) glds16(vsrc+(long)(t)*KVBLK*PV,(unsigned)__builtin_amdgcn_readfirstlane(vdst+(slot)))
  const int vb0=(int)(lds0+LDS_V)+((lane>>4)&1)*32+(lane&3)*8+(4*hi+((lane&15)>>2))*64;
  const char*Kbase=shm+LDS_K; bf16x8 kf[8];
  const lds_cptr shm3=(lds_cptr)shm; const lds_cptr kp0=shm3+LDS_K+hi*1024+r32*16; const lds_cptr vp0=shm3+LDS_V+((lane>>4)&1)*32+(lane&3)*8+(4*hi+((lane&15)>>2))*64;
  DMA_K(0,0);DMA_V(0,0);DMA_K(1,SLOTB);
  bf16x8 qr[4];
  #pragma unroll
  for(int d0=0;d0<4;++d0)qr[d0]=*reinterpret_cast<const bf16x8*>(&Qw[(long)r32*PQ+d0*16+hi*8]);
  float mhat=0.f,l_reg=0.f;f32x16 o[2];o[0]=f32x16{};o[1]=f32x16{};f32x16 negm=f32x16{};asm volatile("":"+v"(negm));
  #define CMASK(P0,P1,t) do{}while(0)
  bool resc=false;
  #define START(P0,P1) do{ const float rm=rowmax(P0,P1); resc=false; \
    { const float dl=rm; mhat=fadd_s(mhat,dl); \
      _Pragma("unroll") for(int r=0;r<16;++r){P0[r]=fsub_s(P0[r],dl);P1[r]=fsub_s(P1[r],dl);} \
      _Pragma("unroll") for(int r=0;r<16;++r)negm[r]=-mhat; asm volatile("":"+v"(negm)); } \
    _Pragma("unroll") for(int r=0;r<16;++r)P0[r]=__builtin_amdgcn_exp2f(P0[r]); }while(0)
  #define RESC() do{ if(resc){ asm volatile("s_waitcnt lgkmcnt(0)":::"memory"); \
      _Pragma("unroll") for(int d_=0;d_<2;++d_) _Pragma("unroll") for(int r=0;r<16;++r)o[d_][r]*=wsf[crow(r,hi)]; } }while(0)
  f32x16 pA0,pA1,pB0,pB1;
  int sl_prev=0,sl_cur=0,sl_next=SLOTB;
  #define ROT() do{sl_prev=sl_cur;sl_cur=sl_next;sl_next=(sl_next==(NSLOT-1)*SLOTB)?0:sl_next+SLOTB;}while(0)
  DMA_K(2,2*SLOTB);
  WAIT_BAR(3);
  qkt(pA0,pA1,Kbase,qr,negm,r32,hi);asm volatile("s_nop 15\n\ts_nop 7":"+v"(pA0),"+v"(pA1));CMASK(pA0,pA1,0);
  START(pA0,pA1);
  _Pragma("unroll") for(int r=0;r<16;++r)pA1[r]=__builtin_amdgcn_exp2f(pA1[r]);
  WAIT_BAR(0);
  DMA_K(3,0);DMA_V(1,SLOTB);
  ROT();
  kload8(kf,kp0+sl_cur);
  WAIT_BAR(2);
  s16x4 vlo[8],vhi[8]; u32x4 pw0,pw1,pw2,pw3;
  #define PKW(P,B) cvtpk_s(P[B],P[B+1])
  #define PAF(k) __builtin_bit_cast(bf16x8,pw##k)
  #define VFR(i) (bf16x8){vlo[i][0],vlo[i][1],vlo[i][2],vlo[i][3],vhi[i][0],vhi[i][1],vhi[i][2],vhi[i][3]}
  #define PIN(x) asm volatile("":"+v"(x))
  #define MX3(a,b,c) __builtin_fmaxf(__builtin_fmaxf((a),(b)),(c))
  #define GAPA(MF,A0,A1,A2,A3,W0,W1,PW) do{ MF; sacc+=A0; sacc+=A1; sacc+=A2; sacc+=A3; PIN(sacc); W0; W1; PIN(PW); SBAR(); }while(0)
  #define EX(v) __builtin_amdgcn_exp2f(v)
  #define GAPB(MF,X,B) do{ MF; X[B]=EX(X[B]); X[B+1]=EX(X[B+1]); X[B+2]=EX(X[B+2]); X[B+3]=EX(X[B+3]); PIN(X); SBAR(); }while(0)
  #define VRD(i) do{ vlo[i]=vtr(vp_+(((i)>>2)*4096+((i)&3)*1024)); vhi[i]=vtr(vp_+(((i)>>2)*4096+((i)&3)*1024+512)); }while(0)
  #define KRD(G,j) do{ if(G){ kload2(kf,kp0+sl_next,j); SBAR(); } }while(0)
  #define STEP(C0,C1,P0,P1,t,GK,GV,GL) do{ SBAR(); \
    const lds_cptr vp_=vp0+sl_prev; \
    VRD(0); SBAR(); float sacc=(P0[0]+P0[1]); \
    GAPA(C0=__builtin_amdgcn_mfma_f32_32x32x16_bf16(kf[0],qr[0],negm,0,0,0), P0[2],P0[3],P0[4],P0[5],     pw0[0]=PKW(P0,0), pw0[1]=PKW(P0,2), pw0); \
    VRD(4); SBAR(); GAPA(C1=__builtin_amdgcn_mfma_f32_32x32x16_bf16(kf[1],qr[0],negm,0,0,0), P0[6],P0[7],P0[8],P0[9],     pw0[2]=PKW(P0,4), pw0[3]=PKW(P0,6), pw0); \
    VRD(1); SBAR(); GAPA(C0=__builtin_amdgcn_mfma_f32_32x32x16_bf16(kf[2],qr[1],C0,0,0,0),   P0[10],P0[11],P0[12],P0[13], pw1[0]=PKW(P0,8), pw1[1]=PKW(P0,10), pw1); \
    VRD(5); SBAR(); GAPA(C1=__builtin_amdgcn_mfma_f32_32x32x16_bf16(kf[3],qr[1],C1,0,0,0),   P0[14],P0[15],P1[0],P1[1],   pw1[2]=PKW(P0,12),pw1[3]=PKW(P0,14), pw1); \
    VRD(2); SBAR(); GAPA(C0=__builtin_amdgcn_mfma_f32_32x32x16_bf16(kf[4],qr[2],C0,0,0,0),   P1[2],P1[3],P1[4],P1[5],     pw2[0]=PKW(P1,0), pw2[1]=PKW(P1,2), pw2); \
    VRD(6); SBAR(); GAPA(C1=__builtin_amdgcn_mfma_f32_32x32x16_bf16(kf[5],qr[2],C1,0,0,0),   P1[6],P1[7],P1[8],P1[9],     pw2[2]=PKW(P1,4), pw2[3]=PKW(P1,6), pw2); \
    VRD(3); SBAR(); GAPA(C0=__builtin_amdgcn_mfma_f32_32x32x16_bf16(kf[6],qr[3],C0,0,0,0),   P1[10],P1[11],P1[12],P1[13], pw3[0]=PKW(P1,8), pw3[1]=PKW(P1,10), pw3); \
    VRD(7); SBAR(); GAPA(C1=__builtin_amdgcn_mfma_f32_32x32x16_bf16(kf[7],qr[3],C1,0,0,0),   P1[14],P1[15],0.f,0.f,       pw3[2]=PKW(P1,12),pw3[3]=PKW(P1,14), pw3); \
    l_reg+=sacc; \
    if(GK){DMA_K((t)+3,sl_cur);} if(GV){DMA_V((t)+1,sl_next);} \
    CMASK(C0,C1,t); \
    { float a=MX3(C0[0],C0[1],C1[0]),b=MX3(C0[2],C0[3],C1[1]); a=MX3(a,C1[2],C1[3]); \
      _Pragma("unroll") for(int r=4;r<16;r+=4){a=MX3(a,C0[r],C0[r+1]);b=MX3(b,C0[r+2],C0[r+3]);a=MX3(a,C1[r],C1[r+1]);b=MX3(b,C1[r+2],C1[r+3]);} \
      float rm=__builtin_fmaxf(a,b); { auto rr=__builtin_amdgcn_permlane32_swap(__float_as_uint(rm),__float_as_uint(rm),false,false); rm=__builtin_fmaxf(__uint_as_float(rr[0]),__uint_as_float(rr[1])); } \
      resc=false; \
      if(__builtin_expect(__any(rm>(float)THRL),0)){ const float dl=__builtin_fmaxf(rm,0.f); mhat+=dl; \
        _Pragma("unroll") for(int r=0;r<16;++r){C0[r]-=dl;C1[r]-=dl;} \
        _Pragma("unroll") for(int r=0;r<16;++r)negm[r]=-mhat; asm volatile("":"+v"(negm)); \
        const float f=__builtin_amdgcn_exp2f(-dl); l_reg*=f; if(hi==0)wsf[r32]=f; resc=true; } } \
    SBAR(); \
    GAPB(o[0]=__builtin_amdgcn_mfma_f32_32x32x16_bf16(PAF(0),VFR(0),o[0],0,0,0), C0,0); \
    GAPB(o[1]=__builtin_amdgcn_mfma_f32_32x32x16_bf16(PAF(0),VFR(4),o[1],0,0,0), C0,4); \
    KRD(GL,0); GAPB(o[0]=__builtin_amdgcn_mfma_f32_32x32x16_bf16(PAF(1),VFR(1),o[0],0,0,0), C0,8); \
    KRD(GL,1); GAPB(o[1]=__builtin_amdgcn_mfma_f32_32x32x16_bf16(PAF(1),VFR(5),o[1],0,0,0), C0,12); \
    KRD(GL,2); GAPB(o[0]=__builtin_amdgcn_mfma_f32_32x32x16_bf16(PAF(2),VFR(2),o[0],0,0,0), C1,0); \
    KRD(GL,3); GAPB(o[1]=__builtin_amdgcn_mfma_f32_32x32x16_bf16(PAF(2),VFR(6),o[1],0,0,0), C1,4); \
    GAPB(o[0]=__builtin_amdgcn_mfma_f32_32x32x16_bf16(PAF(3),VFR(3),o[0],0,0,0), C1,8); \
    GAPB(o[1]=__builtin_amdgcn_mfma_f32_32x32x16_bf16(PAF(3),VFR(7),o[1],0,0,0), C1,12); \
    }while(0)
  int t=1;
  #undef CMASK
  #define CMASK(P0,P1,t) do{}while(0)
  for(;t+5<NT;t+=2){
    STEP(pB0,pB1,pA0,pA1,t,true,true,true);     WAIT_BAR(2); RESC(); ROT();
    STEP(pA0,pA1,pB0,pB1,t+1,true,true,true);   WAIT_BAR(2); RESC(); ROT();
  }
  #undef CMASK
  #define CMASK(P0,P1,t) do{}while(0)
  #define ENDW(tt) do{ if((tt)+3<NT){WAIT_BAR(2);} else if((tt)+2<NT){WAIT_BAR(1);} else {WAIT_BAR(0);} }while(0)
  for(;t+1<NT;t+=2){
    STEP(pB0,pB1,pA0,pA1,t,(t+3<NT),(t+1<NT),(t+1<NT));       ENDW(t);   RESC(); ROT();
    STEP(pA0,pA1,pB0,pB1,t+1,(t+4<NT),(t+2<NT),(t+2<NT));     ENDW(t+1); RESC(); ROT();
  }
  STEP(pB0,pB1,pA0,pA1,NT-1,false,false,false); RESC();
  { float sacc=pB0[0]+pB0[1]; _Pragma("unroll") for(int r=2;r<16;++r)sacc+=pB0[r]; _Pragma("unroll") for(int r=0;r<16;++r)sacc+=pB1[r]; l_reg+=sacc;
    pw0=(u32x4){PKW(pB0,0),PKW(pB0,2),PKW(pB0,4),PKW(pB0,6)};pw1=(u32x4){PKW(pB0,8),PKW(pB0,10),PKW(pB0,12),PKW(pB0,14)};pw2=(u32x4){PKW(pB1,0),PKW(pB1,2),PKW(pB1,4),PKW(pB1,6)};pw3=(u32x4){PKW(pB1,8),PKW(pB1,10),PKW(pB1,12),PKW(pB1,14)};
    SBAR(); pv(o,vb0+sl_cur,PAF(0),PAF(1),PAF(2),PAF(3)); }
  #undef PKW
  #undef PAF
  #undef VFR
  #undef PIN
  #undef MX3
  #undef GAPA
  #undef GAPB
  #undef EX
  #undef VRD
  #undef KRD
  #undef STEP
  #undef ENDW
  {auto rr=__builtin_amdgcn_permlane32_swap(__float_as_uint(l_reg),__float_as_uint(l_reg),false,false);l_reg=__uint_as_float(rr[0])+__uint_as_float(rr[1]);}
  if(hi==0)wsf[32+r32]=l_reg;asm volatile("s_waitcnt lgkmcnt(0)":::"memory");
  float rli[16];
  #pragma unroll
  for(int r=0;r<16;++r)rli[r]=__builtin_amdgcn_rcpf(wsf[32+crow(r,hi)]);
  bf16*Ow=Ob+(long)(wid*QBLK)*PO;
  { bf16*stg=(bf16*)(shm+LDS_OST)+wid*2048;
    #pragma unroll
    for(int r=0;r<16;++r){const int orow=crow(r,hi);
      #pragma unroll
      for(int d0=0;d0<2;++d0)stg[orow*64+d0*32+r32]=__float2bfloat16(o[d0][r]*rli[r]);}
    asm volatile("s_waitcnt lgkmcnt(0)":::"memory");
    #pragma unroll
    for(int i=0;i<4;++i){const int row=i*8+(lane>>3),ch=lane&7; const u32x4 v=*(const u32x4*)(stg+row*64+ch*8); ATTN_STORE16(Ow+(long)row*PO+ch*8,v);} }
  asm volatile("s_waitcnt lgkmcnt(0)\n\ts_barrier":::"memory");
  #undef DMA_K
  #undef DMA_V
  #undef CMASK
  #undef START
  #undef RESC
  #undef ROT
}
constexpr int ATTN_LDS_BYTES=LDS_BYTES;
#undef SBAR
#undef WAIT_BAR
}
#define GAS __attribute__((address_space(1)))
#define LAS __attribute__((address_space(3)))
typedef unsigned short bf16;
typedef unsigned v4u __attribute__((ext_vector_type(4)));
typedef float f32x4 __attribute__((ext_vector_type(4)));
typedef short bf16x8 __attribute__((ext_vector_type(8)));
typedef GAS unsigned gu32;
typedef GAS unsigned long long gu64;
#define RLX_AGENT __ATOMIC_RELAXED, __HIP_MEMORY_SCOPE_AGENT
#define LDS_WAIT() asm volatile("s_waitcnt lgkmcnt(0)" ::: "memory")
#define VM_WAIT() asm volatile("s_waitcnt vmcnt(0)" ::: "memory")
__device__ __forceinline__ unsigned long long rt() { return __builtin_amdgcn_s_memrealtime(); }
__device__ __forceinline__ unsigned f2bf(float f) { unsigned u = __builtin_bit_cast(unsigned, f); return (u + 0x7fffu + ((u >> 16) & 1u)) >> 16; }
__device__ __forceinline__ unsigned pk2(float lo, float hi) { return f2bf(lo) | (f2bf(hi) << 16); }

#define XB_TMO      128
#define XB_XCNT(j)  (256  + 64 * (j))
#define XB_XSUB(j)  (1280 + 64 * (j))
#define XB_XGEN(j)  (2304 + 64 * (j))
#define XB_TOP      3328
#define XB_TOPGEN   3392
#define XCD_BAR_WORDS 3456
#define XB_SPIN_CAP (1u << 18)

__device__ __forceinline__ unsigned xb_ld(unsigned* p)              { return __hip_atomic_load(p, __ATOMIC_RELAXED, __HIP_MEMORY_SCOPE_AGENT); }
__device__ __forceinline__ unsigned xb_add(unsigned* p, unsigned v) { return __hip_atomic_fetch_add(p, v, __ATOMIC_RELAXED, __HIP_MEMORY_SCOPE_AGENT); }
__device__ __forceinline__ unsigned xb_xcc_id() { return (unsigned)__builtin_amdgcn_s_getreg((3 << 11) | 20) & 0xFu; }
#define XB_SPIN(cond, bar) do { unsigned _sp = 0; while (cond) { __builtin_amdgcn_s_sleep(1); \
    if ((++_sp & 255u) == 0u) { if (xb_ld(&(bar)[XB_TMO])) break; if (_sp > XB_SPIN_CAP) { atomicAdd(&(bar)[XB_TMO], 1u); break; } } } } while (0)

struct XcdBarrier {
    unsigned* bar; unsigned x;
    volatile LAS unsigned* st;
};

__device__ __forceinline__ XcdBarrier xcd_barrier_post(unsigned* bar, volatile LAS unsigned* st) {
    XcdBarrier b; b.bar = bar; b.x = xb_xcc_id(); b.st = st;
    if (threadIdx.x == 0) (void)xb_add(&bar[XB_XCNT(b.x)], 1u);
    return b;
}
__device__ __forceinline__ void xcd_barrier_complete(unsigned* bar, unsigned x, unsigned& nloc, unsigned& nx) {
    const unsigned G = gridDim.x * gridDim.y * gridDim.z;
    unsigned sum, cnt, mine, sp = 0u;
    for (;;) {
        sum = 0u; cnt = 0u; mine = 0u;
#pragma unroll
        for (unsigned j = 0; j < 16; ++j) { const unsigned c = xb_ld(&bar[XB_XCNT(j)]); sum += c; cnt += (c > 0u) ? 1u : 0u; mine = (j == x) ? c : mine; }
        if (sum == G) break;
        __builtin_amdgcn_s_sleep(1);
        if ((++sp & 255u) == 0u) { if (xb_ld(&bar[XB_TMO])) break; if (sp > XB_SPIN_CAP) { atomicAdd(&bar[XB_TMO], 1u); break; } }
    }
    nloc = mine > 0u ? mine : 1u; nx = cnt > 0u ? cnt : 1u;
}

__device__ __forceinline__ void xcd_barrier(const XcdBarrier& b) {
    asm volatile("s_waitcnt vmcnt(0)" ::: "memory");
    __syncthreads();
    if (threadIdx.x == 0) {
        unsigned* bar = b.bar;
        __builtin_amdgcn_s_waitcnt(0);
        unsigned nloc = b.st[0], nx = b.st[1];
        if (nloc == 0u) { xcd_barrier_complete(bar, b.x, nloc, nx); b.st[0] = nloc; b.st[1] = nx; }
        const unsigned old = xb_add(&bar[XB_XSUB(b.x)], 1u);
        const unsigned gen = old / nloc;
        if (old + 1u == (gen + 1u) * nloc) {
            __builtin_amdgcn_fence(__ATOMIC_RELEASE, "agent");
            asm volatile("s_waitcnt vmcnt(0)" ::: "memory");
            const unsigned og = xb_add(&bar[XB_TOP], 1u);
            const unsigned tg = og / nx;
            if (og + 1u == (tg + 1u) * nx) xb_add(&bar[XB_TOPGEN], 1u);
            else XB_SPIN(xb_ld(&bar[XB_TOPGEN]) == tg, bar);
            __builtin_amdgcn_fence(__ATOMIC_ACQUIRE, "agent");
            xb_add(&bar[XB_XGEN(b.x)], 1u);
            asm volatile("s_waitcnt vmcnt(0)" ::: "memory");
        } else {
            XB_SPIN(xb_ld(&bar[XB_XGEN(b.x)]) == gen, bar);
            __builtin_amdgcn_fence(__ATOMIC_ACQUIRE, "agent");
            asm volatile("s_waitcnt vmcnt(0)" ::: "memory");
        }
    }
    __syncthreads();
}

constexpr int NWAVES = 8, NTHR = 512;
constexpr int DMODEL = 1024, TPB = 4352  , MROWS = 17408, NLAYER = 4;
constexpr int PATT_LD = 2816, PDN_LD = 1792, DFF = 2816, AU_LD = 5632;
constexpr int C_DAQ = 0, C_DAK = 512, C_DAV = 1024, C_GQQ = 1536, C_GQK = 2048, C_GQV = 2176, C_Z = 2304;
constexpr int C_DNQ = 0, C_BRAW = 1536, C_ARAW = 1544;
constexpr float NEPS = 1e-6f;
constexpr float QSCALE = 0.125f * 1.4426950408889634f;
constexpr size_t WS_CTL = 0, CTL_ZERO_BYTES = 1u << 20;
constexpr size_t WS_MOD = 1u << 20;
constexpr size_t WS_GL = (1u << 20) + (1u << 19);
constexpr size_t WS_WT = 2u << 20;
constexpr size_t WT_IN = 0, WT_BRA = 7864320, WT_BRB = WT_BRA + 524288, WT_BRC = WT_BRB + 524288, WT_O = WT_BRC + 524288, WT_1 = WT_O + 1048576, WT_2 = WT_1 + 5767168;
constexpr size_t WS_XS = 41943040;
constexpr size_t WS_HN = WS_XS + 71303168;
constexpr size_t WS_OC = WS_HN + 35651584;
constexpr size_t WS_PATT = WS_OC + 17825792;
constexpr size_t WS_A = WS_PATT + 98041856;
constexpr size_t WS_END = WS_A + 196083712;
constexpr size_t OPS_BYTES = 73728;
constexpr size_t A_ODA = 160432128;
constexpr size_t A_MRGF = 106954752;
constexpr size_t DO_OA = 35651584;
constexpr int CW_BAR = 4096, CW_Q = 1024;
constexpr int LDS_BYTES = 147456, MISC_OFF = LDS_BYTES - 256;

struct Args { const float* in[27]; float* out; unsigned char* ws; };
typedef const __attribute__((address_space(4))) Args* CArgsP;
#define ARGS_HERE(nm) CArgsP nm = (CArgsP)__builtin_amdgcn_kernarg_segment_ptr(); asm volatile("" : "+s"(nm))

__device__ __forceinline__ float wave_sum(float v) {
#pragma unroll
    for (int o = 1; o < 64; o <<= 1) v += __shfl_xor(v, o);
    return v;
}
__device__ __forceinline__ float silu_f(float v) { return v / (1.f + __expf(-v)); }
__device__ __forceinline__ float bf_lo(unsigned w) { return __uint_as_float(w << 16); }
__device__ __forceinline__ float bf_hi(unsigned w) { return __uint_as_float(w & 0xffff0000u); }
__device__ __forceinline__ float bf_1(bf16 u) { return __uint_as_float((unsigned)u << 16); }

__device__ __forceinline__ void phase_mod(CArgsP a, LAS unsigned char* lds, int tid, int bid, int G) {
    LAS float* sc = (LAS float*)lds; LAS float* red = sc + 5 * 1024;
    const float* c = a->in[1]; const float* cctx = a->in[3]; float* MOD = (float*)(a->ws + WS_MOD);
    for (int i = tid; i < 5 * 1024; i += NTHR) { const float v = (i < 4096) ? c[i] : cctx[i - 4096]; sc[i] = silu_f(v); }
    __syncthreads();
    const int wave = tid >> 6, lane = tid & 63;
    for (int task = bid; task < 4 * 96; task += G) {
        const int l = task / 96, n = (task % 96) * 64 + lane;
        const float* W = a->in[4] + (size_t)l * 1024 * 6144 + n;
        float acc[5] = {0.f, 0.f, 0.f, 0.f, 0.f};
        for (int k = wave * 128; k < wave * 128 + 128; ++k) { const float w = W[(size_t)k * 6144];
#pragma unroll
            for (int r = 0; r < 5; ++r) acc[r] += sc[r * 1024 + k] * w; }
#pragma unroll
        for (int r = 0; r < 5; ++r) red[(wave * 5 + r) * 64 + lane] = acc[r];
        __syncthreads();
        if (tid < 320) { const int r = tid >> 6; float s = 0.f;
#pragma unroll
            for (int w = 0; w < 8; ++w) s += red[(w * 5 + r) * 64 + lane];
            MOD[(size_t)(l * 5 + r) * 6144 + n] = s + a->in[5][l * 6144 + n]; }
        __syncthreads();
    }
}

__device__ __forceinline__ int map_in(int nd) {
    if (nd < 2304) return nd;
    if (nd < 2816) return 3856 + (nd - 2304);
    if (nd < 2816 + 1536) return 2304 + (nd - 2816);
    if (nd < 2816 + 1552) return 3840 + (nd - 2816 - 1536);
    if (nd < 4608) return -1;
    return 4368 + (nd - 4608);
}
template <bool MAPIN> __device__ __forceinline__ void tr_item(const float* W, int K, int N, bf16* WT, LAS float* scr, int item, int lane, int nblk) {
    const int kb = item / nblk, nb = item % nblk, k0 = 64 * kb, n0 = 32 * nb;
    const int nd = n0 + (lane & 31); const int ns = MAPIN ? map_in(nd) : nd;
#pragma unroll 8
    for (int i = 0; i < 32; ++i) { const int kk = 2 * i + (lane >> 5); scr[kk * 33 + (lane & 31)] = (ns >= 0) ? W[(size_t)(k0 + kk) * N + ns] : 0.f; }
    LDS_WAIT(); asm volatile("" ::: "memory");
    const int c = lane & 7;
#pragma unroll
    for (int j = 0; j < 4; ++j) { const int n = (lane >> 3) + 8 * j; const LAS float* s = scr + (8 * c) * 33 + n;
        v4u o; o.x = pk2(s[0 * 33], s[1 * 33]); o.y = pk2(s[2 * 33], s[3 * 33]); o.z = pk2(s[4 * 33], s[5 * 33]); o.w = pk2(s[6 * 33], s[7 * 33]);
        *(GAS v4u*)(WT + (size_t)(n0 + n) * K + k0 + 8 * c) = o; }
    LDS_WAIT(); asm volatile("" ::: "memory");
}
__device__ __forceinline__ void phase_convert(CArgsP a, int l, LAS unsigned char* lds, int gw, int NGW, int wave, int lane) {
    LAS float* scr = (LAS float*)(lds + wave * 16384);
    bf16* WT = (bf16*)(a->ws + WS_WT);
    for (int it = gw; it < 9344; it += NGW) {
        int r = it;
        if (r < 3840) { tr_item<true>(a->in[7] + (size_t)l * 1024 * 7440, 1024, 7440, WT + WT_IN, scr, r, lane, 240); continue; } r -= 3840;
        if (r < 256) { tr_item<false>(a->in[18] + (size_t)l * 512 * 1024, 512, 1024, WT + WT_BRA, scr, r, lane, 32); continue; } r -= 256;
        if (r < 256) { tr_item<false>(a->in[19] + (size_t)l * 512 * 1024, 512, 1024, WT + WT_BRB, scr, r, lane, 32); continue; } r -= 256;
        if (r < 256) { tr_item<false>(a->in[20] + (size_t)l * 512 * 1024, 512, 1024, WT + WT_BRC, scr, r, lane, 32); continue; } r -= 256;
        if (r < 512) { tr_item<false>(a->in[21] + (size_t)l * 1024 * 1024, 1024, 1024, WT + WT_O, scr, r, lane, 32); continue; } r -= 512;
        if (r < 2816) { tr_item<false>(a->in[23] + (size_t)l * 1024 * 5632, 1024, 5632, WT + WT_1, scr, r, lane, 176); continue; } r -= 2816;
        tr_item<false>(a->in[26] + (size_t)l * 2816 * 1024, 2816, 1024, WT + WT_2, scr, r, lane, 32);
    }
}

__device__ __forceinline__ void phase_norm(CArgsP a, int l, int which, int gw, int NGW, int lane) {
    const float* gain = a->in[which ? 22 : 6] + l * 1024;
    const float* modl = (const float*)(a->ws + WS_MOD) + (size_t)l * 5 * 6144;
    const int shoff = which ? 3 * 1024 : 0, scoff = which ? 4 * 1024 : 1024;
    float* XS = (float*)(a->ws + WS_XS); bf16* HN = (bf16*)(a->ws + WS_HN);
    const bool first = (which == 0 && l == 0);
    for (int row = gw; row < MROWS; row += NGW) {
        const int b = row / TPB, p = row % TPB;
        const float* src = first ? (p < 256 ? a->in[2] + ((size_t)b * 256 + p) * 1024 : a->in[0] + ((size_t)b * 4096 + (p - 256)) * 1024) : XS + (size_t)row * 1024;
        f32x4 v[4]; float ss = 0.f;
#pragma unroll
        for (int j = 0; j < 4; ++j) { v[j] = *(const f32x4*)(src + 4 * lane + 256 * j); ss += (v[j].x * v[j].x + v[j].y * v[j].y) + (v[j].z * v[j].z + v[j].w * v[j].w); }
        const float rstd = 1.f / sqrtf(wave_sum(ss) * (1.f / 1024.f) + NEPS);
        const float* mrow = modl + (size_t)(p < 256 ? 4 : b) * 6144;
#pragma unroll
        for (int j = 0; j < 4; ++j) { const int col = 4 * lane + 256 * j;
            const f32x4 g4 = *(const f32x4*)(gain + col), sh = *(const f32x4*)(mrow + shoff + col), sc = *(const f32x4*)(mrow + scoff + col);
            const f32x4 h = (v[j] * rstd * g4) * (sc + 1.0f) + sh;
            *(unsigned long long*)(HN + (size_t)row * 1024 + col) = (unsigned long long)pg8::pkbf(h.x, h.y) | ((unsigned long long)pg8::pkbf(h.z, h.w) << 32);
            if (first) *(f32x4*)(XS + (size_t)row * 1024 + col) = v[j]; }
    }
}

__device__ __forceinline__ void qk_row(CArgsP a, int l, int row, int lane) {
    bf16* prow = (bf16*)(a->ws + WS_PATT) + (size_t)row * PATT_LD;
    const int p = row % TPB; const bool lat = p >= 256; const int t = p - 256;
    const int hv = lane >> 3, j8 = lane & 7, half = j8 >> 2, jj = j8 & 3;
    float cs[8], sn[8];
    if (lat) { const float pos = (float)(half == 0 ? (t >> 6) : (t & 63));
#pragma unroll
        for (int i = 0; i < 8; ++i) { const float f = (float)((jj & 1) * 8 + i); const float invf = exp2f(-f * (13.287712379549449f / 16.f)); sincosf(pos * invf, &sn[i], &cs[i]); } }
    else {
#pragma unroll
        for (int i = 0; i < 8; ++i) { cs[i] = 1.f; sn[i] = 0.f; } }
    const float sgn = (jj < 2) ? -1.f : 1.f;
#pragma unroll
    for (int seg = 0; seg < 4; ++seg) {
        const int colbase = seg == 0 ? C_DAQ : seg == 1 ? C_DAK : seg == 2 ? C_GQQ : C_GQK;
        const float* gain = a->in[seg == 0 ? 8 : seg == 1 ? 9 : seg == 2 ? 12 : 13] + l * 64 + j8 * 8;
        const bool isq = (seg == 0 || seg == 2); const bool active = (seg == 3) ? (hv < 2) : true;
        bf16* ptr = prow + colbase + hv * 64 + j8 * 8;
        v4u raw = (v4u){0u, 0u, 0u, 0u}; if (active) raw = *(const v4u*)ptr;
        float x[8] = {bf_lo(raw.x), bf_hi(raw.x), bf_lo(raw.y), bf_hi(raw.y), bf_lo(raw.z), bf_hi(raw.z), bf_lo(raw.w), bf_hi(raw.w)};
        float ss = 0.f;
#pragma unroll
        for (int i = 0; i < 8; ++i) ss += x[i] * x[i];
        ss += __shfl_xor(ss, 1); ss += __shfl_xor(ss, 2); ss += __shfl_xor(ss, 4);
        const float rstd = 1.f / sqrtf(ss * (1.f / 64.f) + NEPS);
        float o[8];
#pragma unroll
        for (int i = 0; i < 8; ++i) { const float y = x[i] * rstd * gain[i]; const float py = __shfl_xor(y, 2); float r = y * cs[i] + sgn * py * sn[i]; if (isq) r *= QSCALE; o[i] = r; }
        if (active) { v4u w; w.x = pg8::pkbf(o[0], o[1]); w.y = pg8::pkbf(o[2], o[3]); w.z = pg8::pkbf(o[4], o[5]); w.w = pg8::pkbf(o[6], o[7]); *(v4u*)ptr = w; }
    }
}

constexpr int PS = 132;
constexpr int L_QS = 0, L_KS = 33792, L_VS = 67584, L_KK = 101376, L_QK = 117760, L_SC = 134144;
__device__ __forceinline__ void dn_task_decode(int task, int& b, int& seg, int& h, int& n, int& NC) {
    b = task / 272; int r = task % 272;
    if (r < 16) { seg = 0; h = r >> 2; n = r & 3; NC = 4; } else { r -= 16; seg = 1; h = r >> 6; n = r & 63; NC = 64; }
}
__device__ __forceinline__ void dn_prep_task(CArgsP a, int l, int task, LAS unsigned char* lds, int tid) {
    asm volatile("" : "+v"(tid));
    int b, seg, h, n, NC; dn_task_decode(task, b, seg, h, n, NC);
    const int seglo = b * TPB + (seg ? 256 : 0), seghi = seglo + NC * 64, rowbase = seglo + 64 * n;
    const bf16* PDN = (const bf16*)a->out;
    LAS float* QS = (LAS float*)(lds + L_QS); LAS float* KS = (LAS float*)(lds + L_KS); LAS float* VS = (LAS float*)(lds + L_VS);
    LAS float* KK = (LAS float*)(lds + L_KK); LAS float* QK = (LAS float*)(lds + L_QK);
    LAS float* sBeta = (LAS float*)(lds + L_SC); LAS float* sGc = sBeta + 128; LAS float* sEg = sGc + 128; LAS float* sBe = sEg + 128;
    const int wave = tid >> 6, lane = tid & 63;
    { const int c = tid & 127, rg = tid >> 7;
#pragma unroll
      for (int which = 0; which < 3; ++which) {
        const int col = which * 512 + h * 128 + c;
        const float* cw = a->in[14] + (size_t)l * 3 * 1536 + col; const float w0 = cw[0], w1 = cw[1536], w2 = cw[3072];
        LAS float* dst = (which == 0 ? QS : which == 1 ? KS : VS);
        int row = rowbase + 16 * rg;
        float xm = (row - 1 >= seglo) ? bf_1(PDN[(size_t)(row - 1) * PDN_LD + col]) : 0.f;
        float x0 = bf_1(PDN[(size_t)row * PDN_LD + col]);
        for (int i = 0; i < 16; ++i, ++row) {
            const float xp = (row + 1 < seghi) ? bf_1(PDN[(size_t)(row + 1) * PDN_LD + col]) : 0.f;
            const float y = w0 * xm + w1 * x0 + w2 * xp;
            dst[(16 * rg + i) * PS + c] = silu_f(y);
            xm = x0; x0 = xp; }
      } }
    __syncthreads();
    for (int r = wave * 8; r < wave * 8 + 8; ++r) {
        { const float x0 = QS[r * PS + lane], x1 = QS[r * PS + 64 + lane]; const float s = 1.f / sqrtf(wave_sum(x0 * x0 + x1 * x1) + NEPS); QS[r * PS + lane] = x0 * s; QS[r * PS + 64 + lane] = x1 * s; }
        { const float x0 = KS[r * PS + lane], x1 = KS[r * PS + 64 + lane]; const float s = 1.f / sqrtf(wave_sum(x0 * x0 + x1 * x1) + NEPS); KS[r * PS + lane] = x0 * s; KS[r * PS + 64 + lane] = x1 * s; }
    }
    if (wave < 2) { const int dir = wave; const int cn = dir ? 63 - lane : lane; const size_t ro = (size_t)(rowbase + cn) * PDN_LD;
        const float braw = bf_1(PDN[ro + C_BRAW + dir * 4 + h]), araw = bf_1(PDN[ro + C_ARAW + dir * 4 + h]);
        const float beta = 1.f / (1.f + expf(-braw));
        const float xs = araw + a->in[16][l * 8 + dir * 4 + h];
        const float ee = __expf(-fabsf(xs)); const float l1p = (ee < 0.03f) ? ee * (1.f - ee * (0.5f - ee * (0.33333334f - 0.25f * ee))) : __logf(1.f + ee); const float sp = fmaxf(xs, 0.f) + l1p;
        float g = -expf(a->in[15][l * 8 + dir * 4 + h]) * sp;
#pragma unroll
        for (int off = 1; off < 64; off <<= 1) { const float v = __shfl_up(g, off); if (lane >= off) g += v; }
        const float eg = expf(g);
        sBeta[dir * 64 + lane] = beta; sGc[dir * 64 + lane] = g; sEg[dir * 64 + lane] = eg; sBe[dir * 64 + lane] = beta * eg;
        if (lane == 63) ((float*)(a->ws + WS_GL))[task * 2 + dir] = eg; }
    __syncthreads();
    { const int i = tid >> 3, jr = tid & 7; float kk[8], qk[8];
#pragma unroll
      for (int jj = 0; jj < 8; ++jj) { kk[jj] = 0.f; qk[jj] = 0.f; }
      for (int d = 0; d < 128; d += 4) { const f32x4 ki = *(const LAS f32x4*)(KS + i * PS + d), qi = *(const LAS f32x4*)(QS + i * PS + d);
#pragma unroll
        for (int jj = 0; jj < 8; ++jj) { const f32x4 kj = *(const LAS f32x4*)(KS + (jr + 8 * jj) * PS + d);
            kk[jj] += (ki.x * kj.x + ki.y * kj.y) + (ki.z * kj.z + ki.w * kj.w); qk[jj] += (qi.x * kj.x + qi.y * kj.y) + (qi.z * kj.z + qi.w * kj.w); } }
#pragma unroll
      for (int jj = 0; jj < 8; ++jj) { KK[i * 64 + jr + 8 * jj] = kk[jj]; QK[i * 64 + jr + 8 * jj] = qk[jj]; } }
    __syncthreads();
    unsigned char* ops0 = a->ws + WS_A + (size_t)task * 2 * OPS_BYTES;
    const float qs = 0.08838834764831845f;
    for (int f = tid; f < 2048; f += NTHR) {
        const int dir = f >> 10, ff = f & 1023, mb = ff >> 9, ks = (ff >> 6) & 7, ln = ff & 63, g = ln >> 5, r = ln & 31;
        const int cp = mb * 32 + r, cn = dir ? 63 - cp : cp; const float sc = sEg[dir * 64 + cp] * qs;
        const int db = 32 * (ks >> 1) + 16 * (ks & 1) + 4 * g;
        const f32x4 v0 = *(const LAS f32x4*)(QS + cn * PS + db), v1 = *(const LAS f32x4*)(QS + cn * PS + db + 8);
        v4u o; o.x = pg8::pkbf(v0.x * sc, v0.y * sc); o.y = pg8::pkbf(v0.z * sc, v0.w * sc); o.z = pg8::pkbf(v1.x * sc, v1.y * sc); o.w = pg8::pkbf(v1.z * sc, v1.w * sc);
        *(v4u*)(ops0 + (size_t)dir * OPS_BYTES + 32768 + ff * 16) = o; }
    for (int f = tid; f < 2048; f += NTHR) {
        const int dir = f >> 10, ff = f & 1023, mb = ff >> 8, ks = (ff >> 6) & 3, ln = ff & 63, g = ln >> 5, r = ln & 31;
        const int d = mb * 32 + r; const float gl = sGc[dir * 64 + 63]; float v[8];
#pragma unroll
        for (int j = 0; j < 8; ++j) { const int cp = 16 * ks + 8 * (j >> 2) + 4 * g + (j & 3), cn = dir ? 63 - cp : cp; v[j] = KS[cn * PS + d] * expf(gl - sGc[dir * 64 + cp]); }
        v4u o; o.x = pg8::pkbf(v[0], v[1]); o.y = pg8::pkbf(v[2], v[3]); o.z = pg8::pkbf(v[4], v[5]); o.w = pg8::pkbf(v[6], v[7]);
        *(v4u*)(ops0 + (size_t)dir * OPS_BYTES + 16384 + ff * 16) = o; }
    for (int f = tid; f < 1024; f += NTHR) {
        const int dir = f >> 9, ff = f & 511, mb = ff >> 8, ks = (ff >> 6) & 3, ln = ff & 63, g = ln >> 5, r = ln & 31;
        const int cp = mb * 32 + r, cn = dir ? 63 - cp : cp; const float gc = sGc[dir * 64 + cp]; float v[8];
#pragma unroll
        for (int j = 0; j < 8; ++j) { const int sp = 16 * ks + 8 * (j >> 2) + 4 * g + (j & 3), sn = dir ? 63 - sp : sp;
            v[j] = (cp >= sp) ? QK[cn * 64 + sn] * qs * expf(gc - sGc[dir * 64 + sp]) : 0.f; }
        v4u o; o.x = pg8::pkbf(v[0], v[1]); o.y = pg8::pkbf(v[2], v[3]); o.z = pg8::pkbf(v[4], v[5]); o.w = pg8::pkbf(v[6], v[7]);
        *(v4u*)(ops0 + (size_t)dir * OPS_BYTES + 49152 + ff * 16) = o; }
    __syncthreads();
    LAS float* AM = (LAS float*)(lds + L_QS);
    for (int idx = tid; idx < 8192; idx += NTHR) { const int dir = idx >> 12, ip = (idx >> 6) & 63, jp = idx & 63;
        const int in_ = dir ? 63 - ip : ip, jn = dir ? 63 - jp : jp;
        AM[idx] = (ip > jp) ? sBeta[dir * 64 + ip] * KK[in_ * 64 + jn] * expf(sGc[dir * 64 + ip] - sGc[dir * 64 + jp]) : 0.f; }
    __syncthreads();
    { const int dir = tid >> 8, c = tid & 255; float X[64];
      const LAS float* srcm = (c < 128) ? (VS + c) : (KS + (c - 128)); const LAS float* fac = (c < 128) ? (sBeta + dir * 64) : (sBe + dir * 64);
#pragma unroll
      for (int i = 0; i < 64; ++i) { const int in_ = dir ? 63 - i : i; X[i] = srcm[in_ * PS] * fac[i]; }
      __syncthreads();
      const LAS float* Ad = AM + dir * 4096;
#pragma unroll
      for (int i = 1; i < 64; ++i) { float s0 = 0.f, s1 = 0.f;
#pragma unroll
        for (int j = 0; j < i; ++j) { if (j & 1) s1 += Ad[i * 64 + j] * X[j]; else s0 += Ad[i * 64 + j] * X[j]; }
        X[i] -= (s0 + s1); }
      LAS bf16* XB = (LAS bf16*)(lds + L_KS) + dir * 64 * 256;
      const float sg = (c < 128) ? 1.f : -1.f;
#pragma unroll
      for (int i = 0; i < 64; ++i) XB[i * 256 + c] = (bf16)(pg8::pkbf(X[i] * sg, 0.f) & 0xffffu); }
    __syncthreads();
    { const LAS bf16* XB0 = (const LAS bf16*)(lds + L_KS);
      for (int f = tid; f < 2048; f += NTHR) {
        const int dir = f >> 10, ff = f & 1023, mb = ff >> 9, ks = (ff >> 6) & 7, ln = ff & 63, g = ln >> 5, r = ln & 31;
        const int cp = mb * 32 + r, db = 32 * (ks >> 1) + 16 * (ks & 1) + 4 * g;
        const LAS bf16* s = XB0 + (dir * 64 + cp) * 256 + 128 + db;
        v4u o; o.x = (unsigned)s[0] | ((unsigned)s[1] << 16); o.y = (unsigned)s[2] | ((unsigned)s[3] << 16); o.z = (unsigned)s[8] | ((unsigned)s[9] << 16); o.w = (unsigned)s[10] | ((unsigned)s[11] << 16);
        *(v4u*)(ops0 + (size_t)dir * OPS_BYTES + ff * 16) = o; }
      for (int f = tid; f < 1024; f += NTHR) {
        const int dir = f >> 9, ff = f & 511, sl = ff >> 7, blk = (ff >> 6) & 1, ln = ff & 63, g = ln >> 5, e = ln & 31;
        unsigned w[8];
#pragma unroll
        for (int q = 0; q < 8; ++q) { const int r0 = 2 * q, r1 = 2 * q + 1;
            const int i0 = blk * 32 + (r0 & 3) + 8 * (r0 >> 2) + 4 * g, i1 = blk * 32 + (r1 & 3) + 8 * (r1 >> 2) + 4 * g;
            w[q] = (unsigned)XB0[(dir * 64 + i0) * 256 + sl * 32 + e] | ((unsigned)XB0[(dir * 64 + i1) * 256 + sl * 32 + e] << 16); }
        unsigned char* dst = ops0 + (size_t)dir * OPS_BYTES + 57344 + ff * 32;
        *(v4u*)dst = (v4u){w[0], w[1], w[2], w[3]}; *(v4u*)(dst + 16) = (v4u){w[4], w[5], w[6], w[7]}; }
    }
    __syncthreads();
}

typedef float f32x16 __attribute__((ext_vector_type(16)));
#define MFMA32(a_, b_, c_) __builtin_amdgcn_mfma_f32_32x32x16_bf16((a_), (b_), (c_), 0, 0, 0)
__device__ __forceinline__ bf16x8 pack8(const f32x16& x, int s) {
    v4u p; p.x = pg8::pkbf(x[8 * s + 0], x[8 * s + 1]); p.y = pg8::pkbf(x[8 * s + 2], x[8 * s + 3]); p.z = pg8::pkbf(x[8 * s + 4], x[8 * s + 5]); p.w = pg8::pkbf(x[8 * s + 6], x[8 * s + 7]);
    return __builtin_bit_cast(bf16x8, p);
}
__device__ __forceinline__ void dn_scan_job(CArgsP a, int job, int wave, int lane) {
    const int chain = job * 2 + (wave >> 2), sl = wave & 3;
    const int b = chain >> 3, h = (chain >> 1) & 3, dir = chain & 1;
    const int g = lane >> 5, e = lane & 31;
    bf16* OFB = (bf16*)a->out + (size_t)dir * MROWS * 512;
    const float* GL = (const float*)(a->ws + WS_GL);
    f32x16 S[4];
#pragma unroll
    for (int i = 0; i < 4; ++i)
#pragma unroll
        for (int r = 0; r < 16; ++r) S[i][r] = 0.f;
    for (int seg = 0; seg < 2; ++seg) {
        const int NC = seg ? 64 : 4;
        for (int step = 0; step < NC; ++step) {
            const int n = dir ? NC - 1 - step : step;
            const int task = b * 272 + (seg ? 16 + h * 64 + n : h * 4 + n);
            const unsigned char* ops = a->ws + WS_A + ((size_t)task * 2 + dir) * OPS_BYTES;
            const float gl = GL[task * 2 + dir];
            const bf16x8* NW = (const bf16x8*)ops + lane; const bf16x8* KT = (const bf16x8*)(ops + 16384) + lane;
            const bf16x8* QD = (const bf16x8*)(ops + 32768) + lane; const bf16x8* QKp = (const bf16x8*)(ops + 49152) + lane;
            bf16x8 Sb[8];
#pragma unroll
            for (int ks = 0; ks < 8; ++ks) Sb[ks] = pack8(S[ks >> 1], ks & 1);
            f32x16 vn[2];
#pragma unroll
            for (int mb = 0; mb < 2; ++mb) {
                const v4u* up = (const v4u*)(ops + 57344 + ((sl * 2 + mb) * 64 + lane) * 32); const v4u u0 = up[0], u1 = up[1];
                f32x16 c;
                c[0] = bf_lo(u0.x); c[1] = bf_hi(u0.x); c[2] = bf_lo(u0.y); c[3] = bf_hi(u0.y); c[4] = bf_lo(u0.z); c[5] = bf_hi(u0.z); c[6] = bf_lo(u0.w); c[7] = bf_hi(u0.w);
                c[8] = bf_lo(u1.x); c[9] = bf_hi(u1.x); c[10] = bf_lo(u1.y); c[11] = bf_hi(u1.y); c[12] = bf_lo(u1.z); c[13] = bf_hi(u1.z); c[14] = bf_lo(u1.w); c[15] = bf_hi(u1.w);
#pragma unroll
                for (int ks = 0; ks < 8; ++ks) c = MFMA32(NW[(mb * 8 + ks) * 64], Sb[ks], c);
                vn[mb] = c; }
            bf16x8 Vb[4];
#pragma unroll
            for (int ks = 0; ks < 4; ++ks) Vb[ks] = pack8(vn[ks >> 1], ks & 1);
#pragma unroll
            for (int mb = 0; mb < 2; ++mb) {
                f32x16 o;
#pragma unroll
                for (int r = 0; r < 16; ++r) o[r] = 0.f;
#pragma unroll
                for (int ks = 0; ks < 8; ++ks) o = MFMA32(QD[(mb * 8 + ks) * 64], Sb[ks], o);
#pragma unroll
                for (int ks = 0; ks < 4; ++ks) o = MFMA32(QKp[(mb * 4 + ks) * 64], Vb[ks], o);
#pragma unroll
                for (int r = 0; r < 16; ++r) { const int cp = mb * 32 + (r & 3) + 8 * (r >> 2) + 4 * g; const int cn = dir ? 63 - cp : cp;
                    const size_t row = (size_t)b * TPB + (seg ? 256 : 0) + 64 * n + cn;
                    OFB[row * 512 + h * 128 + sl * 32 + e] = (bf16)(pg8::pkbf(o[r], 0.f) & 0xffffu); } }
#pragma unroll
            for (int mb = 0; mb < 4; ++mb) { f32x16 c = S[mb] * gl;
#pragma unroll
                for (int ks = 0; ks < 4; ++ks) c = MFMA32(KT[(mb * 4 + ks) * 64], Vb[ks], c);
                S[mb] = c; }
        }
    }
}

__device__ __forceinline__ void post2_row(CArgsP a, int l, int row, int lane, float lam, float one_m_li) {
    const unsigned* od = (const unsigned*)(a->ws + WS_A + A_ODA) + (size_t)row * 512;
    unsigned* oa = (unsigned*)((unsigned char*)a->out + DO_OA) + (size_t)row * 256;
    const unsigned* of = (const unsigned*)a->out + (size_t)row * 256; const unsigned* ob = of + (size_t)MROWS * 256;
    unsigned* oc = (unsigned*)(a->ws + WS_OC) + (size_t)row * 256;
    const unsigned* zr = (const unsigned*)((const bf16*)(a->ws + WS_PATT) + (size_t)row * PATT_LD + C_Z);
    const float sg0 = a->in[11][l * 128 + 2 * lane], sg1 = a->in[11][l * 128 + 2 * lane + 1];
    const float ng0 = a->in[17][l * 128 + 2 * lane], ng1 = a->in[17][l * 128 + 2 * lane + 1];
#pragma unroll
    for (int h = 0; h < 4; ++h) {
        { const unsigned w1 = od[(h * 2) * 64 + lane], w2 = od[(h * 2 + 1) * 64 + lane];
          const float d0 = bf_lo(w1) - lam * bf_lo(w2), d1 = bf_hi(w1) - lam * bf_hi(w2);
          const float rstd = 1.f / sqrtf(wave_sum(d0 * d0 + d1 * d1) * (1.f / 128.f) + NEPS);
          oa[h * 64 + lane] = pg8::pkbf(d0 * rstd * sg0 * one_m_li, d1 * rstd * sg1 * one_m_li); }
        { const unsigned wf = of[h * 64 + lane], wb = ob[h * 64 + lane], wz = zr[h * 64 + lane];
          const float d0 = bf_lo(wf) + bf_lo(wb), d1 = bf_hi(wf) + bf_hi(wb);
          const float rstd = 1.f / sqrtf(wave_sum(d0 * d0 + d1 * d1) * (1.f / 128.f) + NEPS);
          oc[h * 64 + lane] = pg8::pkbf(d0 * rstd * ng0 * silu_f(bf_lo(wz)), d1 * rstd * ng1 * silu_f(bf_hi(wz))); }
    }
}

__device__ __forceinline__ void phase_act(CArgsP a, int l, int gtid, int nthr) {
    bf16* AU = (bf16*)(a->ws + WS_A);
    const float* cw = a->in[24] + (size_t)l * 3 * DFF; const float* cb = a->in[25] + (size_t)l * DFF;
    for (int it = gtid; it < 1088 * 352; it += nthr) {
        const int cgp = it % 352, strip = it / 352, r0 = strip * 16, p0 = r0 % TPB, col = cgp * 8;
        const bool topv = (p0 != 0 && p0 != 256), botv = (p0 + 15 != 255 && p0 + 15 != TPB - 1);
        float w0[8], w1[8], w2[8], bb[8];
#pragma unroll
        for (int i = 0; i < 8; ++i) { w0[i] = cw[col + i]; w1[i] = cw[DFF + col + i]; w2[i] = cw[2 * DFF + col + i]; bb[i] = cb[col + i]; }
        const bf16* ap = AU + (size_t)r0 * AU_LD + col;
        v4u prev = (v4u){0u, 0u, 0u, 0u}; if (topv) prev = *(const v4u*)(ap - AU_LD);
        v4u cur = *(const v4u*)ap;
        for (int i = 0; i < 16; ++i) {
            v4u nxt = (v4u){0u, 0u, 0u, 0u}; if (i < 15 || botv) nxt = *(const v4u*)(ap + (size_t)(i + 1) * AU_LD);
            bf16* up = AU + (size_t)(r0 + i) * AU_LD + DFF + col; const v4u uu = *(const v4u*)up;
            const float pm[8] = {bf_lo(prev.x), bf_hi(prev.x), bf_lo(prev.y), bf_hi(prev.y), bf_lo(prev.z), bf_hi(prev.z), bf_lo(prev.w), bf_hi(prev.w)};
            const float pc[8] = {bf_lo(cur.x), bf_hi(cur.x), bf_lo(cur.y), bf_hi(cur.y), bf_lo(cur.z), bf_hi(cur.z), bf_lo(cur.w), bf_hi(cur.w)};
            const float pn[8] = {bf_lo(nxt.x), bf_hi(nxt.x), bf_lo(nxt.y), bf_hi(nxt.y), bf_lo(nxt.z), bf_hi(nxt.z), bf_lo(nxt.w), bf_hi(nxt.w)};
            const float pu[8] = {bf_lo(uu.x), bf_hi(uu.x), bf_lo(uu.y), bf_hi(uu.y), bf_lo(uu.z), bf_hi(uu.z), bf_lo(uu.w), bf_hi(uu.w)};
            float o[8];
#pragma unroll
            for (int k = 0; k < 8; ++k) o[k] = silu_f(w0[k] * pm[k] + w1[k] * pc[k] + w2[k] * pn[k] + bb[k]) * pu[k];
            v4u w; w.x = pg8::pkbf(o[0], o[1]); w.y = pg8::pkbf(o[2], o[3]); w.z = pg8::pkbf(o[4], o[5]); w.w = pg8::pkbf(o[6], o[7]);
            *(v4u*)up = w; prev = cur; cur = nxt; }
    }
}

typedef pg8::Epi<1, 0> EpiIn; typedef pg8::Epi<2, 0> EpiGate; typedef pg8::Epi<0, 0> EpiSt;
__global__ void __launch_bounds__(NTHR, 2) mk_fwd(Args args_unused) {
    extern __shared__ __attribute__((aligned(16))) unsigned char lds_raw[];
    LAS unsigned char* lds = (LAS unsigned char*)lds_raw;
    volatile LAS unsigned* MISC = (volatile LAS unsigned*)(lds + MISC_OFF);
    const int tid = threadIdx.x, lane = tid & 63, wave = __builtin_amdgcn_readfirstlane(tid >> 6);
    const int G = gridDim.x, bid = blockIdx.x;
    const int gw = bid * NWAVES + wave, NGW = G * NWAVES;
    for (int u = tid; u < 64; u += NTHR) MISC[u] = 0u;
    __syncthreads();
    XcdBarrier bar;
    { ARGS_HERE(A); bar = xcd_barrier_post((unsigned*)(A->ws + WS_CTL) + CW_BAR, MISC); }
#define GRID_BAR() xcd_barrier(bar)
#define PHASE_IDS() int ptid = threadIdx.x; asm volatile("" : "+v"(ptid)); const int plane = ptid & 63; const int pwave = __builtin_amdgcn_readfirstlane(ptid >> 6); const int pgw = bid * NWAVES + pwave; (void)plane; (void)pgw

    { ARGS_HERE(A); phase_mod(A, lds, tid, bid, G); phase_convert(A, 0, lds, gw, NGW, wave, lane); }
    cg::this_grid().sync();

    for (int l = 0; l < NLAYER; ++l) {
        { ARGS_HERE(A); PHASE_IDS(); if (l > 0) phase_convert(A, l, lds, pgw, NGW, pwave, plane); phase_norm(A, l, 0, pgw, NGW, plane); }
        GRID_BAR();
        { ARGS_HERE(A); PHASE_IDS(); unsigned char* ws = A->ws;
          pg8::Gemm g{(bf16*)(ws + WS_HN), (bf16*)(ws + WS_WT) + WT_IN, MROWS, 4608, 1024, 1024}; pg8::StaticOrder S; S.init(MROWS, 4608, G, bid);
          EpiIn E{(bf16*)(ws + WS_PATT), PATT_LD, (bf16*)A->out, nullptr, 0, 0, nullptr, nullptr, nullptr};
          pg8::gemm_phase<EpiIn, pg8::StaticOrder, true, true>(lds, g, S, E); }
        GRID_BAR();
        { ARGS_HERE(A); PHASE_IDS();
          for (int task = bid; task < 1088; task += G) dn_prep_task(A, l, task, lds, ptid);
          for (int row = pgw; row < MROWS; row += NGW) qk_row(A, l, row, plane); }
        GRID_BAR();
        { const int nunits = 16 + 1536 + (l < NLAYER - 1 ? 96 : 0);
          for (;;) {
            ARGS_HERE(A); PHASE_IDS(); unsigned char* ws = A->ws;
            if (ptid == 0) MISC[8] = __hip_atomic_fetch_add((unsigned*)(ws + WS_CTL) + CW_Q + 64 * l, 1u, __ATOMIC_RELAXED, __HIP_MEMORY_SCOPE_AGENT);
            __syncthreads();
            const int q = __builtin_amdgcn_readfirstlane((int)MISC[8]);
            __syncthreads();
            if (q >= nunits) break;
            if (q < 16) { dn_scan_job(A, q, pwave, plane); asm volatile("s_waitcnt vmcnt(0)" ::: "memory"); __syncthreads(); continue; }
            bf16* PATT = (bf16*)(ws + WS_PATT); bf16* ODA = (bf16*)(ws + WS_A + A_ODA);
            int u = q - 16, combo, qt, NT;
            if (u < 1536) { combo = u >> 4; qt = 1 + (u & 15); NT = 68; } else { combo = u - 1536; qt = 0; NT = 4; }
            const attn_body::bf16 *Qp, *Kp, *Vp; attn_body::bf16* Op; int PO;
            if (combo < 64) { const int b = combo >> 4, vh = combo & 15, hh = vh >> 1, vhalf = vh & 1, h = vh >> 2;
                const size_t r0 = (size_t)b * TPB; const size_t rq = r0 + (size_t)qt * 256;
                Qp = (const attn_body::bf16*)(PATT + rq * PATT_LD + C_DAQ + hh * 64); Kp = (const attn_body::bf16*)(PATT + r0 * PATT_LD + C_DAK + hh * 64);
                Vp = (const attn_body::bf16*)(PATT + r0 * PATT_LD + C_DAV + h * 128 + vhalf * 64); Op = (attn_body::bf16*)(ODA + rq * 1024 + hh * 128 + vhalf * 64); PO = 1024; }
            else { const int cc = combo - 64, b = cc >> 3, hq = cc & 7, kvh = hq >> 2;
                const size_t r0 = (size_t)b * TPB; const size_t rq = r0 + (size_t)qt * 256;
                Qp = (const attn_body::bf16*)(PATT + rq * PATT_LD + C_GQQ + hq * 64); Kp = (const attn_body::bf16*)(PATT + r0 * PATT_LD + C_GQK + kvh * 64);
                Vp = (const attn_body::bf16*)(PATT + r0 * PATT_LD + C_GQV + kvh * 64); Op = (attn_body::bf16*)(PATT + rq * PATT_LD + C_GQQ + hq * 64); PO = PATT_LD; }
            attn_body::attn_unit<8>(Qp, Kp, Vp, Op, PATT_LD, PATT_LD, PATT_LD, PO, NT, (char*)lds_raw);
          } }
        GRID_BAR();
        { ARGS_HERE(A); PHASE_IDS();
          const float lam_init = 0.8f - 0.6f * expf(-0.3f * (float)l);
          const float* lp = A->in[10] + l * 256;
          const float s01 = wave_sum(lp[plane] * lp[64 + plane]), s23 = wave_sum(lp[128 + plane] * lp[192 + plane]);
          const float lam = expf(s01) - expf(s23) + lam_init;
          for (int row = pgw; row < MROWS; row += NGW) post2_row(A, l, row, plane, lam, 1.f - lam_init); }
        GRID_BAR();
        { ARGS_HERE(A); PHASE_IDS(); unsigned char* ws = A->ws;
          pg8::Gemm g{(bf16*)(ws + WS_HN), (bf16*)(ws + WS_WT) + WT_IN + (size_t)4608 * 1024, MROWS, 3072, 1024, 1024}; pg8::StaticOrder S; S.init(MROWS, 3072, G, bid);
          EpiGate E{(bf16*)(ws + WS_A), 3072, nullptr, nullptr, 0, 0, nullptr, nullptr, nullptr};
          pg8::gemm_phase<EpiGate, pg8::StaticOrder, true, true>(lds, g, S, E); }
        GRID_BAR();
        { pg8::StaticOrder S; S.init(MROWS, 1024, G, bid);
          { ARGS_HERE(A); PHASE_IDS(); unsigned char* ws = A->ws;
            pg8::Gemm g{(bf16*)((unsigned char*)A->out + DO_OA), (bf16*)(ws + WS_WT) + WT_BRA, MROWS, 1024, 512, 512};
            pg8::Epi<3, 0> E{nullptr, 0, nullptr, (bf16*)(ws + WS_A), 3072, 0, (float*)(ws + WS_A + A_MRGF), nullptr, nullptr};
            pg8::gemm_phase<pg8::Epi<3, 0>, pg8::StaticOrder, true, true>(lds, g, S, E); }
          { ARGS_HERE(A); PHASE_IDS(); unsigned char* ws = A->ws;
            pg8::Gemm g{(bf16*)(ws + WS_PATT) + C_GQQ, (bf16*)(ws + WS_WT) + WT_BRB, MROWS, 1024, 512, PATT_LD};
            pg8::Epi<3, 1> E{nullptr, 0, nullptr, (bf16*)(ws + WS_A), 3072, 1024, (float*)(ws + WS_A + A_MRGF), nullptr, nullptr};
            pg8::gemm_phase<pg8::Epi<3, 1>, pg8::StaticOrder, true, true>(lds, g, S, E); }
          { ARGS_HERE(A); PHASE_IDS(); unsigned char* ws = A->ws;
            pg8::Gemm g{(bf16*)(ws + WS_OC), (bf16*)(ws + WS_WT) + WT_BRC, MROWS, 1024, 512, 512};
            pg8::Epi<3, 2> E{(bf16*)A->out, 1024, nullptr, (bf16*)(ws + WS_A), 3072, 2048, (float*)(ws + WS_A + A_MRGF), nullptr, nullptr};
            pg8::gemm_phase<pg8::Epi<3, 2>, pg8::StaticOrder, true, true>(lds, g, S, E); } }
        GRID_BAR();
        { ARGS_HERE(A); PHASE_IDS(); unsigned char* ws = A->ws;
          pg8::Gemm g{(bf16*)A->out, (bf16*)(ws + WS_WT) + WT_O, MROWS, 1024, 1024, 1024}; pg8::StaticOrder S; S.init(MROWS, 1024, G, bid);
          pg8::Epi<4, 0> E{nullptr, 0, nullptr, nullptr, 0, 0, (float*)(ws + WS_XS), (const float*)(ws + WS_MOD) + (size_t)l * 5 * 6144 + 2 * 1024, nullptr};
          pg8::gemm_phase<pg8::Epi<4, 0>, pg8::StaticOrder, true, true>(lds, g, S, E); }
        GRID_BAR();
        { ARGS_HERE(A); PHASE_IDS(); phase_norm(A, l, 1, pgw, NGW, plane); }
        GRID_BAR();
        { ARGS_HERE(A); PHASE_IDS(); unsigned char* ws = A->ws;
          pg8::Gemm g{(bf16*)(ws + WS_HN), (bf16*)(ws + WS_WT) + WT_1, MROWS, 5632, 1024, 1024}; pg8::StaticOrder S; S.init(MROWS, 5632, G, bid);
          EpiSt E{(bf16*)(ws + WS_A), AU_LD, nullptr, nullptr, 0, 0, nullptr, nullptr, nullptr};
          pg8::gemm_phase<EpiSt, pg8::StaticOrder, true, true>(lds, g, S, E); }
        GRID_BAR();
        { ARGS_HERE(A); PHASE_IDS(); phase_act(A, l, bid * NTHR + ptid, G * NTHR); }
        GRID_BAR();
        { ARGS_HERE(A); PHASE_IDS(); unsigned char* ws = A->ws;
          pg8::Gemm g{(bf16*)(ws + WS_A) + DFF, (bf16*)(ws + WS_WT) + WT_2, MROWS, 1024, 2816, AU_LD}; pg8::StaticOrder S; S.init(MROWS, 1024, G, bid);
          const float* mp = (const float*)(ws + WS_MOD) + (size_t)l * 5 * 6144 + 5 * 1024;
          if (l < NLAYER - 1) { pg8::Epi<4, 0> E{nullptr, 0, nullptr, nullptr, 0, 0, (float*)(ws + WS_XS), mp, nullptr};
            pg8::gemm_phase<pg8::Epi<4, 0>, pg8::StaticOrder, true, true>(lds, g, S, E); }
          else { pg8::Epi<4, 1> E{nullptr, 0, nullptr, nullptr, 0, 0, (float*)(ws + WS_XS), mp, A->out};
            pg8::gemm_phase<pg8::Epi<4, 1>, pg8::StaticOrder, true, true>(lds, g, S, E); } }
        if (l < NLAYER - 1) GRID_BAR();
    }
}

extern "C" void kernel_launch(void* const* d_in, const int* in_sizes, int n_in, void* d_out, int out_size, void* d_ws, size_t ws_size, hipStream_t stream) {
    static int grid = 0;
    if (grid == 0) {
        if (n_in != 27 || out_size != 4 * 4096 * 1024 || ws_size < WS_END) { fprintf(stderr, "kernel_launch: unexpected shapes (n_in %d out %d ws %zu need %zu)\n", n_in, out_size, ws_size, (size_t)WS_END); grid = -1; return; }
        int dev = 0, cus = 0, per_cu = 0;
        hipGetDevice(&dev); hipDeviceGetAttribute(&cus, hipDeviceAttributeMultiprocessorCount, dev);
        if (hipFuncSetAttribute((const void*)mk_fwd, hipFuncAttributeMaxDynamicSharedMemorySize, LDS_BYTES) != hipSuccess) { fprintf(stderr, "kernel_launch: hipFuncSetAttribute failed\n"); grid = -1; return; }
        if (hipOccupancyMaxActiveBlocksPerMultiprocessor(&per_cu, (const void*)mk_fwd, NTHR, LDS_BYTES) != hipSuccess || per_cu < 1) { fprintf(stderr, "kernel_launch: occupancy query says %d\n", per_cu); per_cu = 1; }
        (void)hipGetLastError();
        grid = cus;
    }
    if (grid < 0) return;
    hipMemsetAsync((char*)d_ws + WS_CTL, 0, CTL_ZERO_BYTES, stream);
    Args a{};
    for (int i = 0; i < 27; ++i) a.in[i] = (const float*)d_in[i];
    a.out = (float*)d_out; a.ws = (unsigned char*)d_ws;
    void* kargs[] = {&a};
    hipError_t e = hipLaunchCooperativeKernel((const void*)mk_fwd, dim3(grid), dim3(NTHR), kargs, LDS_BYTES, stream);
    if (e != hipSuccess) fprintf(stderr, "kernel_launch: cooperative launch failed: %s (grid %d)\n", hipGetErrorString(e), grid);
}
```

```cpp
#include <hip/hip_runtime.h>
#include <hip/hip_cooperative_groups.h>
#include <hip/hip_bf16.h>
#include <cstdio>
#include <cstdint>
#include <cmath>
namespace cg = cooperative_groups;
namespace pg8 {
#define PG8_LAS __attribute__((address_space(3)))
typedef unsigned short bf16_t;
typedef short bf16x8 __attribute__((ext_vector_type(8)));
typedef float f32x4 __attribute__((ext_vector_type(4)));
typedef unsigned u32x4 __attribute__((ext_vector_type(4)));
constexpr int BM = 256, BK = 64, HALF = 128, HTB = HALF * BK * 2  , STAGE_BYTES = 8 * HTB, NXCD = 8, WGM = 8;

__host__ __device__ __forceinline__ int lds_byte(int r, int c) { const int st = (r >> 4) * 2 + (c >> 5), rr = r & 15, cc = c & 31, ob = rr * 64 + cc * 2; return st * 1024 + (ob ^ (((ob >> 9) & 1) << 5)); }
__host__ __device__ __forceinline__ void stage_rc(int b, int& R, int& C) { const int st = b / 1024, sb = b % 1024, swz = sb ^ (((sb >> 9) & 1) << 5); R = (st >> 1) * 16 + swz / 64; C = (st & 1) * 32 + (swz % 64) / 2; }
__host__ __device__ __forceinline__ int perm32(int rho) { const int n = rho >> 4, i = rho & 15; return 8 * (i >> 2) + 4 * n + (i & 3); }

struct Unit { int pm, pn; };
struct Gemm { const bf16_t* A; const bf16_t* Bt; int M, N, K, lda, ldb; };
struct OneUnit { Unit u; int has; __device__ __forceinline__ bool next(int i, Unit& o) const { if (i != 0 || !has) return false; o = u; return true; } __device__ __forceinline__ void a_ready(const Unit&) const {} __device__ __forceinline__ void done(const Unit&) const {} };

struct StaticOrder {
    int nM, nN, nwg, G, c, lat;
    __host__ __device__ void init(int M, int N, int G_, int c_, int lat_ = 0) { nM = M / BM; nN = N / BM; nwg = nM * nN; G = G_; c = c_; lat = lat_; }
    __host__ __device__ bool next(int i, Unit& u) const {
        const long L = (long)i * G + c; if (L >= nwg) return false;
        int wgid = (int)L; { const int q = nwg / NXCD, r = nwg % NXCD, xcd = wgid % NXCD, off = wgid / NXCD; wgid = (xcd < r ? xcd * (q + 1) : r * (q + 1) + (xcd - r) * q) + off; }
        const int nig = WGM * nN, gid = wgid / nig, fm = gid * WGM, gsz = (nM - fm) < WGM ? (nM - fm) : WGM;
        u.pm = fm + ((wgid % nig) % gsz); u.pn = (wgid % nig) / gsz; if (lat == 1) u.pm += u.pm / 16 + 1; else if (lat == 2) u.pm *= 17; return true;
    }
    __device__ __forceinline__ void a_ready(const Unit&) const {}
    __device__ __forceinline__ void done(const Unit&) const {}
};
struct ChainOrder { StaticOrder so; __device__ __forceinline__ bool next(int i, Unit& u) const { Unit t; if (!so.next(i / 3, t)) return false; const int sel = i - (i / 3) * 3; u.pm = t.pm + sel * 68; u.pn = t.pn + sel * 4; return true; } __device__ __forceinline__ void a_ready(const Unit&) const {} __device__ __forceinline__ void done(const Unit&) const {} };
__device__ __forceinline__ unsigned pkbf(float lo, float hi) { typedef float f2_t __attribute__((ext_vector_type(2))); typedef __bf16 b2_t __attribute__((ext_vector_type(2))); f2_t v = {lo, hi}; b2_t b = __builtin_convertvector(v, b2_t); return __builtin_bit_cast(unsigned, b); }
__device__ __forceinline__ float bflo(unsigned w) { return __uint_as_float(w << 16); }
__device__ __forceinline__ float bfhi(unsigned w) { return __uint_as_float(w & 0xffff0000u); }
__device__ __forceinline__ float dpp_ror1(float v) { return __builtin_bit_cast(float, __builtin_amdgcn_update_dpp(0, __builtin_bit_cast(int, v), 0x121, 0xf, 0xf, false)); }
__device__ __forceinline__ float dpp_ror15(float v) { return __builtin_bit_cast(float, __builtin_amdgcn_update_dpp(0, __builtin_bit_cast(int, v), 0x12F, 0xf, 0xf, false)); }
__device__ __forceinline__ float sigm(float x) { return __builtin_amdgcn_rcpf(1.0f + __expf(-x)); }
template <int MODE, int SUB> struct Epi {
    static constexpr bool PERM = true, AFTER_DRAIN = false;
    bf16_t* O; int ldc; bf16_t* O1; const bf16_t* G; int ldg; int gcol; float* F; const float* mod; float* OUT;
    __device__ __forceinline__ void operator()(const f32x4 (&acc)[2][2][4][2], const Unit& u, int wr, int wc, int fr, int fq) const {
        const int rl0 = wr * 64 + fr;
        const int rt = u.pm * BM + rl0;
        const int ct = u.pn * BM + wc * 32 + 8 * fq;
        if constexpr (MODE == 0 || MODE == 1 || MODE == 2) {
            bf16_t* base = O; int ld = ldc; int c0 = ct;
            if constexpr (MODE == 1) { if (u.pn >= 11) { base = O1; ld = 1792; c0 = ct - 2816; } else { ld = 2816; } }
#pragma unroll
            for (int ai = 0; ai < 2; ++ai)
#pragma unroll
                for (int m = 0; m < 4; ++m) { bf16_t* rowp = base + (size_t)(rt + ai * HALF + m * 16) * ld + c0;
#pragma unroll
                    for (int bj = 0; bj < 2; ++bj) { f32x4 v0 = acc[ai][bj][m][0], v1 = acc[ai][bj][m][1];
                        if constexpr (MODE == 2) { v0 = (f32x4){sigm(v0[0]), sigm(v0[1]), sigm(v0[2]), sigm(v0[3])}; v1 = (f32x4){sigm(v1[0]), sigm(v1[1]), sigm(v1[2]), sigm(v1[3])}; }
                        u32x4 w; w.x = pkbf(v0[0], v0[1]); w.y = pkbf(v0[2], v0[3]); w.z = pkbf(v1[0], v1[1]); w.w = pkbf(v1[2], v1[3]);
                        *(u32x4*)(rowp + bj * HALF) = w; } }
        } else if constexpr (MODE == 3) {
            int step = SUB, rtr = rt, ctr = ct, gc = gcol;
            if constexpr (SUB == 4) { step = u.pm / 68; rtr = (u.pm - step * 68) * BM + rl0; ctr = (u.pn & 3) * BM + wc * 32 + 8 * fq; gc = step * 1024; }
#pragma unroll
            for (int ai = 0; ai < 2; ++ai)
#pragma unroll
                for (int m = 0; m < 4; ++m) { const size_t row = (size_t)(rtr + ai * HALF + m * 16);
#pragma unroll
                    for (int bj = 0; bj < 2; ++bj) { const int col = ctr + bj * HALF;
                        const u32x4 gw = *(const u32x4*)(G + row * ldg + gc + col);
                        f32x4 v0 = acc[ai][bj][m][0], v1 = acc[ai][bj][m][1];
                        v0 = v0 * (f32x4){bflo(gw.x), bfhi(gw.x), bflo(gw.y), bfhi(gw.y)}; v1 = v1 * (f32x4){bflo(gw.z), bfhi(gw.z), bflo(gw.w), bfhi(gw.w)};
                        bf16_t* op = O + row * ldc + col;
                        if (step != 0) { const u32x4 pw = *(const u32x4*)op;
                            v0 = v0 + (f32x4){bflo(pw.x), bfhi(pw.x), bflo(pw.y), bfhi(pw.y)}; v1 = v1 + (f32x4){bflo(pw.z), bfhi(pw.z), bflo(pw.w), bfhi(pw.w)}; }
                        u32x4 w; w.x = pkbf(v0[0], v0[1]); w.y = pkbf(v0[2], v0[3]); w.z = pkbf(v1[0], v1[1]); w.w = pkbf(v1[2], v1[3]); *(u32x4*)op = w; } }
        } else if constexpr (MODE == 5) {
            const int j0 = u.pn * 128 + wc * 32 + 8 * fq;
            float w0[8], w1[8], w2[8], bb[8];
            { const f32x4 t0 = *(const f32x4*)(mod + j0), t1 = *(const f32x4*)(mod + j0 + 4), t2 = *(const f32x4*)(mod + 2816 + j0), t3 = *(const f32x4*)(mod + 2816 + j0 + 4),
                          t4 = *(const f32x4*)(mod + 5632 + j0), t5 = *(const f32x4*)(mod + 5632 + j0 + 4), t6 = *(const f32x4*)(OUT + j0), t7 = *(const f32x4*)(OUT + j0 + 4);
#pragma unroll
              for (int k = 0; k < 4; ++k) { w0[k] = t0[k]; w0[k + 4] = t1[k]; w1[k] = t2[k]; w1[k + 4] = t3[k]; w2[k] = t4[k]; w2[k + 4] = t5[k]; bb[k] = t6[k]; bb[k + 4] = t7[k]; } }
#pragma unroll
            for (int ai = 0; ai < 2; ++ai)
#pragma unroll
                for (int m = 0; m < 4; ++m) { const size_t row = (size_t)(rt + ai * HALF + m * 16);
                    float av[8], uv[8], pv[8], nv[8];
#pragma unroll
                    for (int k = 0; k < 8; ++k) { av[k] = acc[ai][0][m][k >> 2][k & 3]; uv[k] = acc[ai][1][m][k >> 2][k & 3];
                        const float ps = dpp_ror1(av[k]), ns = dpp_ror15(av[k]);
                        const float pc = (m > 0) ? dpp_ror1(acc[ai][0][(m > 0) ? m - 1 : 0][k >> 2][k & 3]) : 0.f;
                        const float nc = (m < 3) ? dpp_ror15(acc[ai][0][(m < 3) ? m + 1 : 3][k >> 2][k & 3]) : 0.f;
                        pv[k] = (fr == 0) ? pc : ps; nv[k] = (fr == 15) ? nc : ns; }
                    const bool top = (m == 0 && fr == 0), bot = (m == 3 && fr == 15);
                    if (!top && !bot) { float o[8];
#pragma unroll
                        for (int k = 0; k < 8; ++k) { const float pre = w0[k] * pv[k] + w1[k] * av[k] + w2[k] * nv[k] + bb[k]; o[k] = pre * __builtin_amdgcn_rcpf(1.f + __expf(-pre)) * uv[k]; }
                        u32x4 w; w.x = pkbf(o[0], o[1]); w.y = pkbf(o[2], o[3]); w.z = pkbf(o[4], o[5]); w.w = pkbf(o[6], o[7]); *(u32x4*)(O + row * ldc + j0) = w; }
                    else { const size_t eo = (size_t)((row >> 6) * 2 + (bot ? 1 : 0)) * 2816 + j0; float pp[8];
#pragma unroll
                        for (int k = 0; k < 8; ++k) pp[k] = w1[k] * av[k] + bb[k] + (top ? w2[k] * nv[k] : w0[k] * pv[k]);
                        *(f32x4*)(F + eo) = (f32x4){pp[0], pp[1], pp[2], pp[3]}; *(f32x4*)(F + eo + 4) = (f32x4){pp[4], pp[5], pp[6], pp[7]};
                        u32x4 wa, wu; wa.x = pkbf(av[0], av[1]); wa.y = pkbf(av[2], av[3]); wa.z = pkbf(av[4], av[5]); wa.w = pkbf(av[6], av[7]);
                        wu.x = pkbf(uv[0], uv[1]); wu.y = pkbf(uv[2], uv[3]); wu.z = pkbf(uv[4], uv[5]); wu.w = pkbf(uv[6], uv[7]);
                        *(u32x4*)(O1 + eo) = wa; *(u32x4*)((bf16_t*)G + eo) = wu; } }
        } else {
            const int b = u.pm / 17, ti = u.pm % 17, msel = (ti == 0) ? 4 : b;
            const float* mp = mod + msel * 6144 + ct;
            f32x4 mv[2][2];
#pragma unroll
            for (int bj = 0; bj < 2; ++bj)
#pragma unroll
                for (int n = 0; n < 2; ++n) mv[bj][n] = *(const f32x4*)(mp + bj * HALF + 4 * n);
#pragma unroll
            for (int ai = 0; ai < 2; ++ai)
#pragma unroll
                for (int m = 0; m < 4; ++m) { const int rl = rl0 + ai * HALF + m * 16; const size_t row = (size_t)(u.pm * BM + rl);
#pragma unroll
                    for (int bj = 0; bj < 2; ++bj) { const int col = ct + bj * HALF; float* xp = F + row * 1024 + col;
                        f32x4 r0 = mv[bj][0] * acc[ai][bj][m][0], r1 = mv[bj][1] * acc[ai][bj][m][1];
                        if constexpr (SUB != 2) { r0 = r0 + *(const f32x4*)xp; r1 = r1 + *(const f32x4*)(xp + 4); }
                        if constexpr (SUB == 0) { *(f32x4*)xp = r0; *(f32x4*)(xp + 4) = r1; }
                        else if constexpr (SUB == 2) { const f32x4 d0 = mv[bj][0] * acc[ai][bj][m][0], d1 = mv[bj][1] * acc[ai][bj][m][1];
                            unsafeAtomicAdd(xp + 0, d0[0]); unsafeAtomicAdd(xp + 1, d0[1]); unsafeAtomicAdd(xp + 2, d0[2]); unsafeAtomicAdd(xp + 3, d0[3]); unsafeAtomicAdd(xp + 4, d1[0]); unsafeAtomicAdd(xp + 5, d1[1]); unsafeAtomicAdd(xp + 6, d1[2]); unsafeAtomicAdd(xp + 7, d1[3]); }
                        else { if (ti != 0) { float* op = OUT + ((size_t)b * 4096 + (size_t)(ti - 1) * 256 + rl) * 1024 + col; *(f32x4*)op = r0; *(f32x4*)(op + 4) = r1; } } } }
        }
    }
};
template <class Epi, class Sched, bool ALIGN_EPI = false, bool SP2 = false>
__device__ __forceinline__ void gemm_phase(PG8_LAS unsigned char* lds, const Gemm g, const Sched& S, const Epi& E) {
    int tid = threadIdx.x; asm volatile("" : "+v"(tid)); const int wid = __builtin_amdgcn_readfirstlane(tid >> 6), lane = tid & 63, wr = wid >> 2, wc = wid & 3, fr = lane & 15, fq = lane >> 4;
    const int K = g.K, nt = K / BK;
    unsigned voffA[2], voffB[2];
#pragma unroll
    for (int i = 0; i < 2; ++i) { int R, C; stage_rc(tid * 16 + i * 8192, R, C); const int Rb = Epi::PERM ? ((R & ~31) + perm32(R & 31)) : R;
        voffA[i] = (unsigned)(R * g.lda + C) * 2u; voffB[i] = (unsigned)(Rb * (g.ldb ? g.ldb : K) + C) * 2u; }
    const size_t kstep = (size_t)(BK * 2);
    const size_t hstepA = (size_t)HALF * g.lda * 2, hstepB = (size_t)HALF * (g.ldb ? g.ldb : K) * 2;
    const size_t tstepA = 2 * hstepA, tstepB = 2 * hstepB;
    const unsigned ldsw = (unsigned)wid * 1024u;
    const int aoff = lds_byte(wr * 64 + fr, fq * 8), boff = lds_byte(wc * 32 + fr, fq * 8);
#define PG8_SA(b, h) (((b) * 2 + (h)) * HTB)
#define PG8_SB(b, h) ((4 + (b) * 2 + (h)) * HTB)
#define PG8_STAGE(bufoff, gbase, voff) do { _Pragma("unroll") for (int _i = 0; _i < 2; ++_i) \
        __builtin_amdgcn_global_load_lds((const unsigned*)((const char*)(gbase) + (voff)[_i]), (PG8_LAS unsigned*)(lds + (bufoff) + ldsw + _i * 8192), 16, 0, 0); } while (0)
#define PG8_LDA(dst, b, h) do { _Pragma("unroll") for (int m = 0; m < 4; ++m) _Pragma("unroll") for (int k = 0; k < 2; ++k) dst[m][k] = *(const PG8_LAS bf16x8*)(lds + PG8_SA(b, h) + aoff + m * 2048 + k * 1024); } while (0)
#define PG8_LDB(dst, b, h) do { _Pragma("unroll") for (int n = 0; n < 2; ++n) _Pragma("unroll") for (int k = 0; k < 2; ++k) dst[n][k] = *(const PG8_LAS bf16x8*)(lds + PG8_SB(b, h) + boff + n * 2048 + k * 1024); } while (0)
#define PG8_MMA(ai, bj, At, Bt) do { __builtin_amdgcn_s_setprio(1); _Pragma("unroll") for (int m = 0; m < 4; ++m) _Pragma("unroll") for (int n = 0; n < 2; ++n) _Pragma("unroll") for (int k = 0; k < 2; ++k) \
        acc[ai][bj][m][n] = __builtin_amdgcn_mfma_f32_16x16x32_bf16(Bt[n][k], At[m][k], acc[ai][bj][m][n], 0, 0, 0); __builtin_amdgcn_s_setprio(0); } while (0)
#define PG8_WAIT_V(n) asm volatile("s_waitcnt vmcnt(" #n ")" ::: "memory")
#define PG8_WAIT_L(n) asm volatile("s_waitcnt lgkmcnt(" #n ")" ::: "memory")
#define PG8_BAR __builtin_amdgcn_s_barrier()
#define PG8_SCHED __builtin_amdgcn_sched_barrier(0)
    Unit cur, nxt; int ui = 0;
    if (!S.next(0, cur)) return;
    f32x4 acc[2][2][4][2];
#pragma unroll
    for (int a = 0; a < 2; ++a)
#pragma unroll
        for (int b = 0; b < 2; ++b)
#pragma unroll
            for (int m = 0; m < 4; ++m)
#pragma unroll
                for (int n = 0; n < 2; ++n) acc[a][b][m][n] = (f32x4){0.f, 0.f, 0.f, 0.f};
    bf16x8 At[4][2], B0[2][2], B1[2][2];
    const char* cA = (const char*)g.A + (size_t)cur.pm * tstepA; const char* cB = (const char*)g.Bt + (size_t)cur.pn * tstepB;
    S.a_ready(cur);
    if constexpr (SP2) {
        PG8_STAGE(PG8_SB(0, 0), cB, voffB); PG8_STAGE(PG8_SB(0, 1), cB + hstepB, voffB); PG8_STAGE(PG8_SA(0, 0), cA, voffA); PG8_STAGE(PG8_SA(0, 1), cA + hstepA, voffA);
        if (wr == 1) PG8_BAR;
        PG8_WAIT_V(2); PG8_BAR;
        PG8_STAGE(PG8_SB(1, 0), cB + kstep, voffB); PG8_STAGE(PG8_SA(1, 0), cA + kstep, voffA); PG8_STAGE(PG8_SB(1, 1), cB + hstepB + kstep, voffB);
        PG8_WAIT_V(6); PG8_BAR;
    } else {
        PG8_STAGE(PG8_SB(0, 0), cB, voffB); PG8_STAGE(PG8_SA(0, 0), cA, voffA); PG8_STAGE(PG8_SB(0, 1), cB + hstepB, voffB); PG8_STAGE(PG8_SA(0, 1), cA + hstepA, voffA);
        if (wr == 1) PG8_BAR;
        PG8_WAIT_V(4); PG8_BAR;
        PG8_STAGE(PG8_SB(1, 0), cB + kstep, voffB); PG8_STAGE(PG8_SA(1, 0), cA + kstep, voffA); PG8_STAGE(PG8_SB(1, 1), cB + hstepB + kstep, voffB);
        PG8_WAIT_V(6); PG8_BAR;
    }
    for (;;) {
        const bool has_next = S.next(ui + 1, nxt);
        const char* nA = has_next ? (const char*)g.A + (size_t)nxt.pm * tstepA : cA; const char* nB = has_next ? (const char*)g.Bt + (size_t)nxt.pn * tstepB : cB;
        for (int t = 0; t < nt; t += 2) {
            const bool last = (t == nt - 2);
            const char* a1 = cA + (size_t)(t + 1) * kstep;
            const char* a2 = last ? nA : cA + (size_t)(t + 2) * kstep; const char* b2 = last ? nB : cB + (size_t)(t + 2) * kstep;
            const char* a3 = a2 + kstep; const char* b3 = b2 + kstep;
            if (last && has_next) S.a_ready(nxt);
            if constexpr (SP2) {
            PG8_LDB(B0, 0, 0); PG8_LDB(B1, 0, 1); PG8_SCHED; PG8_LDA(At, 0, 0); PG8_STAGE(PG8_SA(1, 1), a1 + hstepA, voffA);
            PG8_WAIT_V(8); PG8_WAIT_L(0); PG8_BAR; PG8_MMA(0, 0, At, B0); PG8_MMA(0, 1, At, B1); PG8_BAR; PG8_SCHED;
            PG8_LDA(At, 0, 1); PG8_STAGE(PG8_SB(0, 0), b2, voffB); PG8_STAGE(PG8_SB(0, 1), b2 + hstepB, voffB); PG8_STAGE(PG8_SA(0, 0), a2, voffA);
            PG8_WAIT_V(8); PG8_WAIT_L(0); PG8_BAR; PG8_MMA(1, 0, At, B0); PG8_MMA(1, 1, At, B1); PG8_BAR; PG8_SCHED;
            PG8_LDB(B0, 1, 0); PG8_LDB(B1, 1, 1); PG8_SCHED; PG8_LDA(At, 1, 0); PG8_STAGE(PG8_SA(0, 1), a2 + hstepA, voffA);
            PG8_WAIT_V(8); PG8_WAIT_L(0); PG8_BAR; PG8_MMA(0, 0, At, B0); PG8_MMA(0, 1, At, B1); PG8_BAR; PG8_SCHED;
            PG8_LDA(At, 1, 1); PG8_STAGE(PG8_SB(1, 0), b3, voffB); PG8_STAGE(PG8_SB(1, 1), b3 + hstepB, voffB); PG8_STAGE(PG8_SA(1, 0), a3, voffA);
            PG8_WAIT_V(8); PG8_WAIT_L(0); PG8_BAR; PG8_MMA(1, 0, At, B0); PG8_MMA(1, 1, At, B1); PG8_BAR; PG8_SCHED;
            } else {
            PG8_LDB(B0, 0, 0); PG8_SCHED; PG8_LDA(At, 0, 0); PG8_STAGE(PG8_SA(1, 1), a1 + hstepA, voffA);
            PG8_WAIT_L(8); PG8_BAR; PG8_WAIT_L(0); PG8_MMA(0, 0, At, B0); PG8_BAR; PG8_SCHED;
            PG8_LDB(B1, 0, 1); PG8_STAGE(PG8_SB(0, 0), b2, voffB);
            PG8_BAR; PG8_WAIT_L(0); PG8_MMA(0, 1, At, B1); PG8_BAR;
            PG8_LDA(At, 0, 1); PG8_STAGE(PG8_SA(0, 0), a2, voffA);
            PG8_BAR; PG8_WAIT_L(0); PG8_MMA(1, 0, At, B0); PG8_BAR; PG8_SCHED;
            PG8_STAGE(PG8_SB(0, 1), b2 + hstepB, voffB);
            PG8_WAIT_V(6); PG8_BAR; PG8_MMA(1, 1, At, B1); PG8_BAR;
            PG8_LDB(B0, 1, 0); PG8_SCHED; PG8_LDA(At, 1, 0); PG8_STAGE(PG8_SA(0, 1), a2 + hstepA, voffA);
            PG8_WAIT_L(8); PG8_BAR; PG8_WAIT_L(0); PG8_MMA(0, 0, At, B0); PG8_BAR; PG8_SCHED;
            PG8_LDB(B1, 1, 1); PG8_STAGE(PG8_SB(1, 0), b3, voffB);
            PG8_BAR; PG8_WAIT_L(0); PG8_MMA(0, 1, At, B1); PG8_BAR;
            PG8_LDA(At, 1, 1); PG8_STAGE(PG8_SA(1, 0), a3, voffA);
            PG8_BAR; PG8_WAIT_L(0); PG8_MMA(1, 0, At, B0); PG8_BAR; PG8_SCHED;
            PG8_STAGE(PG8_SB(1, 1), b3 + hstepB, voffB);
            PG8_WAIT_V(6); PG8_BAR; PG8_MMA(1, 1, At, B1); PG8_BAR;
            }
        }
        if constexpr (ALIGN_EPI) { if (wr == 0) PG8_BAR; }
        if constexpr (!Epi::AFTER_DRAIN) { E(acc, cur, wr, wc, fr, fq); S.done(cur); }
        if (!has_next) break;
#pragma unroll
        for (int a = 0; a < 2; ++a)
#pragma unroll
            for (int b = 0; b < 2; ++b)
#pragma unroll
                for (int m = 0; m < 4; ++m)
#pragma unroll
                    for (int n = 0; n < 2; ++n) acc[a][b][m][n] = (f32x4){0.f, 0.f, 0.f, 0.f};
        cur = nxt; cA = nA; cB = nB; ++ui;
        if constexpr (ALIGN_EPI) { if (wr == 1) PG8_BAR; }
    }
    PG8_WAIT_V(0);
    if constexpr (!ALIGN_EPI) { if (wr == 0) PG8_BAR; }
    PG8_BAR;
    if constexpr (Epi::AFTER_DRAIN) { E.fused(acc, cur, wr, wc, fr, fq, lds, wid, lane); S.done(cur); }
#undef PG8_SA
#undef PG8_SB
#undef PG8_STAGE
#undef PG8_LDA
#undef PG8_LDB
#undef PG8_MMA
#undef PG8_WAIT_V
#undef PG8_WAIT_L
#undef PG8_BAR
#undef PG8_SCHED
}
}
#include <hip/hip_bf16.h>
#include <cmath>
namespace attn_body {
using bf16=__hip_bfloat16;
using bf16x8=__attribute__((ext_vector_type(8)))short;
using s16x4=__attribute__((ext_vector_type(4)))short;
using f32x16=__attribute__((ext_vector_type(16)))float;
using u32x4=__attribute__((ext_vector_type(4)))unsigned;
constexpr int D=64;
constexpr int NW=8,QBLK=32,QB=QBLK*NW,KVBLK=64;
constexpr int ATTN_UNIT_ROWS=QB;
__device__ __forceinline__ int crow(int r,int hi){return (r&3)+8*(r>>2)+4*hi;}
#define SBAR() __builtin_amdgcn_sched_barrier(0)
__device__ __forceinline__ void cmask(f32x16&p0,f32x16&p1,int jb,int qrel,int hi){
  const float NEG=-INFINITY; int kb=64*jb+4*hi;
  #pragma unroll
  for(int r=0;r<16;++r){int kv=kb+(r&3)+8*(r>>2); if(kv>qrel)p0[r]=NEG; if(kv+32>qrel)p1[r]=NEG;}
}

constexpr int NSLOT=3, SLOTB=8192;
constexpr int LDS_K=0, LDS_V=NSLOT*SLOTB, LDS_WS=2*NSLOT*SLOTB, LDS_OST=LDS_WS+NW*64*4, LDS_BYTES=LDS_OST+NW*4096;
constexpr float C2=0.125f*1.4426950408889634f;
__device__ __forceinline__ void glds16(const void*gsrc,unsigned lds_dst){unsigned keep;
  asm volatile("s_mov_b32 %0, m0\n\ts_mov_b32 m0, %2\n\ts_nop 0\n\tglobal_load_lds_dwordx4 %1, off\n\ts_mov_b32 m0, %0":"=&s"(keep):"v"(gsrc),"s"(lds_dst):"memory");}
__device__ __forceinline__ float max3f(float a,float b,float c){float r;asm("v_max3_f32 %0, %1, %2, %3":"=v"(r):"v"(a),"v"(b),"v"(c));return r;}
__device__ __forceinline__ float max2f(float a,float b){float r;asm("v_max_f32_e32 %0, %1, %2":"=v"(r):"v"(a),"v"(b));return r;}
__device__ __forceinline__ float fadd_s(float a,float b){float r;asm("v_add_f32_e32 %0, %1, %2":"=v"(r):"v"(a),"v"(b));return r;}
__device__ __forceinline__ float fsub_s(float a,float b){float r;asm("v_sub_f32_e32 %0, %1, %2":"=v"(r):"v"(a),"v"(b));return r;}
typedef float f32x2_t __attribute__((ext_vector_type(2))); typedef __bf16 bf16x2_t __attribute__((ext_vector_type(2)));
__device__ __forceinline__ unsigned cvtpk_s(float lo,float hi){f32x2_t v={lo,hi};bf16x2_t b=__builtin_convertvector(v,bf16x2_t);return __builtin_bit_cast(unsigned,b);}
#define WAIT_BAR(N) asm volatile("s_waitcnt vmcnt(" #N ") lgkmcnt(0)\n\ts_barrier":::"memory")

__device__ __forceinline__ void qkt(f32x16&p0,f32x16&p1,const char*Kslot,const bf16x8*qr,const f32x16&negm,int r32,int hi){
  const char*kb=Kslot+hi*1024+r32*16;
  #pragma unroll
  for(int d0=0;d0<4;++d0){
    const bf16x8 b0=*reinterpret_cast<const bf16x8*>(kb+d0*2048);
    const bf16x8 b1=*reinterpret_cast<const bf16x8*>(kb+d0*2048+512);
    if(d0==0){p0=__builtin_amdgcn_mfma_f32_32x32x16_bf16(b0,qr[0],negm,0,0,0);p1=__builtin_amdgcn_mfma_f32_32x32x16_bf16(b1,qr[0],negm,0,0,0);}
    else{p0=__builtin_amdgcn_mfma_f32_32x32x16_bf16(b0,qr[d0],p0,0,0,0);p1=__builtin_amdgcn_mfma_f32_32x32x16_bf16(b1,qr[d0],p1,0,0,0);}}
}
typedef __attribute__((address_space(3))) const char* lds_cptr;
typedef short v4i16_t __attribute__((ext_vector_type(4)));
__device__ __forceinline__ void kload8(bf16x8*kf,lds_cptr kp){
  kf[0]=*(const __attribute__((address_space(3))) bf16x8*)(kp);      kf[1]=*(const __attribute__((address_space(3))) bf16x8*)(kp+512);
  kf[2]=*(const __attribute__((address_space(3))) bf16x8*)(kp+2048); kf[3]=*(const __attribute__((address_space(3))) bf16x8*)(kp+2560);
  kf[4]=*(const __attribute__((address_space(3))) bf16x8*)(kp+4096); kf[5]=*(const __attribute__((address_space(3))) bf16x8*)(kp+4608);
  kf[6]=*(const __attribute__((address_space(3))) bf16x8*)(kp+6144); kf[7]=*(const __attribute__((address_space(3))) bf16x8*)(kp+6656);
}
__device__ __forceinline__ void kload2(bf16x8*kf,lds_cptr kp,int j){ kf[2*j]=*(const __attribute__((address_space(3))) bf16x8*)(kp+j*2048); kf[2*j+1]=*(const __attribute__((address_space(3))) bf16x8*)(kp+j*2048+512); }
__device__ __forceinline__ s16x4 vtr(lds_cptr p){ return __builtin_bit_cast(s16x4,__builtin_amdgcn_ds_read_tr16_b64_v4i16((__attribute__((address_space(3))) v4i16_t*)p)); }
__device__ __forceinline__ float rowmax(const f32x16&p0,const f32x16&p1){
  float a=max3f(p0[0],p0[1],p1[0]),b=max3f(p0[2],p0[3],p1[1]);a=max3f(a,p1[2],p1[3]);
  #pragma unroll
  for(int r=4;r<16;r+=4){a=max3f(a,p0[r],p0[r+1]);b=max3f(b,p0[r+2],p0[r+3]);a=max3f(a,p1[r],p1[r+1]);b=max3f(b,p1[r+2],p1[r+3]);}
  const float m=max2f(a,b);
  auto rr=__builtin_amdgcn_permlane32_swap(__float_as_uint(m),__float_as_uint(m),false,false);
  return max2f(__uint_as_float(rr[0]),__uint_as_float(rr[1]));
}
__device__ __forceinline__ void pv(f32x16*o,int vb,bf16x8 pa0,bf16x8 pa1,bf16x8 pa2,bf16x8 pa3){
  #pragma unroll
  for(int d0=0;d0<2;++d0){s16x4 lo[4],hi[4];
    #pragma unroll
    for(int ks=0;ks<4;++ks){
      asm volatile("ds_read_b64_tr_b16 %0,%1 offset:%c2":"=&v"(lo[ks]):"v"(vb),"i"(d0*4096+ks*1024):"memory");
      asm volatile("ds_read_b64_tr_b16 %0,%1 offset:%c2":"=&v"(hi[ks]):"v"(vb),"i"(d0*4096+ks*1024+512):"memory");}
    asm volatile("s_waitcnt lgkmcnt(0)":::"memory");SBAR();
    #define PK(k) (bf16x8){lo[k][0],lo[k][1],lo[k][2],lo[k][3],hi[k][0],hi[k][1],hi[k][2],hi[k][3]}
    o[d0]=__builtin_amdgcn_mfma_f32_32x32x16_bf16(pa0,PK(0),o[d0],0,0,0);
    o[d0]=__builtin_amdgcn_mfma_f32_32x32x16_bf16(pa1,PK(1),o[d0],0,0,0);
    o[d0]=__builtin_amdgcn_mfma_f32_32x32x16_bf16(pa2,PK(2),o[d0],0,0,0);
    o[d0]=__builtin_amdgcn_mfma_f32_32x32x16_bf16(pa3,PK(3),o[d0],0,0,0);
    #undef PK
  }
}

#ifndef ATTN_STORE16
#define ATTN_STORE16(p,v) (*(u32x4*)(p)=(v))
#endif
template<int THRL> __device__ __forceinline__ void attn_unit(const bf16*Qb,const bf16*__restrict__ Kh,const bf16*__restrict__ Vh,bf16*Ob,const int PQ,const int PK,const int PV,const int PO,const int NT,char*shm){
  int tid=threadIdx.x; asm volatile("":"+v"(tid)); const int lane=tid&63,r32=lane&31,hi=lane>>5; const int wid=__builtin_amdgcn_readfirstlane(tid>>6);
  const bf16*Qw=Qb+(long)(wid*QBLK)*PQ;
  const unsigned lds0=(unsigned)(uintptr_t)shm;
  float*wsf=(float*)(shm+LDS_WS)+wid*64;
  const bf16*ksrc=Kh+(long)lane*PK+wid*8;
  const bf16*vsrc=Vh+(long)(16*(wid&3)+(lane>>2))*PV+(wid>>2)*32+(lane&3)*8;
  const unsigned kdst=lds0+LDS_K+wid*1024, vdst=lds0+LDS_V+wid*1024;
  #define DMA_K(t,slot) glds16(ksrc+(long)(t)*KVBLK*PK,(unsigned)__builtin_amdgcn_readfirstlane(kdst+(slot)))
  #define DMA_V(t,slot) glds16(vsrc+(long)(t)*KVBLK*PV,(unsigned)__builtin_amdgcn_readfirstlane(vdst+(slot)))
  const int vb0=(int)(lds0+LDS_V)+((lane>>4)&1)*32+(lane&3)*8+(4*hi+((lane&15)>>2))*64;
  const char*Kbase=shm+LDS_K; bf16x8 kf[8];
  const lds_cptr shm3=(lds_cptr)shm; const lds_cptr kp0=shm3+LDS_K+hi*1024+r32*16; const lds_cptr vp0=shm3+LDS_V+((lane>>4)&1)*32+(lane&3)*8+(4*hi+((lane&15)>>2))*64;
  DMA_K(0,0);DMA_V(0,0);DMA_K(1,SLOTB);
  bf16x8 qr[4];
  #pragma unroll
  for(int d0=0;d0<4;++d0)qr[d0]=*reinterpret_cast<const bf16x8*>(&Qw[(long)r32*PQ+d0*16+hi*8]);
  float mhat=0.f,l_reg=0.f;f32x16 o[2];o[0]=f32x16{};o[1]=f32x16{};f32x16 negm=f32x16{};asm volatile("":"+v"(negm));
  #define CMASK(P0,P1,t) do{}while(0)
  bool resc=false;
  #define START(P0,P1) do{ const float rm=rowmax(P0,P1); resc=false; \
    { const float dl=rm; mhat=fadd_s(mhat,dl); \
      _Pragma("unroll") for(int r=0;r<16;++r){P0[r]=fsub_s(P0[r],dl);P1[r]=fsub_s(P1[r],dl);} \
      _Pragma("unroll") for(int r=0;r<16;++r)negm[r]=-mhat; asm volatile("":"+v"(negm)); } \
    _Pragma("unroll") for(int r=0;r<16;++r)P0[r]=__builtin_amdgcn_exp2f(P0[r]); }while(0)
  #define RESC() do{ if(resc){ asm volatile("s_waitcnt lgkmcnt(0)":::"memory"); \
      _Pragma("unroll") for(int d_=0;d_<2;++d_) _Pragma("unroll") for(int r=0;r<16;++r)o[d_][r]*=wsf[crow(r,hi)]; } }while(0)
  f32x16 pA0,pA1,pB0,pB1;
  int sl_prev=0,sl_cur=0,sl_next=SLOTB;
  #define ROT() do{sl_prev=sl_cur;sl_cur=sl_next;sl_next=(sl_next==(NSLOT-1)*SLOTB)?0:sl_next+SLOTB;}while(0)
  DMA_K(2,2*SLOTB);
  WAIT_BAR(3);
  qkt(pA0,pA1,Kbase,qr,negm,r32,hi);asm volatile("s_nop 15\n\ts_nop 7":"+v"(pA0),"+v"(pA1));CMASK(pA0,pA1,0);
  START(pA0,pA1);
  _Pragma("unroll") for(int r=0;r<16;++r)pA1[r]=__builtin_amdgcn_exp2f(pA1[r]);
  WAIT_BAR(0);
  DMA_K(3,0);DMA_V(1,SLOTB);
  ROT();
  kload8(kf,kp0+sl_cur);
  WAIT_BAR(2);
  s16x4 vlo[8],vhi[8]; u32x4 pw0,pw1,pw2,pw3;
  #define PKW(P,B) cvtpk_s(P[B],P[B+1])
  #define PAF(k) __builtin_bit_cast(bf16x8,pw##k)
  #define VFR(i) (bf16x8){vlo[i][0],vlo[i][1],vlo[i][2],vlo[i][3],vhi[i][0],vhi[i][1],vhi[i][2],vhi[i][3]}
  #define PIN(x) asm volatile("":"+v"(x))
  #define MX3(a,b,c) __builtin_fmaxf(__builtin_fmaxf((a),(b)),(c))
  #define GAPA(MF,A0,A1,A2,A3,W0,W1,PW) do{ MF; sacc+=A0; sacc+=A1; sacc+=A2; sacc+=A3; PIN(sacc); W0; W1; PIN(PW); SBAR(); }while(0)
  #define EX(v) __builtin_amdgcn_exp2f(v)
  #define GAPB(MF,X,B) do{ MF; X[B]=EX(X[B]); X[B+1]=EX(X[B+1]); X[B+2]=EX(X[B+2]); X[B+3]=EX(X[B+3]); PIN(X); SBAR(); }while(0)
  #define VRD(i) do{ vlo[i]=vtr(vp_+(((i)>>2)*4096+((i)&3)*1024)); vhi[i]=vtr(vp_+(((i)>>2)*4096+((i)&3)*1024+512)); }while(0)
  #define KRD(G,j) do{ if(G){ kload2(kf,kp0+sl_next,j); SBAR(); } }while(0)
  #define STEP(C0,C1,P0,P1,t,GK,GV,GL) do{ SBAR(); \
    const lds_cptr vp_=vp0+sl_prev; \
    VRD(0); SBAR(); float sacc=(P0[0]+P0[1]); \
    GAPA(C0=__builtin_amdgcn_mfma_f32_32x32x16_bf16(kf[0],qr[0],negm,0,0,0), P0[2],P0[3],P0[4],P0[5],     pw0[0]=PKW(P0,0), pw0[1]=PKW(P0,2), pw0); \
    VRD(4); SBAR(); GAPA(C1=__builtin_amdgcn_mfma_f32_32x32x16_bf16(kf[1],qr[0],negm,0,0,0), P0[6],P0[7],P0[8],P0[9],     pw0[2]=PKW(P0,4), pw0[3]=PKW(P0,6), pw0); \
    VRD(1); SBAR(); GAPA(C0=__builtin_amdgcn_mfma_f32_32x32x16_bf16(kf[2],qr[1],C0,0,0,0),   P0[10],P0[11],P0[12],P0[13], pw1[0]=PKW(P0,8), pw1[1]=PKW(P0,10), pw1); \
    VRD(5); SBAR(); GAPA(C1=__builtin_amdgcn_mfma_f32_32x32x16_bf16(kf[3],qr[1],C1,0,0,0),   P0[14],P0[15],P1[0],P1[1],   pw1[2]=PKW(P0,12),pw1[3]=PKW(P0,14), pw1); \
    VRD(2); SBAR(); GAPA(C0=__builtin_amdgcn_mfma_f32_32x32x16_bf16(kf[4],qr[2],C0,0,0,0),   P1[2],P1[3],P1[4],P1[5],     pw2[0]=PKW(P1,0), pw2[1]=PKW(P1,2), pw2); \
    VRD(6); SBAR(); GAPA(C1=__builtin_amdgcn_mfma_f32_32x32x16_bf16(kf[5],qr[2],C1,0,0,0),   P1[6],P1[7],P1[8],P1[9],     pw2[2]=PKW(P1,4), pw2[3]=PKW(P1,6), pw2); \
    VRD(3); SBAR(); GAPA(C0=__builtin_amdgcn_mfma_f32_32x32x16_bf16(kf[6],qr[3],C0,0,0,0),   P1[10],P1[11],P1[12],P1[13], pw3[0]=PKW(P1,8), pw3[1]=PKW(P1,10), pw3); \
    VRD(7); SBAR(); GAPA(C1=__builtin_amdgcn_mfma_f32_32x32x16_bf16(kf[7],qr[3],C1,0,0,0),   P1[14],P1[15],0.f,0.f,       pw3[2]=PKW(P1,12),pw3[3]=PKW(P1,14), pw3); \
    l_reg+=sacc; \
    if(GK){DMA_K((t)+3,sl_cur);} if(GV){DMA_V((t)+1,sl_next);} \
    CMASK(C0,C1,t); \
    { float a=MX3(C0[0],C0[1],C1[0]),b=MX3(C0[2],C0[3],C1[1]); a=MX3(a,C1[2],C1[3]); \
      _Pragma("unroll") for(int r=4;r<16;r+=4){a=MX3(a,C0[r],C0[r+1]);b=MX3(b,C0[r+2],C0[r+3]);a=MX3(a,C1[r],C1[r+1]);b=MX3(b,C1[r+2],C1[r+3]);} \
      float rm=__builtin_fmaxf(a,b); { auto rr=__builtin_amdgcn_permlane32_swap(__float_as_uint(rm),__float_as_uint(rm),false,false); rm=__builtin_fmaxf(__uint_as_float(rr[0]),__uint_as_float(rr[1])); } \
      resc=false; \
      if(__builtin_expect(__any(rm>(float)THRL),0)){ const float dl=__builtin_fmaxf(rm,0.f); mhat+=dl; \
        _Pragma("unroll") for(int r=0;r<16;++r){C0[r]-=dl;C1[r]-=dl;} \
        _Pragma("unroll") for(int r=0;r<16;++r)negm[r]=-mhat; asm volatile("":"+v"(negm)); \
        const float f=__builtin_amdgcn_exp2f(-dl); l_reg*=f; if(hi==0)wsf[r32]=f; resc=true; } } \
    SBAR(); \
    GAPB(o[0]=__builtin_amdgcn_mfma_f32_32x32x16_bf16(PAF(0),VFR(0),o[0],0,0,0), C0,0); \
    GAPB(o[1]=__builtin_amdgcn_mfma_f32_32x32x16_bf16(PAF(0),VFR(4),o[1],0,0,0), C0,4); \
    KRD(GL,0); GAPB(o[0]=__builtin_amdgcn_mfma_f32_32x32x16_bf16(PAF(1),VFR(1),o[0],0,0,0), C0,8); \
    KRD(GL,1); GAPB(o[1]=__builtin_amdgcn_mfma_f32_32x32x16_bf16(PAF(1),VFR(5),o[1],0,0,0), C0,12); \
    KRD(GL,2); GAPB(o[0]=__builtin_amdgcn_mfma_f32_32x32x16_bf16(PAF(2),VFR(2),o[0],0,0,0), C1,0); \
    KRD(GL,3); GAPB(o[1]=__builtin_amdgcn_mfma_f32_32x32x16_bf16(PAF(2),VFR(6),o[1],0,0,0), C1,4); \
    GAPB(o[0]=__builtin_amdgcn_mfma_f32_32x32x16_bf16(PAF(3),VFR(3),o[0],0,0,0), C1,8); \
    GAPB(o[1]=__builtin_amdgcn_mfma_f32_32x32x16_bf16(PAF(3),VFR(7),o[1],0,0,0), C1,12); \
    }while(0)
  int t=1;
  #undef CMASK
  #define CMASK(P0,P1,t) do{}while(0)
  for(;t+5<NT;t+=2){
    STEP(pB0,pB1,pA0,pA1,t,true,true,true);     WAIT_BAR(2); RESC(); ROT();
    STEP(pA0,pA1,pB0,pB1,t+1,true,true,true);   WAIT_BAR(2); RESC(); ROT();
  }
  #undef CMASK
  #define CMASK(P0,P1,t) do{}while(0)
  #define ENDW(tt) do{ if((tt)+3<NT){WAIT_BAR(2);} else if((tt)+2<NT){WAIT_BAR(1);} else {WAIT_BAR(0);} }while(0)
  for(;t+1<NT;t+=2){
    STEP(pB0,pB1,pA0,pA1,t,(t+3<NT),(t+1<NT),(t+1<NT));       ENDW(t);   RESC(); ROT();
    STEP(pA0,pA1,pB0,pB1,t+1,(t+4<NT),(t+2<NT),(t+2<NT));     ENDW(t+1); RESC(); ROT();
  }
  STEP(pB0,pB1,pA0,pA1,NT-1,false,false,false); RESC();
  { float sacc=pB0[0]+pB0[1]; _Pragma("unroll") for(int r=2;r<16;++r)sacc+=pB0[r]; _Pragma("unroll") for(int r=0;r<16;++r)sacc+=pB1[r]; l_reg+=sacc;
    pw0=(u32x4){PKW(pB0,0),PKW(pB0,2),PKW(pB0,4),PKW(pB0,6)};pw1=(u32x4){PKW(pB0,8),PKW(pB0,10),PKW(pB0,12),PKW(pB0,14)};pw2=(u32x4){PKW(pB1,0),PKW(pB1,2),PKW(pB1,4),PKW(pB1,6)};pw3=(u32x4){PKW(pB1,8),PKW(pB1,10),PKW(pB1,12),PKW(pB1,14)};
    SBAR(); pv(o,vb0+sl_cur,PAF(0),PAF(1),PAF(2),PAF(3)); }
  #undef PKW
  #undef PAF
  #undef VFR
  #undef PIN
  #undef MX3
  #undef GAPA
  #undef GAPB
  #undef EX
  #undef VRD
  #undef KRD
  #undef STEP
  #undef ENDW
  {auto rr=__builtin_amdgcn_permlane32_swap(__float_as_uint(l_reg),__float_as_uint(l_reg),false,false);l_reg=__uint_as_float(rr[0])+__uint_as_float(rr[1]);}
  if(hi==0)wsf[32+r32]=l_reg;asm volatile("s_waitcnt lgkmcnt(0)":::"memory");
  float rli[16];
  #pragma unroll
  for(int r=0;r<16;++r)rli[r]=__builtin_amdgcn_rcpf(wsf[32+crow(r,hi)]);
  bf16*Ow=Ob+(long)(wid*QBLK)*PO;
  { bf16*stg=(bf16*)(shm+LDS_OST)+wid*2048;
    #pragma unroll
    for(int r=0;r<16;++r){const int orow=crow(r,hi);
      #pragma unroll
      for(int d0=0;d0<2;++d0)stg[orow*64+d0*32+r32]=__float2bfloat16(o[d0][r]*rli[r]);}
    asm volatile("s_waitcnt lgkmcnt(0)":::"memory");
    #pragma unroll
    for(int i=0;i<4;++i){const int row=i*8+(lane>>3),ch=lane&7; const u32x4 v=*(const u32x4*)(stg+row*64+ch*8); ATTN_STORE16(Ow+(long)row*PO+ch*8,v);} }
  asm volatile("s_waitcnt lgkmcnt(0)\n\ts_barrier":::"memory");
  #undef DMA_K
  #undef DMA_V
  #undef CMASK
  #undef START
  #undef RESC
  #undef ROT
}
constexpr int ATTN_LDS_BYTES=LDS_BYTES;
#undef SBAR
#undef WAIT_BAR
}
#define GAS __attribute__((address_space(1)))
#define LAS __attribute__((address_space(3)))
typedef unsigned short bf16;
typedef unsigned v4u __attribute__((ext_vector_type(4)));
typedef float f32x4 __attribute__((ext_vector_type(4)));
typedef short bf16x8 __attribute__((ext_vector_type(8)));
typedef GAS unsigned gu32;
typedef GAS unsigned long long gu64;
#define RLX_AGENT __ATOMIC_RELAXED, __HIP_MEMORY_SCOPE_AGENT
#define LDS_WAIT() asm volatile("s_waitcnt lgkmcnt(0)" ::: "memory")
#define VM_WAIT() asm volatile("s_waitcnt vmcnt(0)" ::: "memory")
__device__ __forceinline__ unsigned long long rt() { return __builtin_amdgcn_s_memrealtime(); }
__device__ __forceinline__ unsigned f2bf(float f) { unsigned u = __builtin_bit_cast(unsigned, f); return (u + 0x7fffu + ((u >> 16) & 1u)) >> 16; }
__device__ __forceinline__ unsigned pk2(float lo, float hi) { return f2bf(lo) | (f2bf(hi) << 16); }

#define XB_TMO      128
#define XB_XCNT(j)  (256  + 64 * (j))
#define XB_XSUB(j)  (1280 + 64 * (j))
#define XB_XGEN(j)  (2304 + 64 * (j))
#define XB_TOP      3328
#define XB_TOPGEN   3392
#define XCD_BAR_WORDS 3456
#define XB_SPIN_CAP (1u << 22)

__device__ __forceinline__ unsigned xb_ld(unsigned* p)              { return __hip_atomic_load(p, __ATOMIC_RELAXED, __HIP_MEMORY_SCOPE_AGENT); }
__device__ __forceinline__ unsigned xb_add(unsigned* p, unsigned v) { return __hip_atomic_fetch_add(p, v, __ATOMIC_RELAXED, __HIP_MEMORY_SCOPE_AGENT); }
__device__ __forceinline__ unsigned xb_xcc_id() { return (unsigned)__builtin_amdgcn_s_getreg((3 << 11) | 20) & 0xFu; }
#define XB_SPIN(cond, bar) do { unsigned _sp = 0; while (cond) { __builtin_amdgcn_s_sleep(1); \
    if ((++_sp & 255u) == 0u) { if (xb_ld(&(bar)[XB_TMO])) break; if (_sp > XB_SPIN_CAP) { atomicAdd(&(bar)[XB_TMO], 1u); break; } } } } while (0)

struct XcdBarrier {
    unsigned* bar; unsigned x;
    volatile LAS unsigned* st;
};

__device__ __forceinline__ XcdBarrier xcd_barrier_post(unsigned* bar, volatile LAS unsigned* st) {
    XcdBarrier b; b.bar = bar; b.x = xb_xcc_id(); b.st = st;
    if (threadIdx.x == 0) (void)xb_add(&bar[XB_XCNT(b.x)], 1u);
    return b;
}
__device__ __forceinline__ void xcd_barrier_complete(unsigned* bar, unsigned x, unsigned& nloc, unsigned& nx) {
    const unsigned G = gridDim.x * gridDim.y * gridDim.z;
    unsigned sum, cnt, mine, sp = 0u;
    for (;;) {
        sum = 0u; cnt = 0u; mine = 0u;
#pragma unroll
        for (unsigned j = 0; j < 16; ++j) { const unsigned c = xb_ld(&bar[XB_XCNT(j)]); sum += c; cnt += (c > 0u) ? 1u : 0u; mine = (j == x) ? c : mine; }
        if (sum == G) break;
        __builtin_amdgcn_s_sleep(1);
        if ((++sp & 255u) == 0u) { if (xb_ld(&bar[XB_TMO])) break; if (sp > XB_SPIN_CAP) { atomicAdd(&bar[XB_TMO], 1u); break; } }
    }
    nloc = mine > 0u ? mine : 1u; nx = cnt > 0u ? cnt : 1u;
}

__device__ __forceinline__ void xcd_barrier(const XcdBarrier& b) {
    asm volatile("s_waitcnt vmcnt(0)" ::: "memory");
    __syncthreads();
    if (threadIdx.x == 0) {
        unsigned* bar = b.bar;
        __builtin_amdgcn_s_waitcnt(0);
        unsigned nloc = b.st[0], nx = b.st[1];
        if (nloc == 0u) { xcd_barrier_complete(bar, b.x, nloc, nx); b.st[0] = nloc; b.st[1] = nx; }
        const unsigned old = xb_add(&bar[XB_XSUB(b.x)], 1u);
        const unsigned gen = old / nloc;
        if (old + 1u == (gen + 1u) * nloc) {
            __builtin_amdgcn_fence(__ATOMIC_RELEASE, "agent");
            asm volatile("s_waitcnt vmcnt(0)" ::: "memory");
            const unsigned og = xb_add(&bar[XB_TOP], 1u);
            const unsigned tg = og / nx;
            if (og + 1u == (tg + 1u) * nx) xb_add(&bar[XB_TOPGEN], 1u);
            else XB_SPIN(xb_ld(&bar[XB_TOPGEN]) == tg, bar);
            __builtin_amdgcn_fence(__ATOMIC_ACQUIRE, "agent");
            xb_add(&bar[XB_XGEN(b.x)], 1u);
            asm volatile("s_waitcnt vmcnt(0)" ::: "memory");
        } else {
            XB_SPIN(xb_ld(&bar[XB_XGEN(b.x)]) == gen, bar);
            __builtin_amdgcn_fence(__ATOMIC_ACQUIRE, "agent");
            asm volatile("s_waitcnt vmcnt(0)" ::: "memory");
        }
    }
    __syncthreads();
}

constexpr int NWAVES = 8, NTHR = 512;
constexpr int DMODEL = 1024, TPB = 4352  , MROWS = 17408, NLAYER = 4;
constexpr int PATT_LD = 2816, PDN_LD = 1792, DFF = 2816, AU_LD = 5632;
constexpr int C_DAQ = 0, C_DAK = 512, C_DAV = 1024, C_GQQ = 1536, C_GQK = 2048, C_GQV = 2176, C_Z = 2304;
constexpr int C_DNQ = 0, C_BRAW = 1536, C_ARAW = 1544;
constexpr float NEPS = 1e-6f;
constexpr float QSCALE = 0.125f * 1.4426950408889634f;
constexpr size_t WS_CTL = 0, CTL_ZERO_BYTES = 1u << 20;
constexpr size_t WS_MOD = 1u << 20;
constexpr size_t WS_GL = (1u << 20) + (1u << 19);
constexpr size_t WS_WT = 2u << 20;
constexpr size_t WT_IN = 0, WT_BRA = 7864320, WT_BRB = WT_BRA + 524288, WT_BRC = WT_BRB + 524288, WT_O = WT_BRC + 524288, WT_1 = WT_O + 1048576, WT_2 = WT_1 + 5767168;
constexpr size_t WS_XS = 41943040;
constexpr size_t WS_HN = WS_XS + 71303168;
constexpr size_t WS_OC = WS_HN + 35651584;
constexpr size_t WS_PATT = WS_OC + 17825792;
constexpr size_t WS_A = WS_PATT + 98041856;
constexpr size_t WS_END = WS_A + 196083712;
constexpr size_t OPS_BYTES = 73728;
constexpr size_t A_ODA = 160432128;
constexpr size_t A_MRGF = 106954752;
constexpr size_t DO_OA = 35651584;
constexpr int CW_BAR = 4096, CW_Q = 1024;
constexpr int LDS_BYTES = 147456, MISC_OFF = LDS_BYTES - 256;

struct Args { const float* in[27]; float* out; unsigned char* ws; };
typedef const __attribute__((address_space(4))) Args* CArgsP;
#define ARGS_HERE(nm) CArgsP nm = (CArgsP)__builtin_amdgcn_kernarg_segment_ptr(); asm volatile("" : "+s"(nm))

__device__ __forceinline__ float wave_sum(float v) {
#pragma unroll
    for (int o = 1; o < 64; o <<= 1) v += __shfl_xor(v, o);
    return v;
}
__device__ __forceinline__ float silu_f(float v) { return v * __builtin_amdgcn_rcpf(1.f + __expf(-v)); }
__device__ __forceinline__ float bf_lo(unsigned w) { return __uint_as_float(w << 16); }
__device__ __forceinline__ float bf_hi(unsigned w) { return __uint_as_float(w & 0xffff0000u); }
__device__ __forceinline__ float bf_1(bf16 u) { return __uint_as_float((unsigned)u << 16); }

__device__ __forceinline__ void phase_mod(CArgsP a, LAS unsigned char* lds, int tid, int bid, int G) {
    LAS float* sc = (LAS float*)lds; LAS float* red = sc + 5 * 1024;
    const float* c = a->in[1]; const float* cctx = a->in[3]; float* MOD = (float*)(a->ws + WS_MOD);
    for (int i = tid; i < 5 * 1024; i += NTHR) { const float v = (i < 4096) ? c[i] : cctx[i - 4096]; sc[i] = silu_f(v); }
    __syncthreads();
    const int wave = tid >> 6, lane = tid & 63;
    for (int task = bid; task < 4 * 96; task += G) {
        const int l = task / 96, n = (task % 96) * 64 + lane;
        const float* W = a->in[4] + (size_t)l * 1024 * 6144 + n;
        float acc[5] = {0.f, 0.f, 0.f, 0.f, 0.f};
        for (int k0 = wave * 128; k0 < wave * 128 + 128; k0 += 16) { float w[16];
#pragma unroll
            for (int kk = 0; kk < 16; ++kk) w[kk] = W[(size_t)(k0 + kk) * 6144];
#pragma unroll
            for (int kk = 0; kk < 16; ++kk)
#pragma unroll
                for (int r = 0; r < 5; ++r) acc[r] += sc[r * 1024 + k0 + kk] * w[kk]; }
#pragma unroll
        for (int r = 0; r < 5; ++r) red[(wave * 5 + r) * 64 + lane] = acc[r];
        __syncthreads();
        if (tid < 320) { const int r = tid >> 6; float s = 0.f;
#pragma unroll
            for (int w = 0; w < 8; ++w) s += red[(w * 5 + r) * 64 + lane];
            MOD[(size_t)(l * 5 + r) * 6144 + n] = s + a->in[5][l * 6144 + n]; }
        __syncthreads();
    }
}

__device__ __forceinline__ int map_in(int nd) {
    if (nd < 2304) return nd;
    if (nd < 2816) return 3856 + (nd - 2304);
    if (nd < 2816 + 1536) return 2304 + (nd - 2816);
    if (nd < 2816 + 1552) return 3840 + (nd - 2816 - 1536);
    if (nd < 4608) return -1;
    return 4368 + (nd - 4608);
}
template <int MAP> __device__ __forceinline__ void tr_item(const float* W, int K, int N, bf16* WT, LAS float* scr, int item, int lane, int nblk) {
    const int kb = item / nblk, nb = item % nblk, k0 = 64 * kb, n0 = 32 * nb;
    const int nd = n0 + (lane & 31); const int ns = MAP == 1 ? map_in(nd) : MAP == 2 ? (((nd & 255) < 128) ? (nd >> 8) * 128 + (nd & 255) : 2816 + (nd >> 8) * 128 + (nd & 255) - 128) : nd;
    float tv[32];
#pragma unroll
    for (int i = 0; i < 32; ++i) { const int kk = 2 * i + (lane >> 5); tv[i] = (ns >= 0) ? W[(size_t)(k0 + kk) * N + ns] : 0.f; }
#pragma unroll
    for (int i = 0; i < 32; ++i) { const int kk = 2 * i + (lane >> 5); scr[kk * 33 + (lane & 31)] = tv[i]; }
    LDS_WAIT(); asm volatile("" ::: "memory");
    const int c = lane & 7;
#pragma unroll
    for (int j = 0; j < 4; ++j) { const int n = (lane >> 3) + 8 * j; const LAS float* s = scr + (8 * c) * 33 + n;
        v4u o; o.x = pg8::pkbf(s[0 * 33], s[1 * 33]); o.y = pg8::pkbf(s[2 * 33], s[3 * 33]); o.z = pg8::pkbf(s[4 * 33], s[5 * 33]); o.w = pg8::pkbf(s[6 * 33], s[7 * 33]);
        *(GAS v4u*)(WT + (size_t)(n0 + n) * K + k0 + 8 * c) = o; }
    LDS_WAIT(); asm volatile("" ::: "memory");
}
__device__ __forceinline__ void phase_convert(CArgsP a, int l, LAS unsigned char* lds, int gw, int NGW, int wave, int lane, int it_lo = 0, int it_hi = 9344) {
    LAS float* scr = (LAS float*)(lds + wave * 16384);
    bf16* WT = (bf16*)(a->ws + WS_WT);
    for (int it = it_lo + gw; it < it_hi; it += NGW) {
        int r = it;
        if (r < 3840) { tr_item<1>(a->in[7] + (size_t)l * 1024 * 7440, 1024, 7440, WT + WT_IN, scr, r, lane, 240); continue; } r -= 3840;
        if (r < 256) { tr_item<0>(a->in[18] + (size_t)l * 512 * 1024, 512, 1024, WT + WT_BRA, scr, r, lane, 32); continue; } r -= 256;
        if (r < 256) { tr_item<0>(a->in[19] + (size_t)l * 512 * 1024, 512, 1024, WT + WT_BRB, scr, r, lane, 32); continue; } r -= 256;
        if (r < 256) { tr_item<0>(a->in[20] + (size_t)l * 512 * 1024, 512, 1024, WT + WT_BRC, scr, r, lane, 32); continue; } r -= 256;
        if (r < 512) { tr_item<0>(a->in[21] + (size_t)l * 1024 * 1024, 1024, 1024, WT + WT_O, scr, r, lane, 32); continue; } r -= 512;
        if (r < 2816) { tr_item<2>(a->in[23] + (size_t)l * 1024 * 5632, 1024, 5632, WT + WT_1, scr, r, lane, 176); continue; } r -= 2816;
        tr_item<0>(a->in[26] + (size_t)l * 2816 * 1024, 2816, 1024, WT + WT_2, scr, r, lane, 32);
    }
}

__device__ __forceinline__ const float* norm_src(CArgsP a, bool first, int row) {
    const int b = row / TPB, p = row % TPB;
    return first ? (p < 256 ? a->in[2] + ((size_t)b * 256 + p) * 1024 : a->in[0] + ((size_t)b * 4096 + (p - 256)) * 1024) : (const float*)(a->ws + WS_XS) + (size_t)row * 1024;
}
__device__ __forceinline__ void norm_finish(CArgsP a, const float* gain, const float* modl, int shoff, int scoff, bool first, int row, int lane, const f32x4 (&v)[4]) {
    float ss = 0.f;
#pragma unroll
    for (int j = 0; j < 4; ++j) ss += (v[j].x * v[j].x + v[j].y * v[j].y) + (v[j].z * v[j].z + v[j].w * v[j].w);
    const float rstd = __builtin_amdgcn_rsqf(wave_sum(ss) * (1.f / 1024.f) + NEPS);
    const int b = row / TPB, p = row % TPB;
    const float* mrow = modl + (size_t)(p < 256 ? 4 : b) * 6144;
    float* XS = (float*)(a->ws + WS_XS); bf16* HN = (bf16*)(a->ws + WS_HN);
#pragma unroll
    for (int j = 0; j < 4; ++j) { const int col = 4 * lane + 256 * j;
        const f32x4 g4 = *(const f32x4*)(gain + col), sh = *(const f32x4*)(mrow + shoff + col), sc = *(const f32x4*)(mrow + scoff + col);
        const f32x4 h = (v[j] * rstd * g4) * (sc + 1.0f) + sh;
        *(unsigned long long*)(HN + (size_t)row * 1024 + col) = (unsigned long long)pg8::pkbf(h.x, h.y) | ((unsigned long long)pg8::pkbf(h.z, h.w) << 32);
        if (first) *(f32x4*)(XS + (size_t)row * 1024 + col) = v[j]; }
}
__device__ __forceinline__ int norm_row(int i, int mode) { return mode == 0 ? i : mode == 1 ? i + ((i >> 12) + 1) * 256 : (i >> 8) * TPB + (i & 255); }
__device__ __forceinline__ void phase_norm(CArgsP a, int l, int which, int gw, int NGW, int lane, int mode = 0) {
    const float* gain = a->in[which ? 22 : 6] + l * 1024;
    const float* modl = (const float*)(a->ws + WS_MOD) + (size_t)l * 5 * 6144;
    const int shoff = which ? 3 * 1024 : 0, scoff = which ? 4 * 1024 : 1024;
    const bool first = (which == 0 && l == 0);
    const int nrows = mode == 0 ? MROWS : mode == 1 ? 16384 : 1024;
    for (int i = gw; i < nrows; i += 2 * NGW) {
        const int i2 = i + NGW; const bool has2 = i2 < nrows;
        const int row = norm_row(i, mode), row2 = norm_row(has2 ? i2 : i, mode);
        const float* s1 = norm_src(a, first, row); const float* s2 = norm_src(a, first, row2);
        f32x4 v1[4], v2[4];
#pragma unroll
        for (int j = 0; j < 4; ++j) { v1[j] = *(const f32x4*)(s1 + 4 * lane + 256 * j); v2[j] = *(const f32x4*)(s2 + 4 * lane + 256 * j); }
        norm_finish(a, gain, modl, shoff, scoff, first, row, lane, v1);
        if (has2) norm_finish(a, gain, modl, shoff, scoff, first, row2, lane, v2);
    }
}

__device__ __forceinline__ void qk_row(CArgsP a, int l, int row, int lane) {
    bf16* prow = (bf16*)(a->ws + WS_PATT) + (size_t)row * PATT_LD;
    const int p = row % TPB; const bool lat = p >= 256; const int t = p - 256;
    const int hv = lane >> 3, t8 = lane & 7, half = t8 >> 2, tt = t8 & 3, e1 = half * 32 + 4 * tt, e2 = e1 + 16;
    float cs[4], sn[4];
    if (lat) { const float pos = (float)(half == 0 ? (t >> 6) : (t & 63));
#pragma unroll
        for (int i = 0; i < 4; ++i) { const float f = (float)(4 * tt + i); const float invf = __builtin_amdgcn_exp2f(-f * (13.287712379549449f / 16.f)); __sincosf(pos * invf, &sn[i], &cs[i]); } }
    else {
#pragma unroll
        for (int i = 0; i < 4; ++i) { cs[i] = 1.f; sn[i] = 0.f; } }
#pragma unroll
    for (int seg = 0; seg < 4; ++seg) {
        const int colbase = seg == 0 ? C_DAQ : seg == 1 ? C_DAK : seg == 2 ? C_GQQ : C_GQK;
        const float* gain = a->in[seg == 0 ? 8 : seg == 1 ? 9 : seg == 2 ? 12 : 13] + l * 64;
        const bool isq = (seg == 0 || seg == 2); const bool active = (seg == 3) ? (hv < 2) : true;
        bf16* p1 = prow + colbase + hv * 64 + e1; bf16* p2 = prow + colbase + hv * 64 + e2;
        unsigned long long r1 = 0ull, r2 = 0ull; if (active) { r1 = *(const unsigned long long*)p1; r2 = *(const unsigned long long*)p2; }
        const float x1[4] = {bf_lo((unsigned)r1), bf_hi((unsigned)r1), bf_lo((unsigned)(r1 >> 32)), bf_hi((unsigned)(r1 >> 32))};
        const float x2[4] = {bf_lo((unsigned)r2), bf_hi((unsigned)r2), bf_lo((unsigned)(r2 >> 32)), bf_hi((unsigned)(r2 >> 32))};
        float ss = 0.f;
#pragma unroll
        for (int i = 0; i < 4; ++i) ss += x1[i] * x1[i] + x2[i] * x2[i];
        ss += __shfl_xor(ss, 1); ss += __shfl_xor(ss, 2); ss += __shfl_xor(ss, 4);
        const float rstd = __builtin_amdgcn_rsqf(ss * (1.f / 64.f) + NEPS) * (isq ? QSCALE : 1.f);
        float o1[4], o2[4];
#pragma unroll
        for (int i = 0; i < 4; ++i) { const float y1 = x1[i] * rstd * gain[e1 + i], y2 = x2[i] * rstd * gain[e2 + i]; o1[i] = y1 * cs[i] - y2 * sn[i]; o2[i] = y1 * sn[i] + y2 * cs[i]; }
        if (active) { *(unsigned long long*)p1 = (unsigned long long)pg8::pkbf(o1[0], o1[1]) | ((unsigned long long)pg8::pkbf(o1[2], o1[3]) << 32);
                      *(unsigned long long*)p2 = (unsigned long long)pg8::pkbf(o2[0], o2[1]) | ((unsigned long long)pg8::pkbf(o2[2], o2[3]) << 32); }
    }
}

typedef float f32x16 __attribute__((ext_vector_type(16)));
#define MFMA32(a_, b_, c_) __builtin_amdgcn_mfma_f32_32x32x16_bf16((a_), (b_), (c_), 0, 0, 0)
__device__ __forceinline__ bf16x8 pack8(const f32x16& x, int s) {
    v4u p; p.x = pg8::pkbf(x[8 * s + 0], x[8 * s + 1]); p.y = pg8::pkbf(x[8 * s + 2], x[8 * s + 3]); p.z = pg8::pkbf(x[8 * s + 4], x[8 * s + 5]); p.w = pg8::pkbf(x[8 * s + 6], x[8 * s + 7]);
    return __builtin_bit_cast(bf16x8, p);
}
__device__ __forceinline__ void split8(const f32x4 a, const f32x4 b, bf16x8& hi, bf16x8& lo) {
    const float x[8] = {a.x, a.y, a.z, a.w, b.x, b.y, b.z, b.w}; v4u h, l;
    { const unsigned p = pg8::pkbf(x[0], x[1]); h.x = p; l.x = pg8::pkbf(x[0] - bf_lo(p), x[1] - bf_hi(p)); }
    { const unsigned p = pg8::pkbf(x[2], x[3]); h.y = p; l.y = pg8::pkbf(x[2] - bf_lo(p), x[3] - bf_hi(p)); }
    { const unsigned p = pg8::pkbf(x[4], x[5]); h.z = p; l.z = pg8::pkbf(x[4] - bf_lo(p), x[5] - bf_hi(p)); }
    { const unsigned p = pg8::pkbf(x[6], x[7]); h.w = p; l.w = pg8::pkbf(x[6] - bf_lo(p), x[7] - bf_hi(p)); }
    hi = __builtin_bit_cast(bf16x8, h); lo = __builtin_bit_cast(bf16x8, l);
}
constexpr int PS = 132;
constexpr int L_QS = 0, L_KS = 33792, L_VS = 67584, L_NR = 84992, L_KK = 101376, L_QK = 117760, L_SC = 134144;
constexpr int VSS = 136;
__device__ __forceinline__ void dn_task_decode(int task, int& b, int& seg, int& h, int& n, int& NC) {
    b = task / 272; int r = task % 272;
    if (r < 16) { seg = 0; h = r >> 2; n = r & 3; NC = 4; } else { r -= 16; seg = 1; h = r >> 6; n = r & 63; NC = 64; }
}
#ifndef PREP_PROF
#define PREP_PROF 0
#define PREP_SUBA 0
#define PREP_SUBB 0
#endif
#define PREP_MARK(k) do { if (PREP_PROF && blockIdx.x == 0 && tid == 0) { const unsigned t_ = (unsigned)rt(); volatile LAS unsigned* M_ = (volatile LAS unsigned*)(lds + MISC_OFF); M_[16 + (k)] += t_ - prep_t; prep_t = t_; } } while (0)
__device__ __forceinline__ void dn_prep_task(CArgsP a, int l, int task, LAS unsigned char* lds, int tid) {
    asm volatile("" : "+v"(tid));
    unsigned prep_t = (PREP_PROF && blockIdx.x == 0 && tid == 0) ? (unsigned)rt() : 0u;
    int b, seg, h, n, NC; dn_task_decode(task, b, seg, h, n, NC);
    const int seglo = b * TPB + (seg ? 256 : 0), seghi = seglo + NC * 64, rowbase = seglo + 64 * n;
    const bf16* PDN = (const bf16*)a->out;
    LAS float* QS = (LAS float*)(lds + L_QS); LAS float* KS = (LAS float*)(lds + L_KS); LAS bf16* VSb = (LAS bf16*)(lds + L_VS);
    LAS float* KK = (LAS float*)(lds + L_KK); LAS float* QK = (LAS float*)(lds + L_QK);
    LAS float* sBeta = (LAS float*)(lds + L_SC); LAS float* sGc = sBeta + 128; LAS float* sEg = sGc + 128; LAS float* sBe = sEg + 128;
    const int wave = __builtin_amdgcn_readfirstlane(tid >> 6), lane = tid & 63;
    if (tid < 384) { const int cgp = tid % 48, rg = tid / 48, c8 = cgp * 8, which = c8 >> 7, c = c8 & 127, col = which * 512 + h * 128 + c, r0 = rg * 8;
        const float* cw = a->in[14] + (size_t)l * 3 * 1536 + col;
        const f32x4 w0a = *(const f32x4*)cw, w0b = *(const f32x4*)(cw + 4), w1a = *(const f32x4*)(cw + 1536), w1b = *(const f32x4*)(cw + 1540), w2a = *(const f32x4*)(cw + 3072), w2b = *(const f32x4*)(cw + 3076);
        v4u rw[10];
#pragma unroll
        for (int i = 0; i < 10; ++i) { const int row = rowbase + r0 - 1 + i; rw[i] = (v4u){0u, 0u, 0u, 0u}; if (row >= seglo && row < seghi) rw[i] = *(const v4u*)(PDN + (size_t)row * PDN_LD + col); }
        LAS float* dst = (which == 0 ? QS : KS) + c;
#pragma unroll
        for (int i = 0; i < 8; ++i) { const v4u m = rw[i], z = rw[i + 1], n2 = rw[i + 2];
            f32x4 ya = w0a * (f32x4){bf_lo(m.x), bf_hi(m.x), bf_lo(m.y), bf_hi(m.y)} + w1a * (f32x4){bf_lo(z.x), bf_hi(z.x), bf_lo(z.y), bf_hi(z.y)} + w2a * (f32x4){bf_lo(n2.x), bf_hi(n2.x), bf_lo(n2.y), bf_hi(n2.y)};
            f32x4 yb = w0b * (f32x4){bf_lo(m.z), bf_hi(m.z), bf_lo(m.w), bf_hi(m.w)} + w1b * (f32x4){bf_lo(z.z), bf_hi(z.z), bf_lo(z.w), bf_hi(z.w)} + w2b * (f32x4){bf_lo(n2.z), bf_hi(n2.z), bf_lo(n2.w), bf_hi(n2.w)};
            ya = (f32x4){silu_f(ya.x), silu_f(ya.y), silu_f(ya.z), silu_f(ya.w)}; yb = (f32x4){silu_f(yb.x), silu_f(yb.y), silu_f(yb.z), silu_f(yb.w)};
            if (which == 2) { v4u pv; pv.x = pg8::pkbf(ya.x, ya.y); pv.y = pg8::pkbf(ya.z, ya.w); pv.z = pg8::pkbf(yb.x, yb.y); pv.w = pg8::pkbf(yb.z, yb.w); *(LAS v4u*)(VSb + (r0 + i) * VSS + c) = pv; }
            else { *(LAS f32x4*)(dst + (r0 + i) * PS) = ya; *(LAS f32x4*)(dst + (r0 + i) * PS + 4) = yb; } } }
    __syncthreads();
    PREP_MARK(0);
    { const int r = tid >> 3, part = tid & 7;
      LAS float* qp = QS + r * PS + 16 * part; LAS float* kp = KS + r * PS + 16 * part;
      f32x4 qv[4], kv[4]; float sq = 0.f, sk = 0.f;
#pragma unroll
      for (int q = 0; q < 4; ++q) { qv[q] = *(const LAS f32x4*)(qp + 4 * q); kv[q] = *(const LAS f32x4*)(kp + 4 * q);
          sq += (qv[q].x * qv[q].x + qv[q].y * qv[q].y) + (qv[q].z * qv[q].z + qv[q].w * qv[q].w); sk += (kv[q].x * kv[q].x + kv[q].y * kv[q].y) + (kv[q].z * kv[q].z + kv[q].w * kv[q].w); }
      sq += __shfl_xor(sq, 1); sk += __shfl_xor(sk, 1); sq += __shfl_xor(sq, 2); sk += __shfl_xor(sk, 2); sq += __shfl_xor(sq, 4); sk += __shfl_xor(sk, 4);
      const float rq = __builtin_amdgcn_rsqf(sq + NEPS), rk = __builtin_amdgcn_rsqf(sk + NEPS);
#pragma unroll
      for (int q = 0; q < 4; ++q) { *(LAS f32x4*)(qp + 4 * q) = qv[q] * rq; *(LAS f32x4*)(kp + 4 * q) = kv[q] * rk; } }
    if (wave < 2) { const int dir = wave; const int cn = dir ? 63 - lane : lane; const size_t ro = (size_t)(rowbase + cn) * PDN_LD;
        const float braw = bf_1(PDN[ro + C_BRAW + dir * 4 + h]), araw = bf_1(PDN[ro + C_ARAW + dir * 4 + h]);
        const float beta = __builtin_amdgcn_rcpf(1.f + __expf(-braw));
        const float xs = araw + a->in[16][l * 8 + dir * 4 + h];
        const float ee = __expf(-fabsf(xs)); const float l1p = (ee < 0.03f) ? ee * (1.f - ee * (0.5f - ee * (0.33333334f - 0.25f * ee))) : __logf(1.f + ee); const float sp = fmaxf(xs, 0.f) + l1p;
        float g = -__expf(a->in[15][l * 8 + dir * 4 + h]) * sp;
#pragma unroll
        for (int off = 1; off < 64; off <<= 1) { const float v = __shfl_up(g, off); if (lane >= off) g += v; }
        const float eg = __expf(g);
        sBeta[dir * 64 + lane] = beta; sGc[dir * 64 + lane] = g; sEg[dir * 64 + lane] = eg; sBe[dir * 64 + lane] = beta * eg;
        if (lane == 63) ((float*)(a->ws + WS_GL))[task * 2 + dir] = eg; }
    __syncthreads();
    PREP_MARK(1);
    { const int mat = wave >> 2, bi = (wave >> 1) & 1, bj = wave & 1, r = lane & 31, hh = lane >> 5;
      const LAS float* pa = (mat ? QS : KS) + (32 * bi + r) * PS + 8 * hh; const LAS float* pb = KS + (32 * bj + r) * PS + 8 * hh;
      f32x16 acc;
#pragma unroll
      for (int q = 0; q < 16; ++q) acc[q] = 0.f;
#pragma unroll
      for (int ks = 0; ks < 8; ++ks) {
          const f32x4 a0 = *(const LAS f32x4*)(pa + 16 * ks), a1 = *(const LAS f32x4*)(pa + 16 * ks + 4), b0 = *(const LAS f32x4*)(pb + 16 * ks), b1 = *(const LAS f32x4*)(pb + 16 * ks + 4);
          bf16x8 ah, al, bh, bl; split8(a0, a1, ah, al); split8(b0, b1, bh, bl);
          acc = MFMA32(ah, bh, acc); acc = MFMA32(ah, bl, acc); acc = MFMA32(al, bh, acc); }
      LAS float* dstm = mat ? QK : KK;
#pragma unroll
      for (int q = 0; q < 16; ++q) dstm[(32 * bi + (q & 3) + 8 * (q >> 2) + 4 * hh) * 64 + 32 * bj + r] = acc[q]; }
    __syncthreads();
    PREP_MARK(2);
    unsigned char* ops0 = a->ws + WS_A + (size_t)task * 2 * OPS_BYTES;
    const float qs = 0.08838834764831845f;
    LAS float* A1m = (LAS float*)(lds + L_NR);
    for (int idx = tid; idx < 4096; idx += NTHR) { const int ip = idx >> 6, jp = idx & 63;
        A1m[idx] = (ip > jp) ? sBeta[64 + ip] * KK[(63 - ip) * 64 + (63 - jp)] * __expf(sGc[64 + ip] - sGc[64 + jp]) : 0.f; }
    __syncthreads();
    for (int idx = tid; idx < 4096; idx += NTHR) { const int ip = idx >> 6, jp = idx & 63;
        KK[idx] = (ip > jp) ? sBeta[ip] * KK[idx] * __expf(sGc[ip] - sGc[jp]) : 0.f; }
    __syncthreads();
    PREP_MARK(3);
    if (wave < 2) { unsigned adoff = wave ? (unsigned)L_NR : (unsigned)L_KK; asm volatile("" : "+v"(adoff)); LAS float* Ad = (LAS float*)(lds + adoff); float X[64];
#pragma unroll
      for (int i = 0; i < 64; ++i) X[i] = (i == lane) ? 1.f : 0.f;
      f32x4 cur[16], nxt[16];
#pragma unroll
      for (int q = 0; q < 16; ++q) { cur[q] = (f32x4){0.f, 0.f, 0.f, 0.f}; nxt[q] = (f32x4){0.f, 0.f, 0.f, 0.f}; }
      cur[0] = *(const LAS f32x4*)(Ad + 64);
#pragma unroll
      for (int i = 1; i < 64; ++i) {
          if (i + 1 < 64) {
#pragma unroll
              for (int q = 0; q < 16; ++q) if (4 * q < i + 1) nxt[q] = *(const LAS f32x4*)(Ad + (i + 1) * 64 + 4 * q); }
          __builtin_amdgcn_sched_barrier(0);
          float s0 = 0.f, s1 = 0.f;
#pragma unroll
          for (int jj = 0; jj < i; ++jj) { const float av = cur[jj >> 2][jj & 3]; if (jj & 1) s1 += av * X[jj]; else s0 += av * X[jj]; }
          X[i] -= (s0 + s1);
          __builtin_amdgcn_sched_barrier(0);
#pragma unroll
          for (int q = 0; q < 16; ++q) cur[q] = nxt[q]; }
#pragma unroll
      for (int i = 0; i < 64; ++i) Ad[i * 64 + lane] = X[i]; }
    else {
    for (int f = tid - 128; f < 2048; f += NTHR - 128) {
        const int dir = f >> 10, ff = f & 1023, mb = ff >> 9, ks = (ff >> 6) & 7, ln = ff & 63, g = ln >> 5, r = ln & 31;
        const int cp = mb * 32 + r, cn = dir ? 63 - cp : cp; const float sc = sEg[dir * 64 + cp] * qs;
        const int db = 32 * (ks >> 1) + 16 * (ks & 1) + 4 * g;
        const f32x4 v0 = *(const LAS f32x4*)(QS + cn * PS + db), v1 = *(const LAS f32x4*)(QS + cn * PS + db + 8);
        v4u o; o.x = pg8::pkbf(v0.x * sc, v0.y * sc); o.y = pg8::pkbf(v0.z * sc, v0.w * sc); o.z = pg8::pkbf(v1.x * sc, v1.y * sc); o.w = pg8::pkbf(v1.z * sc, v1.w * sc);
        *(v4u*)(ops0 + (size_t)dir * OPS_BYTES + 32768 + ff * 16) = o; }
    for (int f = tid - 128; f < 2048; f += NTHR - 128) {
        const int dir = f >> 10, ff = f & 1023, mb = ff >> 8, ks = (ff >> 6) & 3, ln = ff & 63, g = ln >> 5, r = ln & 31;
        const int d = mb * 32 + r; const float gl = sGc[dir * 64 + 63]; float v[8];
#pragma unroll
        for (int j = 0; j < 8; ++j) { const int cp = 16 * ks + 8 * (j >> 2) + 4 * g + (j & 3), cn = dir ? 63 - cp : cp; v[j] = KS[cn * PS + d] * __expf(gl - sGc[dir * 64 + cp]); }
        v4u o; o.x = pg8::pkbf(v[0], v[1]); o.y = pg8::pkbf(v[2], v[3]); o.z = pg8::pkbf(v[4], v[5]); o.w = pg8::pkbf(v[6], v[7]);
        *(v4u*)(ops0 + (size_t)dir * OPS_BYTES + 16384 + ff * 16) = o; }
    for (int f = tid - 128; f < 1024; f += NTHR - 128) {
        const int dir = f >> 9, ff = f & 511, mb = ff >> 8, ks = (ff >> 6) & 3, ln = ff & 63, g = ln >> 5, r = ln & 31;
        const int cp = mb * 32 + r, cn = dir ? 63 - cp : cp; const float gc = sGc[dir * 64 + cp]; float v[8];
#pragma unroll
        for (int j = 0; j < 8; ++j) { const int sp = 16 * ks + 8 * (j >> 2) + 4 * g + (j & 3), sn = dir ? 63 - sp : sp;
            v[j] = (cp >= sp) ? QK[cn * 64 + sn] * qs * __expf(gc - sGc[dir * 64 + sp]) : 0.f; }
        v4u o; o.x = pg8::pkbf(v[0], v[1]); o.y = pg8::pkbf(v[2], v[3]); o.z = pg8::pkbf(v[4], v[5]); o.w = pg8::pkbf(v[6], v[7]);
        *(v4u*)(ops0 + (size_t)dir * OPS_BYTES + 49152 + ff * 16) = o; }
    }
    __syncthreads();
    PREP_MARK(4);
    PREP_MARK(5);
    { const int dir = wave >> 2, wq = wave & 3, r = lane & 31, hh = lane >> 5;
      unsigned tdoff = dir ? (unsigned)L_NR : (unsigned)L_KK; asm volatile("" : "+v"(tdoff)); const LAS float* Td = (const LAS float*)(lds + tdoff); const LAS float* bet = sBeta + dir * 64; const LAS float* bee = sBe + dir * 64;
      unsigned char* opsd = ops0 + (size_t)dir * OPS_BYTES;
      f32x16 zero16;
#pragma unroll
      for (int q = 0; q < 16; ++q) zero16[q] = 0.f;
      bf16x8 bu[4], aw[4];
#pragma unroll
      for (int ks = 0; ks < 4; ++ks) { float t[8], w8[8];
#pragma unroll
        for (int q = 0; q < 8; ++q) { const int jp = 16 * ks + 8 * hh + q, jn = dir ? 63 - jp : jp; t[q] = bf_1(VSb[jn * VSS + 32 * wq + r]) * bet[jp]; w8[q] = KS[jn * PS + 32 * wq + r] * bee[jp]; }
        v4u pu; pu.x = pg8::pkbf(t[0], t[1]); pu.y = pg8::pkbf(t[2], t[3]); pu.z = pg8::pkbf(t[4], t[5]); pu.w = pg8::pkbf(t[6], t[7]); bu[ks] = __builtin_bit_cast(bf16x8, pu);
        v4u pw; pw.x = pg8::pkbf(w8[0], w8[1]); pw.y = pg8::pkbf(w8[2], w8[3]); pw.z = pg8::pkbf(w8[4], w8[5]); pw.w = pg8::pkbf(w8[6], w8[7]); aw[ks] = __builtin_bit_cast(bf16x8, pw); }
#pragma unroll
      for (int mb = 0; mb < 2; ++mb) {
        bf16x8 tf[4];
#pragma unroll
        for (int ks = 0; ks < 4; ++ks) { const f32x4 t0 = *(const LAS f32x4*)(Td + (32 * mb + r) * 64 + 16 * ks + 8 * hh), t1 = *(const LAS f32x4*)(Td + (32 * mb + r) * 64 + 16 * ks + 8 * hh + 4);
            v4u pt; pt.x = pg8::pkbf(t0.x, t0.y); pt.y = pg8::pkbf(t0.z, t0.w); pt.z = pg8::pkbf(t1.x, t1.y); pt.w = pg8::pkbf(t1.z, t1.w); tf[ks] = __builtin_bit_cast(bf16x8, pt); }
        f32x16 cu = zero16, cw = zero16;
#pragma unroll
        for (int ks = 0; ks < 4; ++ks) { cu = MFMA32(tf[ks], bu[ks], cu); cw = MFMA32(aw[ks], tf[ks], cw); }
        { v4u o0, o1; o0.x = pg8::pkbf(cu[0], cu[1]); o0.y = pg8::pkbf(cu[2], cu[3]); o0.z = pg8::pkbf(cu[4], cu[5]); o0.w = pg8::pkbf(cu[6], cu[7]);
          o1.x = pg8::pkbf(cu[8], cu[9]); o1.y = pg8::pkbf(cu[10], cu[11]); o1.z = pg8::pkbf(cu[12], cu[13]); o1.w = pg8::pkbf(cu[14], cu[15]);
          unsigned char* dst = opsd + 57344 + ((wq * 2 + mb) * 64 + lane) * 32; *(v4u*)dst = o0; *(v4u*)(dst + 16) = o1; }
        { v4u n0, n1; n0.x = pg8::pkbf(-cw[0], -cw[1]); n0.y = pg8::pkbf(-cw[2], -cw[3]); n0.z = pg8::pkbf(-cw[4], -cw[5]); n0.w = pg8::pkbf(-cw[6], -cw[7]);
          n1.x = pg8::pkbf(-cw[8], -cw[9]); n1.y = pg8::pkbf(-cw[10], -cw[11]); n1.z = pg8::pkbf(-cw[12], -cw[13]); n1.w = pg8::pkbf(-cw[14], -cw[15]);
          *(v4u*)(opsd + ((mb * 8 + 2 * wq) * 64 + lane) * 16) = n0; *(v4u*)(opsd + ((mb * 8 + 2 * wq + 1) * 64 + lane) * 16) = n1; }
      } }
    __syncthreads();
    PREP_MARK(6);
}

__device__ __forceinline__ const unsigned char* scan_ops(CArgsP a, int b, int h, int dir, int st, int& task, int& rowb) {
    const int seg = st >= 4, step = seg ? st - 4 : st, NC = seg ? 64 : 4, n = dir ? NC - 1 - step : step;
    task = b * 272 + (seg ? 16 + h * 64 + n : h * 4 + n); rowb = b * TPB + (seg ? 256 : 0) + 64 * n;
    return a->ws + WS_A + ((size_t)task * 2 + dir) * OPS_BYTES;
}
__device__ __forceinline__ void dn_scan_chain(CArgsP a, int chain, LAS unsigned char* lds, int tid) {
    const int wave = __builtin_amdgcn_readfirstlane(tid >> 6), lane = tid & 63;
    const int b = chain >> 3, h = (chain >> 1) & 3, dir = chain & 1;
    const int g = lane >> 5, e = lane & 31, sl = wave & 3;
    bf16* OFB = (bf16*)a->out + (size_t)dir * MROWS * 512;
    const float* GL = (const float*)(a->ws + WS_GL);
    f32x16 S[4];
#pragma unroll
    for (int i = 0; i < 4; ++i)
#pragma unroll
        for (int r = 0; r < 16; ++r) S[i][r] = 0.f;
    v4u R[7], U[4]; float gl; int task, rowb;
    { const unsigned char* ops = scan_ops(a, b, h, dir, 0, task, rowb);
#pragma unroll
      for (int i = 0; i < 7; ++i) R[i] = *(const v4u*)(ops + 16 * (tid + 512 * i));
#pragma unroll
      for (int mb = 0; mb < 2; ++mb) { const v4u* up = (const v4u*)(ops + 57344 + ((sl * 2 + mb) * 64 + lane) * 32); U[2 * mb] = up[0]; U[2 * mb + 1] = up[1]; }
      gl = GL[task * 2 + dir];
#pragma unroll
      for (int i = 0; i < 7; ++i) *(LAS v4u*)(lds + 16 * (tid + 512 * i)) = R[i]; }
    __syncthreads();
    for (int st = 0; st < 68; ++st) {
        const LAS unsigned char* buf = lds + (st & 1) * 57344;
        const int rowc = rowb; const float glc = gl; v4u Uc[4];
#pragma unroll
        for (int i = 0; i < 4; ++i) Uc[i] = U[i];
        if (st + 1 < 68) { const unsigned char* ops = scan_ops(a, b, h, dir, st + 1, task, rowb);
#pragma unroll
            for (int i = 0; i < 7; ++i) R[i] = *(const v4u*)(ops + 16 * (tid + 512 * i));
#pragma unroll
            for (int mb = 0; mb < 2; ++mb) { const v4u* up = (const v4u*)(ops + 57344 + ((sl * 2 + mb) * 64 + lane) * 32); U[2 * mb] = up[0]; U[2 * mb + 1] = up[1]; }
            gl = GL[task * 2 + dir]; }
        if (wave < 4) {
            const LAS bf16x8* NW = (const LAS bf16x8*)buf + lane; const LAS bf16x8* KT = (const LAS bf16x8*)(buf + 16384) + lane;
            const LAS bf16x8* QD = (const LAS bf16x8*)(buf + 32768) + lane; const LAS bf16x8* QKp = (const LAS bf16x8*)(buf + 49152) + lane;
            bf16x8 Sb[8];
#pragma unroll
            for (int ks = 0; ks < 8; ++ks) Sb[ks] = pack8(S[ks >> 1], ks & 1);
            f32x16 vn[2];
#pragma unroll
            for (int mb = 0; mb < 2; ++mb) {
                const v4u u0 = Uc[2 * mb], u1 = Uc[2 * mb + 1];
                f32x16 c;
                c[0] = bf_lo(u0.x); c[1] = bf_hi(u0.x); c[2] = bf_lo(u0.y); c[3] = bf_hi(u0.y); c[4] = bf_lo(u0.z); c[5] = bf_hi(u0.z); c[6] = bf_lo(u0.w); c[7] = bf_hi(u0.w);
                c[8] = bf_lo(u1.x); c[9] = bf_hi(u1.x); c[10] = bf_lo(u1.y); c[11] = bf_hi(u1.y); c[12] = bf_lo(u1.z); c[13] = bf_hi(u1.z); c[14] = bf_lo(u1.w); c[15] = bf_hi(u1.w);
#pragma unroll
                for (int ks = 0; ks < 8; ++ks) c = MFMA32(NW[(mb * 8 + ks) * 64], Sb[ks], c);
                vn[mb] = c; }
            bf16x8 Vb[4];
#pragma unroll
            for (int ks = 0; ks < 4; ++ks) Vb[ks] = pack8(vn[ks >> 1], ks & 1);
#pragma unroll
            for (int mb = 0; mb < 2; ++mb) {
                f32x16 o;
#pragma unroll
                for (int r = 0; r < 16; ++r) o[r] = 0.f;
#pragma unroll
                for (int ks = 0; ks < 8; ++ks) o = MFMA32(QD[(mb * 8 + ks) * 64], Sb[ks], o);
#pragma unroll
                for (int ks = 0; ks < 4; ++ks) o = MFMA32(QKp[(mb * 4 + ks) * 64], Vb[ks], o);
#pragma unroll
                for (int r = 0; r < 16; ++r) { const int cp = mb * 32 + (r & 3) + 8 * (r >> 2) + 4 * g; const int cn = dir ? 63 - cp : cp;
                    OFB[(size_t)(rowc + cn) * 512 + h * 128 + sl * 32 + e] = (bf16)(pg8::pkbf(o[r], 0.f) & 0xffffu); } }
#pragma unroll
            for (int mb = 0; mb < 4; ++mb) { f32x16 c = S[mb] * glc;
#pragma unroll
                for (int ks = 0; ks < 4; ++ks) c = MFMA32(KT[(mb * 4 + ks) * 64], Vb[ks], c);
                S[mb] = c; }
        }
        if (st + 1 < 68) { LAS unsigned char* nb = lds + ((st + 1) & 1) * 57344;
#pragma unroll
            for (int i = 0; i < 7; ++i) *(LAS v4u*)(nb + 16 * (tid + 512 * i)) = R[i]; }
        __syncthreads();
    }
}

__device__ __forceinline__ void unpack8(const v4u w, float (&f)[8]) { f[0] = bf_lo(w.x); f[1] = bf_hi(w.x); f[2] = bf_lo(w.y); f[3] = bf_hi(w.y); f[4] = bf_lo(w.z); f[5] = bf_hi(w.z); f[6] = bf_lo(w.w); f[7] = bf_hi(w.w); }
__device__ __forceinline__ float sum16(float v) { v += __shfl_xor(v, 1); v += __shfl_xor(v, 2); v += __shfl_xor(v, 4); v += __shfl_xor(v, 8); return v; }
__device__ __forceinline__ void post2_row(CArgsP a, int l, int row, int lane, float lam, float one_m_li) {
    const int h = lane >> 4, pt = lane & 15, e0 = 8 * pt;
    const bf16* od = (const bf16*)(a->ws + WS_A + A_ODA) + (size_t)row * 1024;
    bf16* oabc = (bf16*)(a->ws + WS_A + A_MRGF); bf16* oa = oabc + (size_t)row * 512;
    const bf16* of = (const bf16*)a->out + (size_t)row * 512; const bf16* ob = of + (size_t)MROWS * 512;
    bf16* oc = oabc + ((size_t)2 * MROWS + row) * 512;
    { const bf16* og = (const bf16*)(a->ws + WS_PATT) + (size_t)row * PATT_LD + C_GQQ; *(v4u*)(oabc + ((size_t)MROWS + row) * 512 + 8 * lane) = *(const v4u*)(og + 8 * lane); }
    const bf16* zr = (const bf16*)(a->ws + WS_PATT) + (size_t)row * PATT_LD + C_Z;
    float o1[8], o2[8], ff[8], fb[8], zz[8];
    unpack8(*(const v4u*)(od + (h * 2) * 128 + e0), o1); unpack8(*(const v4u*)(od + (h * 2 + 1) * 128 + e0), o2);
    unpack8(*(const v4u*)(of + h * 128 + e0), ff); unpack8(*(const v4u*)(ob + h * 128 + e0), fb); unpack8(*(const v4u*)(zr + h * 128 + e0), zz);
    const float* sg = a->in[11] + l * 128 + e0; const float* ng = a->in[17] + l * 128 + e0;
    float d[8], c[8], s1 = 0.f, s2 = 0.f;
#pragma unroll
    for (int i = 0; i < 8; ++i) { d[i] = o1[i] - lam * o2[i]; c[i] = ff[i] + fb[i]; s1 += d[i] * d[i]; s2 += c[i] * c[i]; }
    s1 = sum16(s1); s2 = sum16(s2);
    const float r1 = __builtin_amdgcn_rsqf(s1 * (1.f / 128.f) + NEPS) * one_m_li, r2 = __builtin_amdgcn_rsqf(s2 * (1.f / 128.f) + NEPS);
    float ra[8], rc[8];
#pragma unroll
    for (int i = 0; i < 8; ++i) { ra[i] = d[i] * r1 * sg[i]; rc[i] = c[i] * r2 * ng[i] * silu_f(zz[i]); }
    v4u wa, wc; wa.x = pg8::pkbf(ra[0], ra[1]); wa.y = pg8::pkbf(ra[2], ra[3]); wa.z = pg8::pkbf(ra[4], ra[5]); wa.w = pg8::pkbf(ra[6], ra[7]);
    wc.x = pg8::pkbf(rc[0], rc[1]); wc.y = pg8::pkbf(rc[2], rc[3]); wc.z = pg8::pkbf(rc[4], rc[5]); wc.w = pg8::pkbf(rc[6], rc[7]);
    *(v4u*)(oa + h * 128 + e0) = wa; *(v4u*)(oc + h * 128 + e0) = wc;
}

__device__ __forceinline__ void phase_act(CArgsP a, int l, int gtid, int nthr) {
    bf16* AU = (bf16*)(a->ws + WS_A);
    const float* cw = a->in[24] + (size_t)l * 3 * DFF; const float* cb = a->in[25] + (size_t)l * DFF;
    for (int it = gtid; it < 2176 * 352; it += nthr) {
        const int cgp = it % 352, strip = it / 352, r0 = strip * 8, p0 = r0 % TPB, col = cgp * 8;
        const bool topv = (p0 != 0 && p0 != 256), botv = (p0 + 7 != 255 && p0 + 7 != TPB - 1);
        const bf16* ap = AU + (size_t)r0 * AU_LD + col;
        v4u ar[10], ur[8];
        ar[0] = (v4u){0u, 0u, 0u, 0u}; if (topv) ar[0] = *(const v4u*)(ap - AU_LD);
#pragma unroll
        for (int i = 0; i < 8; ++i) { ar[i + 1] = *(const v4u*)(ap + (size_t)i * AU_LD); ur[i] = *(const v4u*)(ap + (size_t)i * AU_LD + DFF); }
        ar[9] = (v4u){0u, 0u, 0u, 0u}; if (botv) ar[9] = *(const v4u*)(ap + (size_t)8 * AU_LD);
        float w0[8], w1[8], w2[8], bb[8];
#pragma unroll
        for (int i = 0; i < 8; ++i) { w0[i] = cw[col + i]; w1[i] = cw[DFF + col + i]; w2[i] = cw[2 * DFF + col + i]; bb[i] = cb[col + i]; }
#pragma unroll
        for (int i = 0; i < 8; ++i) { float pm[8], pc[8], pn[8], pu[8], o[8];
            unpack8(ar[i], pm); unpack8(ar[i + 1], pc); unpack8(ar[i + 2], pn); unpack8(ur[i], pu);
#pragma unroll
            for (int k = 0; k < 8; ++k) o[k] = silu_f(w0[k] * pm[k] + w1[k] * pc[k] + w2[k] * pn[k] + bb[k]) * pu[k];
            v4u w; w.x = pg8::pkbf(o[0], o[1]); w.y = pg8::pkbf(o[2], o[3]); w.z = pg8::pkbf(o[4], o[5]); w.w = pg8::pkbf(o[6], o[7]);
            *(v4u*)(AU + (size_t)(r0 + i) * AU_LD + DFF + col) = w; }
    }
}

constexpr size_t WS_EP = WS_END, WS_EA = WS_END + 6127616, WS_EU = WS_EA + 3063808, WS_END2 = WS_EU + 3063808;
__device__ __forceinline__ void phase_act_fix(CArgsP a, int l, int gtid, int nthr) {
    bf16* ACT = (bf16*)(a->ws + WS_A); const float* EP = (const float*)(a->ws + WS_EP); const bf16* EA = (const bf16*)(a->ws + WS_EA); const bf16* EU = (const bf16*)(a->ws + WS_EU);
    const float* cw = a->in[24] + (size_t)l * 3 * DFF;
    for (int it = gtid; it < 544 * 352; it += nthr) {
        const int cgp = it % 352, e = it / 352, col = cgp * 8, bot = e & 1, row = (e >> 1) * 64 + (bot ? 63 : 0), p = row % TPB;
        const bool nbv = bot ? (p != 255 && p != TPB - 1) : (p != 0 && p != 256);
        float nb[8] = {0.f, 0.f, 0.f, 0.f, 0.f, 0.f, 0.f, 0.f}, uu[8];
        if (nbv) unpack8(*(const v4u*)(EA + (size_t)(bot ? e + 1 : e - 1) * DFF + col), nb);
        unpack8(*(const v4u*)(EU + (size_t)e * DFF + col), uu);
        const f32x4 p0 = *(const f32x4*)(EP + (size_t)e * DFF + col), p1 = *(const f32x4*)(EP + (size_t)e * DFF + col + 4);
        const float* wm = cw + (bot ? 2 * DFF : 0) + col;
        const float pp[8] = {p0.x, p0.y, p0.z, p0.w, p1.x, p1.y, p1.z, p1.w}; float o[8];
#pragma unroll
        for (int k = 0; k < 8; ++k) o[k] = silu_f(pp[k] + wm[k] * nb[k]) * uu[k];
        v4u w; w.x = pg8::pkbf(o[0], o[1]); w.y = pg8::pkbf(o[2], o[3]); w.z = pg8::pkbf(o[4], o[5]); w.w = pg8::pkbf(o[6], o[7]);
        *(v4u*)(ACT + (size_t)row * DFF + col) = w; }
}

typedef pg8::Epi<1, 0> EpiIn; typedef pg8::Epi<2, 0> EpiGate; typedef pg8::Epi<0, 0> EpiSt;
__global__ void __launch_bounds__(NTHR, 2) mk_fwd(Args args_unused) {
    extern __shared__ __attribute__((aligned(16))) unsigned char lds_raw[];
    LAS unsigned char* lds = (LAS unsigned char*)lds_raw;
    volatile LAS unsigned* MISC = (volatile LAS unsigned*)(lds + MISC_OFF);
    const int tid = threadIdx.x, lane = tid & 63, wave = __builtin_amdgcn_readfirstlane(tid >> 6);
    const int G = gridDim.x, bid = blockIdx.x;
    const int gw = bid * NWAVES + wave, NGW = G * NWAVES;
    for (int u = tid; u < 64; u += NTHR) MISC[u] = 0u;
    __syncthreads();
    { ARGS_HERE(A); (void)xcd_barrier_post((unsigned*)(A->ws + WS_CTL) + CW_BAR, MISC); }
#ifndef DUP_MASK
#define DUP_MASK 0
#endif
#ifndef PROF_A
#define PROF_A 0
#endif
#ifndef PROF_B
#define PROF_B 0
#endif
    unsigned long long prof_a = 0ull, prof_b = 0ull, prof_last = 0ull; int prof_ph = 0;
#define GRID_BAR() do { ARGS_HERE(B_); XcdBarrier bar; bar.bar = (unsigned*)(B_->ws + WS_CTL) + CW_BAR; bar.x = xb_xcc_id(); bar.st = MISC; xcd_barrier(bar); \
    if (PROF_A | PROF_B) { const unsigned long long t_ = rt(); if ((PROF_A >> prof_ph) & 1) prof_a += t_ - prof_last; if ((PROF_B >> prof_ph) & 1) prof_b += t_ - prof_last; prof_last = t_; ++prof_ph; } } while (0)
#define PHASE_IDS() int ptid = threadIdx.x; asm volatile("" : "+v"(ptid)); const int plane = ptid & 63; const int pwave = __builtin_amdgcn_readfirstlane(ptid >> 6); const int pgw = bid * NWAVES + pwave; (void)plane; (void)pgw

    const unsigned long long prof_t0 = (PROF_A | PROF_B) ? rt() : 0ull;
    { ARGS_HERE(A); phase_mod(A, lds, tid, bid, G); phase_convert(A, 0, lds, gw, NGW, wave, lane); }
    { ARGS_HERE(A); if (A->out == nullptr) cg::this_grid().sync(); }
    GRID_BAR();
    if ((PROF_A >> 15) & 1) prof_a += rt() - prof_t0;

    for (int l = 0; l < NLAYER; ++l) {
        if (PROF_A | PROF_B) { prof_ph = 0; prof_last = rt(); }
        { ARGS_HERE(A); PHASE_IDS();
          if (l == 0) phase_norm(A, 0, 0, pgw, NGW, plane, 0);
          else { phase_convert(A, l, lds, pgw, NGW, pwave, plane, 7936, 9344); phase_norm(A, l, 0, pgw, NGW, plane, 2); } }
        GRID_BAR();
        { ARGS_HERE(A); PHASE_IDS(); unsigned char* ws = A->ws;
          pg8::Gemm g{(bf16*)(ws + WS_HN), (bf16*)(ws + WS_WT) + WT_IN, MROWS, 4608, 1024, 1024}; pg8::StaticOrder S; S.init(MROWS, 4608, G, bid);
          EpiIn E{(bf16*)(ws + WS_PATT), PATT_LD, (bf16*)A->out, nullptr, 0, 0, nullptr, nullptr, nullptr};
          pg8::gemm_phase<EpiIn, pg8::StaticOrder, true, true>(lds, g, S, E);
          if (DUP_MASK & 2) pg8::gemm_phase<EpiIn, pg8::StaticOrder, true, true>(lds, g, S, E); }
        GRID_BAR();
        { ARGS_HERE(A); PHASE_IDS();
          for (;;) {
            if (ptid == 0) MISC[8] = __hip_atomic_fetch_add((unsigned*)(A->ws + WS_CTL) + CW_Q + 64 * l + 32, 1u, __ATOMIC_RELAXED, __HIP_MEMORY_SCOPE_AGENT);
            __syncthreads();
            const int q = __builtin_amdgcn_readfirstlane((int)MISC[8]);
            __syncthreads();
            if (q >= 1088 + 272) break;
            if (q < 1088) { dn_prep_task(A, l, q, lds, ptid); continue; }
            const int r0 = (q - 1088) * 64 + pwave * 8;
            for (int r = 0; r < 8; ++r) qk_row(A, l, r0 + r, plane);
          } }
        GRID_BAR();
        for (int pass = ((DUP_MASK & 8) ? 0 : 1); pass < 2; ++pass)
        { const int nunits = 32 + 1536 + (l < NLAYER - 1 ? 96 : 0);
          for (;;) {
            ARGS_HERE(A); PHASE_IDS(); unsigned char* ws = A->ws;
            if (ptid == 0) MISC[8] = __hip_atomic_fetch_add((unsigned*)(ws + WS_CTL) + CW_Q + 64 * l + 16 * pass, 1u, __ATOMIC_RELAXED, __HIP_MEMORY_SCOPE_AGENT);
            __syncthreads();
            const int q = __builtin_amdgcn_readfirstlane((int)MISC[8]);
            __syncthreads();
            if (q >= nunits) break;
            if (q < 32) { dn_scan_chain(A, q, lds, ptid); if (DUP_MASK & 128) { __syncthreads(); dn_scan_chain(A, q, lds, ptid); } asm volatile("s_waitcnt vmcnt(0)" ::: "memory"); __syncthreads(); continue; }
            bf16* PATT = (bf16*)(ws + WS_PATT); bf16* ODA = (bf16*)(ws + WS_A + A_ODA);
            int u = q - 32, combo, qt, NT;
            if (u < 1536) { combo = u >> 4; qt = 1 + (u & 15); NT = 68; } else { combo = u - 1536; qt = 0; NT = 4; }
            const attn_body::bf16 *Qp, *Kp, *Vp; attn_body::bf16* Op; int PO;
            if (combo < 64) { const int b = combo >> 4, vh = combo & 15, hh = vh >> 1, vhalf = vh & 1, h = vh >> 2;
                const size_t r0 = (size_t)b * TPB; const size_t rq = r0 + (size_t)qt * 256;
                Qp = (const attn_body::bf16*)(PATT + rq * PATT_LD + C_DAQ + hh * 64); Kp = (const attn_body::bf16*)(PATT + r0 * PATT_LD + C_DAK + hh * 64);
                Vp = (const attn_body::bf16*)(PATT + r0 * PATT_LD + C_DAV + h * 128 + vhalf * 64); Op = (attn_body::bf16*)(ODA + rq * 1024 + hh * 128 + vhalf * 64); PO = 1024; }
            else { const int cc = combo - 64, b = cc >> 3, hq = cc & 7, kvh = hq >> 2;
                const size_t r0 = (size_t)b * TPB; const size_t rq = r0 + (size_t)qt * 256;
                Qp = (const attn_body::bf16*)(PATT + rq * PATT_LD + C_GQQ + hq * 64); Kp = (const attn_body::bf16*)(PATT + r0 * PATT_LD + C_GQK + kvh * 64);
                Vp = (const attn_body::bf16*)(PATT + r0 * PATT_LD + C_GQV + kvh * 64); Op = (attn_body::bf16*)(PATT + rq * PATT_LD + C_GQQ + hq * 64); PO = PATT_LD;
                if (pass == 0) { Op = (attn_body::bf16*)((bf16*)(ws + WS_OC) + rq * 512 + hq * 64); PO = 512; } }
            attn_body::attn_unit<8>(Qp, Kp, Vp, Op, PATT_LD, PATT_LD, PATT_LD, PO, NT, (char*)lds_raw);
          } }
        GRID_BAR();
        { ARGS_HERE(A); PHASE_IDS();
          const float lam_init = 0.8f - 0.6f * expf(-0.3f * (float)l);
          const float* lp = A->in[10] + l * 256;
          const float s01 = wave_sum(lp[plane] * lp[64 + plane]), s23 = wave_sum(lp[128 + plane] * lp[192 + plane]);
          const float lam = expf(s01) - expf(s23) + lam_init;
          for (int row = pgw; row < MROWS; row += NGW) post2_row(A, l, row, plane, lam, 1.f - lam_init);
          if (DUP_MASK & 16) for (int row = pgw; row < MROWS; row += NGW) post2_row(A, l, row, plane, lam, 1.f - lam_init); }
        { ARGS_HERE(A); PHASE_IDS(); unsigned char* ws = A->ws;
          pg8::Gemm g{(bf16*)(ws + WS_HN), (bf16*)(ws + WS_WT) + WT_IN + (size_t)4608 * 1024, MROWS, 3072, 1024, 1024}; pg8::StaticOrder S; S.init(l == NLAYER - 1 ? 16384 : MROWS, 3072, G, bid, l == NLAYER - 1);
          EpiGate E{(bf16*)(ws + WS_A), 3072, nullptr, nullptr, 0, 0, nullptr, nullptr, nullptr};
          pg8::gemm_phase<EpiGate, pg8::StaticOrder, true, true>(lds, g, S, E);
          if (DUP_MASK & 32) pg8::gemm_phase<EpiGate, pg8::StaticOrder, true, true>(lds, g, S, E); }
        GRID_BAR();
        { ARGS_HERE(A); PHASE_IDS(); unsigned char* ws = A->ws;
          pg8::ChainOrder S; S.so.init(l == NLAYER - 1 ? 16384 : MROWS, 1024, G, bid, l == NLAYER - 1);
          pg8::Gemm g{(bf16*)(ws + WS_A + A_MRGF), (bf16*)(ws + WS_WT) + WT_BRA, 3 * MROWS, 3072, 512, 512, 0};
          pg8::Epi<3, 4> E{(bf16*)A->out, 1024, nullptr, (bf16*)(ws + WS_A), 3072, 0, nullptr, nullptr, nullptr};
          pg8::gemm_phase<pg8::Epi<3, 4>, pg8::ChainOrder, true, true>(lds, g, S, E); }
        GRID_BAR();
        { const int nrnd = (l < NLAYER - 1) ? 2 : 1;
          for (int rnd = 0; rnd < nrnd; ++rnd) {
            { ARGS_HERE(A); PHASE_IDS(); unsigned char* ws = A->ws;
              const float* mp = (const float*)(ws + WS_MOD) + (size_t)l * 5 * 6144 + 2 * 1024;
              pg8::Gemm g{(bf16*)A->out, (bf16*)(ws + WS_WT) + WT_O, MROWS, 1024, 1024, 1024, 0}; pg8::StaticOrder S; S.init(rnd == 0 ? 16384 : 1024, 1024, G, bid, rnd == 0 ? 1 : 2);
              pg8::Epi<4, 0> E{nullptr, 0, nullptr, nullptr, 0, 0, (float*)(ws + WS_XS), mp, nullptr};
              pg8::gemm_phase<pg8::Epi<4, 0>, pg8::StaticOrder, true, true>(lds, g, S, E);
              if (rnd == 1 && bid >= 16) phase_norm(A, l, 1, (bid - 16) * NWAVES + pwave, (G - 16) * NWAVES, plane, 1); }
            GRID_BAR(); }
          { ARGS_HERE(A); PHASE_IDS(); phase_norm(A, l, 1, pgw, NGW, plane, (l < NLAYER - 1) ? 2 : 1); }
          GRID_BAR(); }
        { ARGS_HERE(A); PHASE_IDS(); unsigned char* ws = A->ws;
          pg8::Gemm g{(bf16*)(ws + WS_HN), (bf16*)(ws + WS_WT) + WT_1, MROWS, 5632, 1024, 1024}; pg8::StaticOrder S; S.init(l == NLAYER - 1 ? 16384 : MROWS, 5632, G, bid, l == NLAYER - 1);
          pg8::Epi<5, 0> E{(bf16*)(ws + WS_A), DFF, (bf16*)(ws + WS_EA), (const bf16*)(ws + WS_EU), 0, 0, (float*)(ws + WS_EP), A->in[24] + (size_t)l * 3 * DFF, (float*)(A->in[25] + (size_t)l * DFF)};
          pg8::gemm_phase<pg8::Epi<5, 0>, pg8::StaticOrder, true, true>(lds, g, S, E); }
        GRID_BAR();
        { ARGS_HERE(A); PHASE_IDS(); phase_act_fix(A, l, bid * NTHR + ptid, G * NTHR); }
        GRID_BAR();
        if (l < NLAYER - 1) {
          for (int rnd = 0; rnd < 2; ++rnd) {
            { ARGS_HERE(A); PHASE_IDS(); unsigned char* ws = A->ws;
              const float* mp = (const float*)(ws + WS_MOD) + (size_t)l * 5 * 6144 + 5 * 1024;
              pg8::Gemm g{(bf16*)(ws + WS_A), (bf16*)(ws + WS_WT) + WT_2, MROWS, 1024, 2816, DFF, 0}; pg8::StaticOrder S; S.init(rnd == 0 ? 16384 : 1024, 1024, G, bid, rnd == 0 ? 1 : 2);
              pg8::Epi<4, 0> E{nullptr, 0, nullptr, nullptr, 0, 0, (float*)(ws + WS_XS), mp, nullptr};
              pg8::gemm_phase<pg8::Epi<4, 0>, pg8::StaticOrder, true, true>(lds, g, S, E);
              if (rnd == 1 && bid >= 16) { const int gw2 = (bid - 16) * NWAVES + pwave, ngw2 = (G - 16) * NWAVES;
                  phase_convert(A, l + 1, lds, gw2, ngw2, pwave, plane, 0, 7936); phase_norm(A, l + 1, 0, gw2, ngw2, plane, 1); } }
            GRID_BAR(); }
        } else {
          ARGS_HERE(A); PHASE_IDS(); unsigned char* ws = A->ws;
          const float* mp = (const float*)(ws + WS_MOD) + (size_t)l * 5 * 6144 + 5 * 1024;
          pg8::Gemm g{(bf16*)(ws + WS_A), (bf16*)(ws + WS_WT) + WT_2, MROWS, 1024, 2816, DFF, 0}; pg8::StaticOrder S; S.init(16384, 1024, G, bid, 1);
          pg8::Epi<4, 1> E{nullptr, 0, nullptr, nullptr, 0, 0, (float*)(ws + WS_XS), mp, A->out};
          pg8::gemm_phase<pg8::Epi<4, 1>, pg8::StaticOrder, true, true>(lds, g, S, E);
          if (PROF_A | PROF_B) GRID_BAR();
        }
    }
    if (PREP_PROF && blockIdx.x == 0) { const unsigned long long extra = (unsigned long long)MISC[16 + PREP_SUBA] + ((unsigned long long)MISC[16 + PREP_SUBB] / 1000ull) * 100000ull, t0_ = rt(); while (rt() - t0_ < extra) __builtin_amdgcn_s_sleep(8); }
    if ((PROF_A | PROF_B) && blockIdx.x == 0) { const unsigned long long extra = prof_a + (prof_b / 1000ull) * 100000ull, t0_ = rt(); while (rt() - t0_ < extra) __builtin_amdgcn_s_sleep(8); }
}

extern "C" void kernel_launch(void* const* d_in, const int* in_sizes, int n_in, void* d_out, int out_size, void* d_ws, size_t ws_size, hipStream_t stream) {
    static int grid = 0;
    if (grid == 0) {
        if (n_in != 27 || out_size != 4 * 4096 * 1024 || ws_size < WS_END2) { fprintf(stderr, "kernel_launch: unexpected shapes (n_in %d out %d ws %zu need %zu)\n", n_in, out_size, ws_size, (size_t)WS_END2); grid = -1; return; }
        int dev = 0, cus = 0, per_cu = 0;
        hipGetDevice(&dev); hipDeviceGetAttribute(&cus, hipDeviceAttributeMultiprocessorCount, dev);
        if (hipFuncSetAttribute((const void*)mk_fwd, hipFuncAttributeMaxDynamicSharedMemorySize, LDS_BYTES) != hipSuccess) { fprintf(stderr, "kernel_launch: hipFuncSetAttribute failed\n"); grid = -1; return; }
        if (hipOccupancyMaxActiveBlocksPerMultiprocessor(&per_cu, (const void*)mk_fwd, NTHR, LDS_BYTES) != hipSuccess || per_cu < 1) { fprintf(stderr, "kernel_launch: occupancy query says %d\n", per_cu); per_cu = 1; }
        (void)hipGetLastError();
        grid = cus;
    }
    if (grid < 0) return;
    hipMemsetAsync((char*)d_ws + WS_CTL, 0, CTL_ZERO_BYTES, stream);
    Args a{};
    for (int i = 0; i < 27; ++i) a.in[i] = (const float*)d_in[i];
    a.out = (float*)d_out; a.ws = (unsigned char*)d_ws;
    void* kargs[] = {&a};
    hipError_t e = hipLaunchCooperativeKernel((const void*)mk_fwd, dim3(grid), dim3(NTHR), kargs, LDS_BYTES, stream);
    if (e != hipSuccess) fprintf(stderr, "kernel_launch: cooperative launch failed: %s (grid %d)\n", hipGetErrorString(e), grid);
}
```

```cpp
#include <hip/hip_runtime.h>
#include <hip/hip_cooperative_groups.h>
#include <hip/hip_bf16.h>
#include <cstdio>
#include <cstdint>
#include <cmath>
namespace cg = cooperative_groups;
namespace pg8 {
#define PG8_LAS __attribute__((address_space(3)))
typedef unsigned short bf16_t;
typedef short bf16x8 __attribute__((ext_vector_type(8)));
typedef float f32x4 __attribute__((ext_vector_type(4)));
typedef unsigned u32x4 __attribute__((ext_vector_type(4)));
constexpr int BM = 256, BK = 64, HALF = 128, HTB = HALF * BK * 2  , STAGE_BYTES = 8 * HTB, NXCD = 8, WGM = 8;

__host__ __device__ __forceinline__ int lds_byte(int r, int c) { const int st = (r >> 4) * 2 + (c >> 5), rr = r & 15, cc = c & 31, ob = rr * 64 + cc * 2; return st * 1024 + (ob ^ (((ob >> 9) & 1) << 5)); }
__host__ __device__ __forceinline__ void stage_rc(int b, int& R, int& C) { const int st = b / 1024, sb = b % 1024, swz = sb ^ (((sb >> 9) & 1) << 5); R = (st >> 1) * 16 + swz / 64; C = (st & 1) * 32 + (swz % 64) / 2; }
__host__ __device__ __forceinline__ int perm32(int rho) { const int n = rho >> 4, i = rho & 15; return 8 * (i >> 2) + 4 * n + (i & 3); }

struct Unit { int pm, pn; };
struct Gemm { const bf16_t* A; const bf16_t* Bt; int M, N, K, lda, ldb; };
struct OneUnit { Unit u; int has; __device__ __forceinline__ bool next(int i, Unit& o) const { if (i != 0 || !has) return false; o = u; return true; } __device__ __forceinline__ void a_ready(const Unit&) const {} __device__ __forceinline__ void done(const Unit&) const {} };

struct StaticOrder {
    int nM, nN, nwg, G, c, lat;
    __host__ __device__ void init(int M, int N, int G_, int c_, int lat_ = 0) { nM = M / BM; nN = N / BM; nwg = nM * nN; G = G_; c = c_; lat = lat_; }
    __host__ __device__ bool next(int i, Unit& u) const {
        const long L = (long)i * G + c; if (L >= nwg) return false;
        int wgid = (int)L; { const int q = nwg / NXCD, r = nwg % NXCD, xcd = wgid % NXCD, off = wgid / NXCD; wgid = (xcd < r ? xcd * (q + 1) : r * (q + 1) + (xcd - r) * q) + off; }
        const int nig = WGM * nN, gid = wgid / nig, fm = gid * WGM, gsz = (nM - fm) < WGM ? (nM - fm) : WGM;
        u.pm = fm + ((wgid % nig) % gsz); u.pn = (wgid % nig) / gsz; if (lat == 1) u.pm += u.pm / 16 + 1; else if (lat == 2) u.pm *= 17; return true;
    }
    __device__ __forceinline__ void a_ready(const Unit&) const {}
    __device__ __forceinline__ void done(const Unit&) const {}
};
struct ChainOrder { StaticOrder so; __device__ __forceinline__ bool next(int i, Unit& u) const { Unit t; if (!so.next(i / 3, t)) return false; const int sel = i - (i / 3) * 3; u.pm = t.pm + sel * 68; u.pn = t.pn + sel * 4; return true; } __device__ __forceinline__ void a_ready(const Unit&) const {} __device__ __forceinline__ void done(const Unit&) const {} };
__device__ __forceinline__ unsigned pkbf(float lo, float hi) { typedef float f2_t __attribute__((ext_vector_type(2))); typedef __bf16 b2_t __attribute__((ext_vector_type(2))); f2_t v = {lo, hi}; b2_t b = __builtin_convertvector(v, b2_t); return __builtin_bit_cast(unsigned, b); }
__device__ __forceinline__ float bflo(unsigned w) { return __uint_as_float(w << 16); }
__device__ __forceinline__ float bfhi(unsigned w) { return __uint_as_float(w & 0xffff0000u); }
__device__ __forceinline__ float dpp_ror1(float v) { return __builtin_bit_cast(float, __builtin_amdgcn_update_dpp(0, __builtin_bit_cast(int, v), 0x121, 0xf, 0xf, false)); }
__device__ __forceinline__ float dpp_ror15(float v) { return __builtin_bit_cast(float, __builtin_amdgcn_update_dpp(0, __builtin_bit_cast(int, v), 0x12F, 0xf, 0xf, false)); }
__device__ __forceinline__ float sigm(float x) { return __builtin_amdgcn_rcpf(1.0f + __expf(-x)); }
template <int MODE, int SUB> struct Epi {
    static constexpr bool PERM = true, AFTER_DRAIN = false;
    bf16_t* O; int ldc; bf16_t* O1; const bf16_t* G; int ldg; int gcol; float* F; const float* mod; float* OUT;
    __device__ __forceinline__ void operator()(const f32x4 (&acc)[2][2][4][2], const Unit& u, int wr, int wc, int fr, int fq) const {
        const int rl0 = wr * 64 + fr;
        const int rt = u.pm * BM + rl0;
        const int ct = u.pn * BM + wc * 32 + 8 * fq;
        if constexpr (MODE == 0 || MODE == 1 || MODE == 2) {
            bf16_t* base = O; int ld = ldc; int c0 = ct;
            if constexpr (MODE == 1) { if (u.pn >= 11) { base = O1; ld = 1792; c0 = ct - 2816; } else { ld = 2816; } }
#pragma unroll
            for (int ai = 0; ai < 2; ++ai)
#pragma unroll
                for (int m = 0; m < 4; ++m) { bf16_t* rowp = base + (size_t)(rt + ai * HALF + m * 16) * ld + c0;
#pragma unroll
                    for (int bj = 0; bj < 2; ++bj) { f32x4 v0 = acc[ai][bj][m][0], v1 = acc[ai][bj][m][1];
                        if constexpr (MODE == 2) { v0 = (f32x4){sigm(v0[0]), sigm(v0[1]), sigm(v0[2]), sigm(v0[3])}; v1 = (f32x4){sigm(v1[0]), sigm(v1[1]), sigm(v1[2]), sigm(v1[3])}; }
                        u32x4 w; w.x = pkbf(v0[0], v0[1]); w.y = pkbf(v0[2], v0[3]); w.z = pkbf(v1[0], v1[1]); w.w = pkbf(v1[2], v1[3]);
                        *(u32x4*)(rowp + bj * HALF) = w; } }
        } else if constexpr (MODE == 3) {
            int step = SUB, rtr = rt, ctr = ct, gc = gcol;
            if constexpr (SUB == 4) { step = u.pm / 68; rtr = (u.pm - step * 68) * BM + rl0; ctr = (u.pn & 3) * BM + wc * 32 + 8 * fq; gc = step * 1024; }
#pragma unroll
            for (int ai = 0; ai < 2; ++ai)
#pragma unroll
                for (int m = 0; m < 4; ++m) { const size_t row = (size_t)(rtr + ai * HALF + m * 16);
#pragma unroll
                    for (int bj = 0; bj < 2; ++bj) { const int col = ctr + bj * HALF;
                        const u32x4 gw = *(const u32x4*)(G + row * ldg + gc + col);
                        f32x4 v0 = acc[ai][bj][m][0], v1 = acc[ai][bj][m][1];
                        v0 = v0 * (f32x4){bflo(gw.x), bfhi(gw.x), bflo(gw.y), bfhi(gw.y)}; v1 = v1 * (f32x4){bflo(gw.z), bfhi(gw.z), bflo(gw.w), bfhi(gw.w)};
                        bf16_t* op = O + row * ldc + col;
                        if (step != 0) { const u32x4 pw = *(const u32x4*)op;
                            v0 = v0 + (f32x4){bflo(pw.x), bfhi(pw.x), bflo(pw.y), bfhi(pw.y)}; v1 = v1 + (f32x4){bflo(pw.z), bfhi(pw.z), bflo(pw.w), bfhi(pw.w)}; }
                        u32x4 w; w.x = pkbf(v0[0], v0[1]); w.y = pkbf(v0[2], v0[3]); w.z = pkbf(v1[0], v1[1]); w.w = pkbf(v1[2], v1[3]); *(u32x4*)op = w; } }
        } else if constexpr (MODE == 5) {
            const int j0 = u.pn * 128 + wc * 32 + 8 * fq;
            float w0[8], w1[8], w2[8], bb[8];
            { const f32x4 t0 = *(const f32x4*)(mod + j0), t1 = *(const f32x4*)(mod + j0 + 4), t2 = *(const f32x4*)(mod + 2816 + j0), t3 = *(const f32x4*)(mod + 2816 + j0 + 4),
                          t4 = *(const f32x4*)(mod + 5632 + j0), t5 = *(const f32x4*)(mod + 5632 + j0 + 4), t6 = *(const f32x4*)(OUT + j0), t7 = *(const f32x4*)(OUT + j0 + 4);
#pragma unroll
              for (int k = 0; k < 4; ++k) { w0[k] = t0[k]; w0[k + 4] = t1[k]; w1[k] = t2[k]; w1[k + 4] = t3[k]; w2[k] = t4[k]; w2[k + 4] = t5[k]; bb[k] = t6[k]; bb[k + 4] = t7[k]; } }
#pragma unroll
            for (int ai = 0; ai < 2; ++ai)
#pragma unroll
                for (int m = 0; m < 4; ++m) { const size_t row = (size_t)(rt + ai * HALF + m * 16);
                    float av[8], uv[8], pv[8], nv[8];
#pragma unroll
                    for (int k = 0; k < 8; ++k) { av[k] = acc[ai][0][m][k >> 2][k & 3]; uv[k] = acc[ai][1][m][k >> 2][k & 3];
                        const float ps = dpp_ror1(av[k]), ns = dpp_ror15(av[k]);
                        const float pc = (m > 0) ? dpp_ror1(acc[ai][0][(m > 0) ? m - 1 : 0][k >> 2][k & 3]) : 0.f;
                        const float nc = (m < 3) ? dpp_ror15(acc[ai][0][(m < 3) ? m + 1 : 3][k >> 2][k & 3]) : 0.f;
                        pv[k] = (fr == 0) ? pc : ps; nv[k] = (fr == 15) ? nc : ns; }
                    const bool top = (m == 0 && fr == 0), bot = (m == 3 && fr == 15);
                    if (!top && !bot) { float o[8];
#pragma unroll
                        for (int k = 0; k < 8; ++k) { const float pre = w0[k] * pv[k] + w1[k] * av[k] + w2[k] * nv[k] + bb[k]; o[k] = pre * __builtin_amdgcn_rcpf(1.f + __expf(-pre)) * uv[k]; }
                        u32x4 w; w.x = pkbf(o[0], o[1]); w.y = pkbf(o[2], o[3]); w.z = pkbf(o[4], o[5]); w.w = pkbf(o[6], o[7]); *(u32x4*)(O + row * ldc + j0) = w; }
                    else { const size_t eo = (size_t)((row >> 6) * 2 + (bot ? 1 : 0)) * 2816 + j0; float pp[8];
#pragma unroll
                        for (int k = 0; k < 8; ++k) pp[k] = w1[k] * av[k] + bb[k] + (top ? w2[k] * nv[k] : w0[k] * pv[k]);
                        *(f32x4*)(F + eo) = (f32x4){pp[0], pp[1], pp[2], pp[3]}; *(f32x4*)(F + eo + 4) = (f32x4){pp[4], pp[5], pp[6], pp[7]};
                        u32x4 wa, wu; wa.x = pkbf(av[0], av[1]); wa.y = pkbf(av[2], av[3]); wa.z = pkbf(av[4], av[5]); wa.w = pkbf(av[6], av[7]);
                        wu.x = pkbf(uv[0], uv[1]); wu.y = pkbf(uv[2], uv[3]); wu.z = pkbf(uv[4], uv[5]); wu.w = pkbf(uv[6], uv[7]);
                        *(u32x4*)(O1 + eo) = wa; *(u32x4*)((bf16_t*)G + eo) = wu; } }
        } else {
            const int b = u.pm / 17, ti = u.pm % 17, msel = (ti == 0) ? 4 : b;
            const float* mp = mod + msel * 6144 + ct;
            f32x4 mv[2][2];
#pragma unroll
            for (int bj = 0; bj < 2; ++bj)
#pragma unroll
                for (int n = 0; n < 2; ++n) mv[bj][n] = *(const f32x4*)(mp + bj * HALF + 4 * n);
#pragma unroll
            for (int ai = 0; ai < 2; ++ai)
#pragma unroll
                for (int m = 0; m < 4; ++m) { const int rl = rl0 + ai * HALF + m * 16; const size_t row = (size_t)(u.pm * BM + rl);
#pragma unroll
                    for (int bj = 0; bj < 2; ++bj) { const int col = ct + bj * HALF; float* xp = F + row * 1024 + col;
                        f32x4 r0 = mv[bj][0] * acc[ai][bj][m][0], r1 = mv[bj][1] * acc[ai][bj][m][1];
                        if constexpr (SUB != 2) { r0 = r0 + *(const f32x4*)xp; r1 = r1 + *(const f32x4*)(xp + 4); }
                        if constexpr (SUB == 0) { *(f32x4*)xp = r0; *(f32x4*)(xp + 4) = r1; }
                        else if constexpr (SUB == 2) { const f32x4 d0 = mv[bj][0] * acc[ai][bj][m][0], d1 = mv[bj][1] * acc[ai][bj][m][1];
                            unsafeAtomicAdd(xp + 0, d0[0]); unsafeAtomicAdd(xp + 1, d0[1]); unsafeAtomicAdd(xp + 2, d0[2]); unsafeAtomicAdd(xp + 3, d0[3]); unsafeAtomicAdd(xp + 4, d1[0]); unsafeAtomicAdd(xp + 5, d1[1]); unsafeAtomicAdd(xp + 6, d1[2]); unsafeAtomicAdd(xp + 7, d1[3]); }
                        else { if (ti != 0) { float* op = OUT + ((size_t)b * 4096 + (size_t)(ti - 1) * 256 + rl) * 1024 + col; *(f32x4*)op = r0; *(f32x4*)(op + 4) = r1; } } } }
        }
    }
};
template <class Epi, class Sched, bool ALIGN_EPI = false, bool SP2 = false>
__device__ __forceinline__ void gemm_phase(PG8_LAS unsigned char* lds, const Gemm g, const Sched& S, const Epi& E) {
    int tid = threadIdx.x; asm volatile("" : "+v"(tid)); const int wid = __builtin_amdgcn_readfirstlane(tid >> 6), lane = tid & 63, wr = wid >> 2, wc = wid & 3, fr = lane & 15, fq = lane >> 4;
    const int K = g.K, nt = K / BK;
    unsigned voffA[2], voffB[2];
#pragma unroll
    for (int i = 0; i < 2; ++i) { int R, C; stage_rc(tid * 16 + i * 8192, R, C); const int Rb = Epi::PERM ? ((R & ~31) + perm32(R & 31)) : R;
        voffA[i] = (unsigned)(R * g.lda + C) * 2u; voffB[i] = (unsigned)(Rb * (g.ldb ? g.ldb : K) + C) * 2u; }
    const size_t kstep = (size_t)(BK * 2);
    const size_t hstepA = (size_t)HALF * g.lda * 2, hstepB = (size_t)HALF * (g.ldb ? g.ldb : K) * 2;
    const size_t tstepA = 2 * hstepA, tstepB = 2 * hstepB;
    const unsigned ldsw = (unsigned)wid * 1024u;
    const int aoff = lds_byte(wr * 64 + fr, fq * 8), boff = lds_byte(wc * 32 + fr, fq * 8);
#define PG8_SA(b, h) (((b) * 2 + (h)) * HTB)
#define PG8_SB(b, h) ((4 + (b) * 2 + (h)) * HTB)
#define PG8_STAGE(bufoff, gbase, voff) do { _Pragma("unroll") for (int _i = 0; _i < 2; ++_i) \
        __builtin_amdgcn_global_load_lds((const unsigned*)((const char*)(gbase) + (voff)[_i]), (PG8_LAS unsigned*)(lds + (bufoff) + ldsw + _i * 8192), 16, 0, 0); } while (0)
#define PG8_LDA(dst, b, h) do { _Pragma("unroll") for (int m = 0; m < 4; ++m) _Pragma("unroll") for (int k = 0; k < 2; ++k) dst[m][k] = *(const PG8_LAS bf16x8*)(lds + PG8_SA(b, h) + aoff + m * 2048 + k * 1024); } while (0)
#define PG8_LDB(dst, b, h) do { _Pragma("unroll") for (int n = 0; n < 2; ++n) _Pragma("unroll") for (int k = 0; k < 2; ++k) dst[n][k] = *(const PG8_LAS bf16x8*)(lds + PG8_SB(b, h) + boff + n * 2048 + k * 1024); } while (0)
#define PG8_MMA(ai, bj, At, Bt) do { __builtin_amdgcn_s_setprio(1); _Pragma("unroll") for (int m = 0; m < 4; ++m) _Pragma("unroll") for (int n = 0; n < 2; ++n) _Pragma("unroll") for (int k = 0; k < 2; ++k) \
        acc[ai][bj][m][n] = __builtin_amdgcn_mfma_f32_16x16x32_bf16(Bt[n][k], At[m][k], acc[ai][bj][m][n], 0, 0, 0); __builtin_amdgcn_s_setprio(0); } while (0)
#define PG8_WAIT_V(n) asm volatile("s_waitcnt vmcnt(" #n ")" ::: "memory")
#define PG8_WAIT_L(n) asm volatile("s_waitcnt lgkmcnt(" #n ")" ::: "memory")
#define PG8_BAR __builtin_amdgcn_s_barrier()
#define PG8_SCHED __builtin_amdgcn_sched_barrier(0)
    Unit cur, nxt; int ui = 0;
    if (!S.next(0, cur)) return;
    f32x4 acc[2][2][4][2];
#pragma unroll
    for (int a = 0; a < 2; ++a)
#pragma unroll
        for (int b = 0; b < 2; ++b)
#pragma unroll
            for (int m = 0; m < 4; ++m)
#pragma unroll
                for (int n = 0; n < 2; ++n) acc[a][b][m][n] = (f32x4){0.f, 0.f, 0.f, 0.f};
    bf16x8 At[4][2], B0[2][2], B1[2][2];
    const char* cA = (const char*)g.A + (size_t)cur.pm * tstepA; const char* cB = (const char*)g.Bt + (size_t)cur.pn * tstepB;
    S.a_ready(cur);
    if constexpr (SP2) {
        PG8_STAGE(PG8_SB(0, 0), cB, voffB); PG8_STAGE(PG8_SB(0, 1), cB + hstepB, voffB); PG8_STAGE(PG8_SA(0, 0), cA, voffA); PG8_STAGE(PG8_SA(0, 1), cA + hstepA, voffA);
        if (wr == 1) PG8_BAR;
        PG8_WAIT_V(2); PG8_BAR;
        PG8_STAGE(PG8_SB(1, 0), cB + kstep, voffB); PG8_STAGE(PG8_SA(1, 0), cA + kstep, voffA); PG8_STAGE(PG8_SB(1, 1), cB + hstepB + kstep, voffB);
        PG8_WAIT_V(6); PG8_BAR;
    } else {
        PG8_STAGE(PG8_SB(0, 0), cB, voffB); PG8_STAGE(PG8_SA(0, 0), cA, voffA); PG8_STAGE(PG8_SB(0, 1), cB + hstepB, voffB); PG8_STAGE(PG8_SA(0, 1), cA + hstepA, voffA);
        if (wr == 1) PG8_BAR;
        PG8_WAIT_V(4); PG8_BAR;
        PG8_STAGE(PG8_SB(1, 0), cB + kstep, voffB); PG8_STAGE(PG8_SA(1, 0), cA + kstep, voffA); PG8_STAGE(PG8_SB(1, 1), cB + hstepB + kstep, voffB);
        PG8_WAIT_V(6); PG8_BAR;
    }
    for (;;) {
        const bool has_next = S.next(ui + 1, nxt);
        const char* nA = has_next ? (const char*)g.A + (size_t)nxt.pm * tstepA : cA; const char* nB = has_next ? (const char*)g.Bt + (size_t)nxt.pn * tstepB : cB;
        for (int t = 0; t < nt; t += 2) {
            const bool last = (t == nt - 2);
            const char* a1 = cA + (size_t)(t + 1) * kstep;
            const char* a2 = last ? nA : cA + (size_t)(t + 2) * kstep; const char* b2 = last ? nB : cB + (size_t)(t + 2) * kstep;
            const char* a3 = a2 + kstep; const char* b3 = b2 + kstep;
            if (last && has_next) S.a_ready(nxt);
            if constexpr (SP2) {
            PG8_LDB(B0, 0, 0); PG8_LDB(B1, 0, 1); PG8_SCHED; PG8_LDA(At, 0, 0); PG8_STAGE(PG8_SA(1, 1), a1 + hstepA, voffA);
            PG8_WAIT_V(8); PG8_WAIT_L(0); PG8_BAR; PG8_MMA(0, 0, At, B0); PG8_MMA(0, 1, At, B1); PG8_BAR; PG8_SCHED;
            PG8_LDA(At, 0, 1); PG8_STAGE(PG8_SB(0, 0), b2, voffB); PG8_STAGE(PG8_SB(0, 1), b2 + hstepB, voffB); PG8_STAGE(PG8_SA(0, 0), a2, voffA);
            PG8_WAIT_V(8); PG8_WAIT_L(0); PG8_BAR; PG8_MMA(1, 0, At, B0); PG8_MMA(1, 1, At, B1); PG8_BAR; PG8_SCHED;
            PG8_LDB(B0, 1, 0); PG8_LDB(B1, 1, 1); PG8_SCHED; PG8_LDA(At, 1, 0); PG8_STAGE(PG8_SA(0, 1), a2 + hstepA, voffA);
            PG8_WAIT_V(8); PG8_WAIT_L(0); PG8_BAR; PG8_MMA(0, 0, At, B0); PG8_MMA(0, 1, At, B1); PG8_BAR; PG8_SCHED;
            PG8_LDA(At, 1, 1); PG8_STAGE(PG8_SB(1, 0), b3, voffB); PG8_STAGE(PG8_SB(1, 1), b3 + hstepB, voffB); PG8_STAGE(PG8_SA(1, 0), a3, voffA);
            PG8_WAIT_V(8); PG8_WAIT_L(0); PG8_BAR; PG8_MMA(1, 0, At, B0); PG8_MMA(1, 1, At, B1); PG8_BAR; PG8_SCHED;
            } else {
            PG8_LDB(B0, 0, 0); PG8_SCHED; PG8_LDA(At, 0, 0); PG8_STAGE(PG8_SA(1, 1), a1 + hstepA, voffA);
            PG8_WAIT_L(8); PG8_BAR; PG8_WAIT_L(0); PG8_MMA(0, 0, At, B0); PG8_BAR; PG8_SCHED;
            PG8_LDB(B1, 0, 1); PG8_STAGE(PG8_SB(0, 0), b2, voffB);
            PG8_BAR; PG8_WAIT_L(0); PG8_MMA(0, 1, At, B1); PG8_BAR;
            PG8_LDA(At, 0, 1); PG8_STAGE(PG8_SA(0, 0), a2, voffA);
            PG8_BAR; PG8_WAIT_L(0); PG8_MMA(1, 0, At, B0); PG8_BAR; PG8_SCHED;
            PG8_STAGE(PG8_SB(0, 1), b2 + hstepB, voffB);
            PG8_WAIT_V(6); PG8_BAR; PG8_MMA(1, 1, At, B1); PG8_BAR;
            PG8_LDB(B0, 1, 0); PG8_SCHED; PG8_LDA(At, 1, 0); PG8_STAGE(PG8_SA(0, 1), a2 + hstepA, voffA);
            PG8_WAIT_L(8); PG8_BAR; PG8_WAIT_L(0); PG8_MMA(0, 0, At, B0); PG8_BAR; PG8_SCHED;
            PG8_LDB(B1, 1, 1); PG8_STAGE(PG8_SB(1, 0), b3, voffB);
            PG8_BAR; PG8_WAIT_L(0); PG8_MMA(0, 1, At, B1); PG8_BAR;
            PG8_LDA(At, 1, 1); PG8_STAGE(PG8_SA(1, 0), a3, voffA);
            PG8_BAR; PG8_WAIT_L(0); PG8_MMA(1, 0, At, B0); PG8_BAR; PG8_SCHED;
            PG8_STAGE(PG8_SB(1, 1), b3 + hstepB, voffB);
            PG8_WAIT_V(6); PG8_BAR; PG8_MMA(1, 1, At, B1); PG8_BAR;
            }
        }
        if constexpr (ALIGN_EPI) { if (wr == 0) PG8_BAR; }
        if constexpr (!Epi::AFTER_DRAIN) { E(acc, cur, wr, wc, fr, fq); S.done(cur); }
        if (!has_next) break;
#pragma unroll
        for (int a = 0; a < 2; ++a)
#pragma unroll
            for (int b = 0; b < 2; ++b)
#pragma unroll
                for (int m = 0; m < 4; ++m)
#pragma unroll
                    for (int n = 0; n < 2; ++n) acc[a][b][m][n] = (f32x4){0.f, 0.f, 0.f, 0.f};
        cur = nxt; cA = nA; cB = nB; ++ui;
        if constexpr (ALIGN_EPI) { if (wr == 1) PG8_BAR; }
    }
    PG8_WAIT_V(0);
    if constexpr (!ALIGN_EPI) { if (wr == 0) PG8_BAR; }
    PG8_BAR;
    if constexpr (Epi::AFTER_DRAIN) { E.fused(acc, cur, wr, wc, fr, fq, lds, wid, lane); S.done(cur); }
#undef PG8_SA
#undef PG8_SB
#undef PG8_STAGE
#undef PG8_LDA
#undef PG8_LDB
#undef PG8_MMA
#undef PG8_WAIT_V
#undef PG8_WAIT_L
#undef PG8_BAR
#undef PG8_SCHED
}
}
#include <hip/hip_bf16.h>
#include <cmath>
namespace attn_body {
using bf16=__hip_bfloat16;
using bf16x8=__attribute__((ext_vector_type(8)))short;
using s16x4=__attribute__((ext_vector_type(4)))short;
using f32x16=__attribute__((ext_vector_type(16)))float;
using u32x4=__attribute__((ext_vector_type(4)))unsigned;
constexpr int D=64;
constexpr int NW=8,QBLK=32,QB=QBLK*NW,KVBLK=64;
constexpr int ATTN_UNIT_ROWS=QB;
__device__ __forceinline__ int crow(int r,int hi){return (r&3)+8*(r>>2)+4*hi;}
#define SBAR() __builtin_amdgcn_sched_barrier(0)
__device__ __forceinline__ void cmask(f32x16&p0,f32x16&p1,int jb,int qrel,int hi){
  const float NEG=-INFINITY; int kb=64*jb+4*hi;
  #pragma unroll
  for(int r=0;r<16;++r){int kv=kb+(r&3)+8*(r>>2); if(kv>qrel)p0[r]=NEG; if(kv+32>qrel)p1[r]=NEG;}
}

constexpr int NSLOT=3, SLOTB=8192;
constexpr int LDS_K=0, LDS_V=NSLOT*SLOTB, LDS_WS=2*NSLOT*SLOTB, LDS_OST=LDS_WS+NW*64*4, LDS_BYTES=LDS_OST+NW*4096;
constexpr float C2=0.125f*1.4426950408889634f;
__device__ __forceinline__ void glds16(const void*gsrc,unsigned lds_dst){unsigned keep;
  asm volatile("s_mov_b32 %0, m0\n\ts_mov_b32 m0, %2\n\ts_nop 0\n\tglobal_load_lds_dwordx4 %1, off\n\ts_mov_b32 m0, %0":"=&s"(keep):"v"(gsrc),"s"(lds_dst):"memory");}
__device__ __forceinline__ float max3f(float a,float b,float c){float r;asm("v_max3_f32 %0, %1, %2, %3":"=v"(r):"v"(a),"v"(b),"v"(c));return r;}
__device__ __forceinline__ float max2f(float a,float b){float r;asm("v_max_f32_e32 %0, %1, %2":"=v"(r):"v"(a),"v"(b));return r;}
__device__ __forceinline__ float fadd_s(float a,float b){float r;asm("v_add_f32_e32 %0, %1, %2":"=v"(r):"v"(a),"v"(b));return r;}
__device__ __forceinline__ float fsub_s(float a,float b){float r;asm("v_sub_f32_e32 %0, %1, %2":"=v"(r):"v"(a),"v"(b));return r;}
typedef float f32x2_t __attribute__((ext_vector_type(2))); typedef __bf16 bf16x2_t __attribute__((ext_vector_type(2)));
__device__ __forceinline__ unsigned cvtpk_s(float lo,float hi){f32x2_t v={lo,hi};bf16x2_t b=__builtin_convertvector(v,bf16x2_t);return __builtin_bit_cast(unsigned,b);}
#define WAIT_BAR(N) asm volatile("s_waitcnt vmcnt(" #N ") lgkmcnt(0)\n\ts_barrier":::"memory")

__device__ __forceinline__ void qkt(f32x16&p0,f32x16&p1,const char*Kslot,const bf16x8*qr,const f32x16&negm,int r32,int hi){
  const char*kb=Kslot+hi*1024+r32*16;
  #pragma unroll
  for(int d0=0;d0<4;++d0){
    const bf16x8 b0=*reinterpret_cast<const bf16x8*>(kb+d0*2048);
    const bf16x8 b1=*reinterpret_cast<const bf16x8*>(kb+d0*2048+512);
    if(d0==0){p0=__builtin_amdgcn_mfma_f32_32x32x16_bf16(b0,qr[0],negm,0,0,0);p1=__builtin_amdgcn_mfma_f32_32x32x16_bf16(b1,qr[0],negm,0,0,0);}
    else{p0=__builtin_amdgcn_mfma_f32_32x32x16_bf16(b0,qr[d0],p0,0,0,0);p1=__builtin_amdgcn_mfma_f32_32x32x16_bf16(b1,qr[d0],p1,0,0,0);}}
}
typedef __attribute__((address_space(3))) const char* lds_cptr;
typedef short v4i16_t __attribute__((ext_vector_type(4)));
__device__ __forceinline__ void kload8(bf16x8*kf,lds_cptr kp){
  kf[0]=*(const __attribute__((address_space(3))) bf16x8*)(kp);      kf[1]=*(const __attribute__((address_space(3))) bf16x8*)(kp+512);
  kf[2]=*(const __attribute__((address_space(3))) bf16x8*)(kp+2048); kf[3]=*(const __attribute__((address_space(3))) bf16x8*)(kp+2560);
  kf[4]=*(const __attribute__((address_space(3))) bf16x8*)(kp+4096); kf[5]=*(const __attribute__((address_space(3))) bf16x8*)(kp+4608);
  kf[6]=*(const __attribute__((address_space(3))) bf16x8*)(kp+6144); kf[7]=*(const __attribute__((address_space(3))) bf16x8*)(kp+6656);
}
__device__ __forceinline__ void kload2(bf16x8*kf,lds_cptr kp,int j){ kf[2*j]=*(const __attribute__((address_space(3))) bf16x8*)(kp+j*2048); kf[2*j+1]=*(const __attribute__((address_space(3))) bf16x8*)(kp+j*2048+512); }
__device__ __forceinline__ s16x4 vtr(lds_cptr p){ return __builtin_bit_cast(s16x4,__builtin_amdgcn_ds_read_tr16_b64_v4i16((__attribute__((address_space(3))) v4i16_t*)p)); }
__device__ __forceinline__ float rowmax(const f32x16&p0,const f32x16&p1){
  float a=max3f(p0[0],p0[1],p1[0]),b=max3f(p0[2],p0[3],p1[1]);a=max3f(a,p1[2],p1[3]);
  #pragma unroll
  for(int r=4;r<16;r+=4){a=max3f(a,p0[r],p0[r+1]);b=max3f(b,p0[r+2],p0[r+3]);a=max3f(a,p1[r],p1[r+1]);b=max3f(b,p1[r+2],p1[r+3]);}
  const float m=max2f(a,b);
  auto rr=__builtin_amdgcn_permlane32_swap(__float_as_uint(m),__float_as_uint(m),false,false);
  return max2f(__uint_as_float(rr[0]),__uint_as_float(rr[1]));
}
__device__ __forceinline__ void pv(f32x16*o,int vb,bf16x8 pa0,bf16x8 pa1,bf16x8 pa2,bf16x8 pa3){
  #pragma unroll
  for(int d0=0;d0<2;++d0){s16x4 lo[4],hi[4];
    #pragma unroll
    for(int ks=0;ks<4;++ks){
      asm volatile("ds_read_b64_tr_b16 %0,%1 offset:%c2":"=&v"(lo[ks]):"v"(vb),"i"(d0*4096+ks*1024):"memory");
      asm volatile("ds_read_b64_tr_b16 %0,%1 offset:%c2":"=&v"(hi[ks]):"v"(vb),"i"(d0*4096+ks*1024+512):"memory");}
    asm volatile("s_waitcnt lgkmcnt(0)":::"memory");SBAR();
    #define PK(k) (bf16x8){lo[k][0],lo[k][1],lo[k][2],lo[k][3],hi[k][0],hi[k][1],hi[k][2],hi[k][3]}
    o[d0]=__builtin_amdgcn_mfma_f32_32x32x16_bf16(pa0,PK(0),o[d0],0,0,0);
    o[d0]=__builtin_amdgcn_mfma_f32_32x32x16_bf16(pa1,PK(1),o[d0],0,0,0);
    o[d0]=__builtin_amdgcn_mfma_f32_32x32x16_bf16(pa2,PK(2),o[d0],0,0,0);
    o[d0]=__builtin_amdgcn_mfma_f32_32x32x16_bf16(pa3,PK(3),o[d0],0,0,0);
    #undef PK
  }
}

#ifndef ATTN_STORE16
#define ATTN_STORE16(p,v) (*(u32x4*)(p)=(v))
#endif
template<int THRL> __device__ __forceinline__ void attn_unit(const bf16*Qb,const bf16*__restrict__ Kh,const bf16*__restrict__ Vh,bf16*Ob,const int PQ,const int PK,const int PV,const int PO,const int NT,char*shm){
  int tid=threadIdx.x; asm volatile("":"+v"(tid)); const int lane=tid&63,r32=lane&31,hi=lane>>5; const int wid=__builtin_amdgcn_readfirstlane(tid>>6);
  const bf16*Qw=Qb+(long)(wid*QBLK)*PQ;
  const unsigned lds0=(unsigned)(uintptr_t)shm;
  float*wsf=(float*)(shm+LDS_WS)+wid*64;
  const bf16*ksrc=Kh+(long)lane*PK+wid*8;
  const bf16*vsrc=Vh+(long)(16*(wid&3)+(lane>>2))*PV+(wid>>2)*32+(lane&3)*8;
  const unsigned kdst=lds0+LDS_K+wid*1024, vdst=lds0+LDS_V+wid*1024;
  #define DMA_K(t,slot) glds16(ksrc+(long)(t)*KVBLK*PK,(unsigned)__builtin_amdgcn_readfirstlane(kdst+(slot)))
  #define DMA_V(t,slot) glds16(vsrc+(long)(t)*KVBLK*PV,(unsigned)__builtin_amdgcn_readfirstlane(vdst+(slot)))
  const int vb0=(int)(lds0+LDS_V)+((lane>>4)&1)*32+(lane&3)*8+(4*hi+((lane&15)>>2))*64;
  const char*Kbase=shm+LDS_K; bf16x8 kf[8];
  const lds_cptr shm3=(lds_cptr)shm; const lds_cptr kp0=shm3+LDS_K+hi*1024+r32*16; const lds_cptr vp0=shm3+LDS_V+((lane>>4)&1)*32+(lane&3)*8+(4*hi+((lane&15)>>2))*64;
  DMA_K(0,0);DMA_V(0,0);DMA_K(1,SLOTB);
  bf16x8 qr[4];
  #pragma unroll
  for(int d0=0;d0<4;++d0)qr[d0]=*reinterpret_cast<const bf16x8*>(&Qw[(long)r32*PQ+d0*16+hi*8]);
  float mhat=0.f,l_reg=0.f;f32x16 o[2];o[0]=f32x16{};o[1]=f32x16{};f32x16 negm=f32x16{};asm volatile("":"+v"(negm));
  #define CMASK(P0,P1,t) do{}while(0)
  bool resc=false;
  #define START(P0,P1) do{ const float rm=rowmax(P0,P1); resc=false; \
    { const float dl=rm; mhat=fadd_s(mhat,dl); \
      _Pragma("unroll") for(int r=0;r<16;++r){P0[r]=fsub_s(P0[r],dl);P1[r]=fsub_s(P1[r],dl);} \
      _Pragma("unroll") for(int r=0;r<16;++r)negm[r]=-mhat; asm volatile("":"+v"(negm)); } \
    _Pragma("unroll") for(int r=0;r<16;++r)P0[r]=__builtin_amdgcn_exp2f(P0[r]); }while(0)
  #define RESC() do{ if(resc){ asm volatile("s_waitcnt lgkmcnt(0)":::"memory"); \
      _Pragma("unroll") for(int d_=0;d_<2;++d_) _Pragma("unroll") for(int r=0;r<16;++r)o[d_][r]*=wsf[crow(r,hi)]; } }while(0)
  f32x16 pA0,pA1,pB0,pB1;
  int sl_prev=0,sl_cur=0,sl_next=SLOTB;
  #define ROT() do{sl_prev=sl_cur;sl_cur=sl_next;sl_next=(sl_next==(NSLOT-1)*SLOTB)?0:sl_next+SLOTB;}while(0)
  DMA_K(2,2*SLOTB);
  WAIT_BAR(3);
  qkt(pA0,pA1,Kbase,qr,negm,r32,hi);asm volatile("s_nop 15\n\ts_nop 7":"+v"(pA0),"+v"(pA1));CMASK(pA0,pA1,0);
  START(pA0,pA1);
  _Pragma("unroll") for(int r=0;r<16;++r)pA1[r]=__builtin_amdgcn_exp2f(pA1[r]);
  WAIT_BAR(0);
  DMA_K(3,0);DMA_V(1,SLOTB);
  ROT();
  kload8(kf,kp0+sl_cur);
  WAIT_BAR(2);
  s16x4 vlo[8],vhi[8]; u32x4 pw0,pw1,pw2,pw3;
  #define PKW(P,B) cvtpk_s(P[B],P[B+1])
  #define PAF(k) __builtin_bit_cast(bf16x8,pw##k)
  #define VFR(i) (bf16x8){vlo[i][0],vlo[i][1],vlo[i][2],vlo[i][3],vhi[i][0],vhi[i][1],vhi[i][2],vhi[i][3]}
  #define PIN(x) asm volatile("":"+v"(x))
  #define MX3(a,b,c) __builtin_fmaxf(__builtin_fmaxf((a),(b)),(c))
  #define GAPA(MF,A0,A1,A2,A3,W0,W1,PW) do{ MF; sacc+=A0; sacc+=A1; sacc+=A2; sacc+=A3; PIN(sacc); W0; W1; PIN(PW); SBAR(); }while(0)
  #define EX(v) __builtin_amdgcn_exp2f(v)
  #define GAPB(MF,X,B) do{ MF; X[B]=EX(X[B]); X[B+1]=EX(X[B+1]); X[B+2]=EX(X[B+2]); X[B+3]=EX(X[B+3]); PIN(X); SBAR(); }while(0)
  #define VRD(i) do{ vlo[i]=vtr(vp_+(((i)>>2)*4096+((i)&3)*1024)); vhi[i]=vtr(vp_+(((i)>>2)*4096+((i)&3)*1024+512)); }while(0)
  #define KRD(G,j) do{ if(G){ kload2(kf,kp0+sl_next,j); SBAR(); } }while(0)
  #define STEP(C0,C1,P0,P1,t,GK,GV,GL) do{ SBAR(); \
    const lds_cptr vp_=vp0+sl_prev; \
    VRD(0); SBAR(); float sacc=(P0[0]+P0[1]); \
    GAPA(C0=__builtin_amdgcn_mfma_f32_32x32x16_bf16(kf[0],qr[0],negm,0,0,0), P0[2],P0[3],P0[4],P0[5],     pw0[0]=PKW(P0,0), pw0[1]=PKW(P0,2), pw0); \
    VRD(4); SBAR(); GAPA(C1=__builtin_amdgcn_mfma_f32_32x32x16_bf16(kf[1],qr[0],negm,0,0,0), P0[6],P0[7],P0[8],P0[9],     pw0[2]=PKW(P0,4), pw0[3]=PKW(P0,6), pw0); \
    VRD(1); SBAR(); GAPA(C0=__builtin_amdgcn_mfma_f32_32x32x16_bf16(kf[2],qr[1],C0,0,0,0),   P0[10],P0[11],P0[12],P0[13], pw1[0]=PKW(P0,8), pw1[1]=PKW(P0,10), pw1); \
    VRD(5); SBAR(); GAPA(C1=__builtin_amdgcn_mfma_f32_32x32x16_bf16(kf[3],qr[1],C1,0,0,0),   P0[14],P0[15],P1[0],P1[1],   pw1[2]=PKW(P0,12),pw1[3]=PKW(P0,14), pw1); \
    VRD(2); SBAR(); GAPA(C0=__builtin_amdgcn_mfma_f32_32x32x16_bf16(kf[4],qr[2],C0,0,0,0),   P1[2],P1[3],P1[4],P1[5],     pw2[0]=PKW(P1,0), pw2[1]=PKW(P1,2), pw2); \
    VRD(6); SBAR(); GAPA(C1=__builtin_amdgcn_mfma_f32_32x32x16_bf16(kf[5],qr[2],C1,0,0,0),   P1[6],P1[7],P1[8],P1[9],     pw2[2]=PKW(P1,4), pw2[3]=PKW(P1,6), pw2); \
    VRD(3); SBAR(); GAPA(C0=__builtin_amdgcn_mfma_f32_32x32x16_bf16(kf[6],qr[3],C0,0,0,0),   P1[10],P1[11],P1[12],P1[13], pw3[0]=PKW(P1,8), pw3[1]=PKW(P1,10), pw3); \
    VRD(7); SBAR(); GAPA(C1=__builtin_amdgcn_mfma_f32_32x32x16_bf16(kf[7],qr[3],C1,0,0,0),   P1[14],P1[15],0.f,0.f,       pw3[2]=PKW(P1,12),pw3[3]=PKW(P1,14), pw3); \
    l_reg+=sacc; \
    if(GK){DMA_K((t)+3,sl_cur);} if(GV){DMA_V((t)+1,sl_next);} \
    CMASK(C0,C1,t); \
    { float a=MX3(C0[0],C0[1],C1[0]),b=MX3(C0[2],C0[3],C1[1]); a=MX3(a,C1[2],C1[3]); \
      _Pragma("unroll") for(int r=4;r<16;r+=4){a=MX3(a,C0[r],C0[r+1]);b=MX3(b,C0[r+2],C0[r+3]);a=MX3(a,C1[r],C1[r+1]);b=MX3(b,C1[r+2],C1[r+3]);} \
      float rm=__builtin_fmaxf(a,b); { auto rr=__builtin_amdgcn_permlane32_swap(__float_as_uint(rm),__float_as_uint(rm),false,false); rm=__builtin_fmaxf(__uint_as_float(rr[0]),__uint_as_float(rr[1])); } \
      resc=false; \
      if(__builtin_expect(__any(rm>(float)THRL),0)){ const float dl=__builtin_fmaxf(rm,0.f); mhat+=dl; \
        _Pragma("unroll") for(int r=0;r<16;++r){C0[r]-=dl;C1[r]-=dl;} \
        _Pragma("unroll") for(int r=0;r<16;++r)negm[r]=-mhat; asm volatile("":"+v"(negm)); \
        const float f=__builtin_amdgcn_exp2f(-dl); l_reg*=f; if(hi==0)wsf[r32]=f; resc=true; } } \
    SBAR(); \
    GAPB(o[0]=__builtin_amdgcn_mfma_f32_32x32x16_bf16(PAF(0),VFR(0),o[0],0,0,0), C0,0); \
    GAPB(o[1]=__builtin_amdgcn_mfma_f32_32x32x16_bf16(PAF(0),VFR(4),o[1],0,0,0), C0,4); \
    KRD(GL,0); GAPB(o[0]=__builtin_amdgcn_mfma_f32_32x32x16_bf16(PAF(1),VFR(1),o[0],0,0,0), C0,8); \
    KRD(GL,1); GAPB(o[1]=__builtin_amdgcn_mfma_f32_32x32x16_bf16(PAF(1),VFR(5),o[1],0,0,0), C0,12); \
    KRD(GL,2); GAPB(o[0]=__builtin_amdgcn_mfma_f32_32x32x16_bf16(PAF(2),VFR(2),o[0],0,0,0), C1,0); \
    KRD(GL,3); GAPB(o[1]=__builtin_amdgcn_mfma_f32_32x32x16_bf16(PAF(2),VFR(6),o[1],0,0,0), C1,4); \
    GAPB(o[0]=__builtin_amdgcn_mfma_f32_32x32x16_bf16(PAF(3),VFR(3),o[0],0,0,0), C1,8); \
    GAPB(o[1]=__builtin_amdgcn_mfma_f32_32x32x16_bf16(PAF(3),VFR(7),o[1],0,0,0), C1,12); \
    }while(0)
  int t=1;
  #undef CMASK
  #define CMASK(P0,P1,t) do{}while(0)
  for(;t+5<NT;t+=2){
    STEP(pB0,pB1,pA0,pA1,t,true,true,true);     WAIT_BAR(2); RESC(); ROT();
    STEP(pA0,pA1,pB0,pB1,t+1,true,true,true);   WAIT_BAR(2); RESC(); ROT();
  }
  #undef CMASK
  #define CMASK(P0,P1,t) do{}while(0)
  #define ENDW(tt) do{ if((tt)+3<NT){WAIT_BAR(2);} else if((tt)+2<NT){WAIT_BAR(1);} else {WAIT_BAR(0);} }while(0)
  for(;t+1<NT;t+=2){
    STEP(pB0,pB1,pA0,pA1,t,(t+3<NT),(t+1<NT),(t+1<NT));       ENDW(t);   RESC(); ROT();
    STEP(pA0,pA1,pB0,pB1,t+1,(t+4<NT),(t+2<NT),(t+2<NT));     ENDW(t+1); RESC(); ROT();
  }
  STEP(pB0,pB1,pA0,pA1,NT-1,false,false,false); RESC();
  { float sacc=pB0[0]+pB0[1]; _Pragma("unroll") for(int r=2;r<16;++r)sacc+=pB0[r]; _Pragma("unroll") for(int r=0;r<16;++r)sacc+=pB1[r]; l_reg+=sacc;
    pw0=(u32x4){PKW(pB0,0),PKW(pB0,2),PKW(pB0,4),PKW(pB0,6)};pw1=(u32x4){PKW(pB0,8),PKW(pB0,10),PKW(pB0,12),PKW(pB0,14)};pw2=(u32x4){PKW(pB1,0),PKW(pB1,2),PKW(pB1,4),PKW(pB1,6)};pw3=(u32x4){PKW(pB1,8),PKW(pB1,10),PKW(pB1,12),PKW(pB1,14)};
    SBAR(); pv(o,vb0+sl_cur,PAF(0),PAF(1),PAF(2),PAF(3)); }
  #undef PKW
  #undef PAF
  #undef VFR
  #undef PIN
  #undef MX3
  #undef GAPA
  #undef GAPB
  #undef EX
  #undef VRD
  #undef KRD
  #undef STEP
  #undef ENDW
  {auto rr=__builtin_amdgcn_permlane32_swap(__float_as_uint(l_reg),__float_as_uint(l_reg),false,false);l_reg=__uint_as_float(rr[0])+__uint_as_float(rr[1]);}
  if(hi==0)wsf[32+r32]=l_reg;asm volatile("s_waitcnt lgkmcnt(0)":::"memory");
  float rli[16];
  #pragma unroll
  for(int r=0;r<16;++r)rli[r]=__builtin_amdgcn_rcpf(wsf[32+crow(r,hi)]);
  bf16*Ow=Ob+(long)(wid*QBLK)*PO;
  { bf16*stg=(bf16*)(shm+LDS_OST)+wid*2048;
    #pragma unroll
    for(int r=0;r<16;++r){const int orow=crow(r,hi);
      #pragma unroll
      for(int d0=0;d0<2;++d0)stg[orow*64+d0*32+r32]=__float2bfloat16(o[d0][r]*rli[r]);}
    asm volatile("s_waitcnt lgkmcnt(0)":::"memory");
    #pragma unroll
    for(int i=0;i<4;++i){const int row=i*8+(lane>>3),ch=lane&7; const u32x4 v=*(const u32x4*)(stg+row*64+ch*8); ATTN_STORE16(Ow+(long)row*PO+ch*8,v);} }
  asm volatile("s_waitcnt lgkmcnt(0)\n\ts_barrier":::"memory");
  #undef DMA_K
  #undef DMA_V
  #undef CMASK
  #undef START
  #undef RESC
  #undef ROT
}
constexpr int ATTN_LDS_BYTES=LDS_BYTES;
#undef SBAR
#undef WAIT_BAR
}
#define GAS __attribute__((address_space(1)))
#define LAS __attribute__((address_space(3)))
typedef unsigned short bf16;
typedef unsigned v4u __attribute__((ext_vector_type(4)));
typedef float f32x4 __attribute__((ext_vector_type(4)));
typedef short bf16x8 __attribute__((ext_vector_type(8)));
typedef GAS unsigned gu32;
typedef GAS unsigned long long gu64;
#define RLX_AGENT __ATOMIC_RELAXED, __HIP_MEMORY_SCOPE_AGENT
#define LDS_WAIT() asm volatile("s_waitcnt lgkmcnt(0)" ::: "memory")
#define VM_WAIT() asm volatile("s_waitcnt vmcnt(0)" ::: "memory")
__device__ __forceinline__ unsigned long long rt() { return __builtin_amdgcn_s_memrealtime(); }
__device__ __forceinline__ unsigned f2bf(float f) { unsigned u = __builtin_bit_cast(unsigned, f); return (u + 0x7fffu + ((u >> 16) & 1u)) >> 16; }
__device__ __forceinline__ unsigned pk2(float lo, float hi) { return f2bf(lo) | (f2bf(hi) << 16); }

#define XB_TMO      128
#define XB_XCNT(j)  (256  + 64 * (j))
#define XB_XSUB(j)  (1280 + 64 * (j))
#define XB_XGEN(j)  (2304 + 64 * (j))
#define XB_TOP      3328
#define XB_TOPGEN   3392
#define XCD_BAR_WORDS 3456
#define XB_SPIN_CAP (1u << 22)

__device__ __forceinline__ unsigned xb_ld(unsigned* p)              { return __hip_atomic_load(p, __ATOMIC_RELAXED, __HIP_MEMORY_SCOPE_AGENT); }
__device__ __forceinline__ unsigned xb_add(unsigned* p, unsigned v) { return __hip_atomic_fetch_add(p, v, __ATOMIC_RELAXED, __HIP_MEMORY_SCOPE_AGENT); }
__device__ __forceinline__ unsigned xb_xcc_id() { return (unsigned)__builtin_amdgcn_s_getreg((3 << 11) | 20) & 0xFu; }
#define XB_SPIN(cond, bar) do { unsigned _sp = 0; while (cond) { __builtin_amdgcn_s_sleep(1); \
    if ((++_sp & 255u) == 0u) { if (xb_ld(&(bar)[XB_TMO])) break; if (_sp > XB_SPIN_CAP) { atomicAdd(&(bar)[XB_TMO], 1u); break; } } } } while (0)

struct XcdBarrier {
    unsigned* bar; unsigned x;
    volatile LAS unsigned* st;
};

__device__ __forceinline__ XcdBarrier xcd_barrier_post(unsigned* bar, volatile LAS unsigned* st) {
    XcdBarrier b; b.bar = bar; b.x = xb_xcc_id(); b.st = st;
    if (threadIdx.x == 0) (void)xb_add(&bar[XB_XCNT(b.x)], 1u);
    return b;
}
__device__ __forceinline__ void xcd_barrier_complete(unsigned* bar, unsigned x, unsigned& nloc, unsigned& nx) {
    const unsigned G = gridDim.x * gridDim.y * gridDim.z;
    unsigned sum, cnt, mine, sp = 0u;
    for (;;) {
        sum = 0u; cnt = 0u; mine = 0u;
#pragma unroll
        for (unsigned j = 0; j < 16; ++j) { const unsigned c = xb_ld(&bar[XB_XCNT(j)]); sum += c; cnt += (c > 0u) ? 1u : 0u; mine = (j == x) ? c : mine; }
        if (sum == G) break;
        __builtin_amdgcn_s_sleep(1);
        if ((++sp & 255u) == 0u) { if (xb_ld(&bar[XB_TMO])) break; if (sp > XB_SPIN_CAP) { atomicAdd(&bar[XB_TMO], 1u); break; } }
    }
    nloc = mine > 0u ? mine : 1u; nx = cnt > 0u ? cnt : 1u;
}

__device__ __forceinline__ void xcd_barrier(const XcdBarrier& b) {
    asm volatile("s_waitcnt vmcnt(0)" ::: "memory");
    __syncthreads();
    if (threadIdx.x == 0) {
        unsigned* bar = b.bar;
        __builtin_amdgcn_s_waitcnt(0);
        unsigned nloc = b.st[0], nx = b.st[1];
        if (nloc == 0u) { xcd_barrier_complete(bar, b.x, nloc, nx); b.st[0] = nloc; b.st[1] = nx; }
        const unsigned old = xb_add(&bar[XB_XSUB(b.x)], 1u);
        const unsigned gen = old / nloc;
        if (old + 1u == (gen + 1u) * nloc) {
            __builtin_amdgcn_fence(__ATOMIC_RELEASE, "agent");
            asm volatile("s_waitcnt vmcnt(0)" ::: "memory");
            const unsigned og = xb_add(&bar[XB_TOP], 1u);
            const unsigned tg = og / nx;
            if (og + 1u == (tg + 1u) * nx) xb_add(&bar[XB_TOPGEN], 1u);
            else XB_SPIN(xb_ld(&bar[XB_TOPGEN]) == tg, bar);
            __builtin_amdgcn_fence(__ATOMIC_ACQUIRE, "agent");
            xb_add(&bar[XB_XGEN(b.x)], 1u);
            asm volatile("s_waitcnt vmcnt(0)" ::: "memory");
        } else {
            XB_SPIN(xb_ld(&bar[XB_XGEN(b.x)]) == gen, bar);
            __builtin_amdgcn_fence(__ATOMIC_ACQUIRE, "agent");
            asm volatile("s_waitcnt vmcnt(0)" ::: "memory");
        }
    }
    __syncthreads();
}

constexpr int NWAVES = 8, NTHR = 512;
constexpr int DMODEL = 1024, TPB = 4352  , MROWS = 17408, NLAYER = 4;
constexpr int PATT_LD = 2816, PDN_LD = 1792, DFF = 2816, AU_LD = 5632;
constexpr int C_DAQ = 0, C_DAK = 512, C_DAV = 1024, C_GQQ = 1536, C_GQK = 2048, C_GQV = 2176, C_Z = 2304;
constexpr int C_DNQ = 0, C_BRAW = 1536, C_ARAW = 1544;
constexpr float NEPS = 1e-6f;
constexpr float QSCALE = 0.125f * 1.4426950408889634f;
constexpr size_t WS_CTL = 0, CTL_ZERO_BYTES = 1u << 20;
constexpr size_t WS_MOD = 1u << 20;
constexpr size_t WS_GL = (1u << 20) + (1u << 19);
constexpr size_t WS_WT = 2u << 20;
constexpr size_t WT_IN = 0, WT_BRA = 7864320, WT_BRB = WT_BRA + 524288, WT_BRC = WT_BRB + 524288, WT_O = WT_BRC + 524288, WT_1 = WT_O + 1048576, WT_2 = WT_1 + 5767168;
constexpr size_t WS_XS = 41943040;
constexpr size_t WS_HN = WS_XS + 71303168;
constexpr size_t WS_OC = WS_HN + 35651584;
constexpr size_t WS_PATT = WS_OC + 17825792;
constexpr size_t WS_A = WS_PATT + 98041856;
constexpr size_t WS_END = WS_A + 196083712;
constexpr size_t OPS_BYTES = 73728;
constexpr size_t A_ODA = 160432128;
constexpr size_t A_MRGF = 106954752;
constexpr size_t DO_OA = 35651584;
constexpr int CW_BAR = 4096, CW_Q = 1024;
constexpr int LDS_BYTES = 147456, MISC_OFF = LDS_BYTES - 256;

struct Args { const float* in[27]; float* out; unsigned char* ws; };
typedef const __attribute__((address_space(4))) Args* CArgsP;
#define ARGS_HERE(nm) CArgsP nm = (CArgsP)__builtin_amdgcn_kernarg_segment_ptr(); asm volatile("" : "+s"(nm))

__device__ __forceinline__ float dpp_ror(float v, const int n) { return n == 8 ? __builtin_bit_cast(float, __builtin_amdgcn_update_dpp(0, __builtin_bit_cast(int, v), 0x128, 0xf, 0xf, false))
                                                                        : n == 4 ? __builtin_bit_cast(float, __builtin_amdgcn_update_dpp(0, __builtin_bit_cast(int, v), 0x124, 0xf, 0xf, false))
                                                                        : n == 2 ? __builtin_bit_cast(float, __builtin_amdgcn_update_dpp(0, __builtin_bit_cast(int, v), 0x122, 0xf, 0xf, false))
                                                                                 : __builtin_bit_cast(float, __builtin_amdgcn_update_dpp(0, __builtin_bit_cast(int, v), 0x121, 0xf, 0xf, false)); }
__device__ __forceinline__ float row16_sum(float v) { v += dpp_ror(v, 8); v += dpp_ror(v, 4); v += dpp_ror(v, 2); v += dpp_ror(v, 1); return v; }
__device__ __forceinline__ float wave_sum(float v) {
    v = row16_sum(v);
    return __builtin_bit_cast(float, __builtin_amdgcn_readlane(__builtin_bit_cast(int, v), 0)) + __builtin_bit_cast(float, __builtin_amdgcn_readlane(__builtin_bit_cast(int, v), 16))
         + __builtin_bit_cast(float, __builtin_amdgcn_readlane(__builtin_bit_cast(int, v), 32)) + __builtin_bit_cast(float, __builtin_amdgcn_readlane(__builtin_bit_cast(int, v), 48));
}
__device__ __forceinline__ float silu_f(float v) { return v * __builtin_amdgcn_rcpf(1.f + __expf(-v)); }
__device__ __forceinline__ float bf_lo(unsigned w) { return __uint_as_float(w << 16); }
__device__ __forceinline__ float bf_hi(unsigned w) { return __uint_as_float(w & 0xffff0000u); }
__device__ __forceinline__ float bf_1(bf16 u) { return __uint_as_float((unsigned)u << 16); }

__device__ __forceinline__ void phase_mod(CArgsP a, LAS unsigned char* lds, int tid, int bid, int G) {
    LAS float* sc = (LAS float*)lds; LAS float* red = sc + 5 * 1024;
    const float* c = a->in[1]; const float* cctx = a->in[3]; float* MOD = (float*)(a->ws + WS_MOD);
    for (int i = tid; i < 5 * 1024; i += NTHR) { const float v = (i < 4096) ? c[i] : cctx[i - 4096]; sc[i] = silu_f(v); }
    __syncthreads();
    const int wave = tid >> 6, lane = tid & 63;
    for (int task = bid; task < 4 * 96; task += G) {
        const int l = task / 96, n = (task % 96) * 64 + lane;
        const float* W = a->in[4] + (size_t)l * 1024 * 6144 + n;
        float acc[5] = {0.f, 0.f, 0.f, 0.f, 0.f};
        for (int k0 = wave * 128; k0 < wave * 128 + 128; k0 += 16) { float w[16];
#pragma unroll
            for (int kk = 0; kk < 16; ++kk) w[kk] = W[(size_t)(k0 + kk) * 6144];
#pragma unroll
            for (int kk = 0; kk < 16; ++kk)
#pragma unroll
                for (int r = 0; r < 5; ++r) acc[r] += sc[r * 1024 + k0 + kk] * w[kk]; }
#pragma unroll
        for (int r = 0; r < 5; ++r) red[(wave * 5 + r) * 64 + lane] = acc[r];
        __syncthreads();
        if (tid < 320) { const int r = tid >> 6; float s = 0.f;
#pragma unroll
            for (int w = 0; w < 8; ++w) s += red[(w * 5 + r) * 64 + lane];
            MOD[(size_t)(l * 5 + r) * 6144 + n] = s + a->in[5][l * 6144 + n]; }
        __syncthreads();
    }
}

__device__ __forceinline__ int map_in(int nd) {
    if (nd < 2304) return nd;
    if (nd < 2816) return 3856 + (nd - 2304);
    if (nd < 2816 + 1536) return 2304 + (nd - 2816);
    if (nd < 2816 + 1552) return 3840 + (nd - 2816 - 1536);
    if (nd < 4608) return -1;
    return 4368 + (nd - 4608);
}
template <int MAP> __device__ __forceinline__ void tr_item(const float* W, int K, int N, bf16* WT, LAS float* scr, int item, int lane, int nblk) {
    const int kb = item / nblk, nb = item % nblk, k0 = 64 * kb, n0 = 32 * nb;
    const int nd = n0 + (lane & 31); const int ns = MAP == 1 ? map_in(nd) : MAP == 2 ? (((nd & 255) < 128) ? (nd >> 8) * 128 + (nd & 255) : 2816 + (nd >> 8) * 128 + (nd & 255) - 128) : nd;
    float tv[32];
#pragma unroll
    for (int i = 0; i < 32; ++i) { const int kk = 2 * i + (lane >> 5); tv[i] = (ns >= 0) ? W[(size_t)(k0 + kk) * N + ns] : 0.f; }
#pragma unroll
    for (int i = 0; i < 32; ++i) { const int kk = 2 * i + (lane >> 5); scr[kk * 33 + (lane & 31)] = tv[i]; }
    LDS_WAIT(); asm volatile("" ::: "memory");
    const int c = lane & 7;
#pragma unroll
    for (int j = 0; j < 4; ++j) { const int n = (lane >> 3) + 8 * j; const LAS float* s = scr + (8 * c) * 33 + n;
        v4u o; o.x = pk2(s[0 * 33], s[1 * 33]); o.y = pk2(s[2 * 33], s[3 * 33]); o.z = pk2(s[4 * 33], s[5 * 33]); o.w = pk2(s[6 * 33], s[7 * 33]);
        *(GAS v4u*)(WT + (size_t)(n0 + n) * K + k0 + 8 * c) = o; }
    LDS_WAIT(); asm volatile("" ::: "memory");
}
__device__ __forceinline__ void phase_convert(CArgsP a, int l, LAS unsigned char* lds, int gw, int NGW, int wave, int lane, int it_lo = 0, int it_hi = 9344) {
    LAS float* scr = (LAS float*)(lds + wave * 16384);
    bf16* WT = (bf16*)(a->ws + WS_WT);
    for (int it = it_lo + gw; it < it_hi; it += NGW) {
        int r = it;
        if (r < 3840) { tr_item<1>(a->in[7] + (size_t)l * 1024 * 7440, 1024, 7440, WT + WT_IN, scr, r, lane, 240); continue; } r -= 3840;
        if (r < 256) { tr_item<0>(a->in[18] + (size_t)l * 512 * 1024, 512, 1024, WT + WT_BRA, scr, r, lane, 32); continue; } r -= 256;
        if (r < 256) { tr_item<0>(a->in[19] + (size_t)l * 512 * 1024, 512, 1024, WT + WT_BRB, scr, r, lane, 32); continue; } r -= 256;
        if (r < 256) { tr_item<0>(a->in[20] + (size_t)l * 512 * 1024, 512, 1024, WT + WT_BRC, scr, r, lane, 32); continue; } r -= 256;
        if (r < 512) { tr_item<0>(a->in[21] + (size_t)l * 1024 * 1024, 1024, 1024, WT + WT_O, scr, r, lane, 32); continue; } r -= 512;
        if (r < 2816) { tr_item<2>(a->in[23] + (size_t)l * 1024 * 5632, 1024, 5632, WT + WT_1, scr, r, lane, 176); continue; } r -= 2816;
        tr_item<0>(a->in[26] + (size_t)l * 2816 * 1024, 2816, 1024, WT + WT_2, scr, r, lane, 32);
    }
}

__device__ __forceinline__ const float* norm_src(CArgsP a, bool first, int row) {
    const int b = row / TPB, p = row % TPB;
    return first ? (p < 256 ? a->in[2] + ((size_t)b * 256 + p) * 1024 : a->in[0] + ((size_t)b * 4096 + (p - 256)) * 1024) : (const float*)(a->ws + WS_XS) + (size_t)row * 1024;
}
__device__ __forceinline__ void norm_finish(CArgsP a, const float* gain, const float* modl, int shoff, int scoff, bool first, int row, int lane, const f32x4 (&v)[4]) {
    float ss = 0.f;
#pragma unroll
    for (int j = 0; j < 4; ++j) ss += (v[j].x * v[j].x + v[j].y * v[j].y) + (v[j].z * v[j].z + v[j].w * v[j].w);
    const float rstd = __builtin_amdgcn_rsqf(wave_sum(ss) * (1.f / 1024.f) + NEPS);
    const int b = row / TPB, p = row % TPB;
    const float* mrow = modl + (size_t)(p < 256 ? 4 : b) * 6144;
    float* XS = (float*)(a->ws + WS_XS); bf16* HN = (bf16*)(a->ws + WS_HN);
#pragma unroll
    for (int j = 0; j < 4; ++j) { const int col = 4 * lane + 256 * j;
        const f32x4 g4 = *(const f32x4*)(gain + col), sh = *(const f32x4*)(mrow + shoff + col), sc = *(const f32x4*)(mrow + scoff + col);
        const f32x4 h = (v[j] * rstd * g4) * (sc + 1.0f) + sh;
        *(unsigned long long*)(HN + (size_t)row * 1024 + col) = (unsigned long long)pg8::pkbf(h.x, h.y) | ((unsigned long long)pg8::pkbf(h.z, h.w) << 32);
        if (first) *(f32x4*)(XS + (size_t)row * 1024 + col) = v[j]; }
}
__device__ __forceinline__ int norm_row(int i, int mode) { return mode == 0 ? i : mode == 1 ? i + ((i >> 12) + 1) * 256 : (i >> 8) * TPB + (i & 255); }
__device__ __forceinline__ void phase_norm(CArgsP a, int l, int which, int gw, int NGW, int lane, int mode = 0) {
    const float* gain = a->in[which ? 22 : 6] + l * 1024;
    const float* modl = (const float*)(a->ws + WS_MOD) + (size_t)l * 5 * 6144;
    const int shoff = which ? 3 * 1024 : 0, scoff = which ? 4 * 1024 : 1024;
    const bool first = (which == 0 && l == 0);
    const int nrows = mode == 0 ? MROWS : mode == 1 ? 16384 : 1024;
    for (int i = gw; i < nrows; i += 2 * NGW) {
        const int i2 = i + NGW; const bool has2 = i2 < nrows;
        const int row = norm_row(i, mode), row2 = norm_row(has2 ? i2 : i, mode);
        const float* s1 = norm_src(a, first, row); const float* s2 = norm_src(a, first, row2);
        f32x4 v1[4], v2[4];
#pragma unroll
        for (int j = 0; j < 4; ++j) { v1[j] = *(const f32x4*)(s1 + 4 * lane + 256 * j); v2[j] = *(const f32x4*)(s2 + 4 * lane + 256 * j); }
        norm_finish(a, gain, modl, shoff, scoff, first, row, lane, v1);
        if (has2) norm_finish(a, gain, modl, shoff, scoff, first, row2, lane, v2);
    }
}

__device__ __forceinline__ void qk_row(CArgsP a, int l, int row, int lane) {
    bf16* prow = (bf16*)(a->ws + WS_PATT) + (size_t)row * PATT_LD;
    const int p = row % TPB; const bool lat = p >= 256; const int t = p - 256;
    const int hv = lane >> 3, t8 = lane & 7, half = t8 >> 2, tt = t8 & 3, e1 = half * 32 + 4 * tt, e2 = e1 + 16;
    float cs[4], sn[4];
    if (lat) { const float pos = (float)(half == 0 ? (t >> 6) : (t & 63));
#pragma unroll
        for (int i = 0; i < 4; ++i) { const float f = (float)(4 * tt + i); const float invf = __builtin_amdgcn_exp2f(-f * (13.287712379549449f / 16.f)); __sincosf(pos * invf, &sn[i], &cs[i]); } }
    else {
#pragma unroll
        for (int i = 0; i < 4; ++i) { cs[i] = 1.f; sn[i] = 0.f; } }
#pragma unroll
    for (int seg = 0; seg < 4; ++seg) {
        const int colbase = seg == 0 ? C_DAQ : seg == 1 ? C_DAK : seg == 2 ? C_GQQ : C_GQK;
        const float* gain = a->in[seg == 0 ? 8 : seg == 1 ? 9 : seg == 2 ? 12 : 13] + l * 64;
        const bool isq = (seg == 0 || seg == 2); const bool active = (seg == 3) ? (hv < 2) : true;
        bf16* p1 = prow + colbase + hv * 64 + e1; bf16* p2 = prow + colbase + hv * 64 + e2;
        unsigned long long r1 = 0ull, r2 = 0ull; if (active) { r1 = *(const unsigned long long*)p1; r2 = *(const unsigned long long*)p2; }
        const float x1[4] = {bf_lo((unsigned)r1), bf_hi((unsigned)r1), bf_lo((unsigned)(r1 >> 32)), bf_hi((unsigned)(r1 >> 32))};
        const float x2[4] = {bf_lo((unsigned)r2), bf_hi((unsigned)r2), bf_lo((unsigned)(r2 >> 32)), bf_hi((unsigned)(r2 >> 32))};
        float ss = 0.f;
#pragma unroll
        for (int i = 0; i < 4; ++i) ss += x1[i] * x1[i] + x2[i] * x2[i];
        ss += __shfl_xor(ss, 1); ss += __shfl_xor(ss, 2); ss += __shfl_xor(ss, 4);
        const float rstd = __builtin_amdgcn_rsqf(ss * (1.f / 64.f) + NEPS) * (isq ? QSCALE : 1.f);
        float o1[4], o2[4];
#pragma unroll
        for (int i = 0; i < 4; ++i) { const float y1 = x1[i] * rstd * gain[e1 + i], y2 = x2[i] * rstd * gain[e2 + i]; o1[i] = y1 * cs[i] - y2 * sn[i]; o2[i] = y1 * sn[i] + y2 * cs[i]; }
        if (active) { *(unsigned long long*)p1 = (unsigned long long)pg8::pkbf(o1[0], o1[1]) | ((unsigned long long)pg8::pkbf(o1[2], o1[3]) << 32);
                      *(unsigned long long*)p2 = (unsigned long long)pg8::pkbf(o2[0], o2[1]) | ((unsigned long long)pg8::pkbf(o2[2], o2[3]) << 32); }
    }
}

typedef float f32x16 __attribute__((ext_vector_type(16)));
#define MFMA32(a_, b_, c_) __builtin_amdgcn_mfma_f32_32x32x16_bf16((a_), (b_), (c_), 0, 0, 0)
__device__ __forceinline__ bf16x8 pack8(const f32x16& x, int s) {
    v4u p; p.x = pg8::pkbf(x[8 * s + 0], x[8 * s + 1]); p.y = pg8::pkbf(x[8 * s + 2], x[8 * s + 3]); p.z = pg8::pkbf(x[8 * s + 4], x[8 * s + 5]); p.w = pg8::pkbf(x[8 * s + 6], x[8 * s + 7]);
    return __builtin_bit_cast(bf16x8, p);
}
__device__ __forceinline__ void split8(const f32x4 a, const f32x4 b, bf16x8& hi, bf16x8& lo) {
    const float x[8] = {a.x, a.y, a.z, a.w, b.x, b.y, b.z, b.w}; v4u h, l;
    { const unsigned p = pg8::pkbf(x[0], x[1]); h.x = p; l.x = pg8::pkbf(x[0] - bf_lo(p), x[1] - bf_hi(p)); }
    { const unsigned p = pg8::pkbf(x[2], x[3]); h.y = p; l.y = pg8::pkbf(x[2] - bf_lo(p), x[3] - bf_hi(p)); }
    { const unsigned p = pg8::pkbf(x[4], x[5]); h.z = p; l.z = pg8::pkbf(x[4] - bf_lo(p), x[5] - bf_hi(p)); }
    { const unsigned p = pg8::pkbf(x[6], x[7]); h.w = p; l.w = pg8::pkbf(x[6] - bf_lo(p), x[7] - bf_hi(p)); }
    hi = __builtin_bit_cast(bf16x8, h); lo = __builtin_bit_cast(bf16x8, l);
}
constexpr int PS = 132;
constexpr int L_QS = 0, L_KS = 33792, L_VS = 67584, L_NR = 84992, L_KK = 101376, L_QK = 117760, L_SC = 134144;
constexpr int VSS = 136;
__device__ __forceinline__ void dn_task_decode(int task, int& b, int& seg, int& h, int& n, int& NC) {
    b = task / 272; int r = task % 272;
    if (r < 16) { seg = 0; h = r >> 2; n = r & 3; NC = 4; } else { r -= 16; seg = 1; h = r >> 6; n = r & 63; NC = 64; }
}
#ifndef PREP_PROF
#define PREP_PROF 0
#define PREP_SUBA 0
#define PREP_SUBB 0
#endif
#define PREP_MARK(k) do { if (PREP_PROF && blockIdx.x == 0 && tid == 0) { const unsigned t_ = (unsigned)rt(); volatile LAS unsigned* M_ = (volatile LAS unsigned*)(lds + MISC_OFF); M_[16 + (k)] += t_ - prep_t; prep_t = t_; } } while (0)
__device__ __forceinline__ void dn_prep_task(CArgsP a, int l, int task, LAS unsigned char* lds, int tid) {
    asm volatile("" : "+v"(tid));
    unsigned prep_t = (PREP_PROF && blockIdx.x == 0 && tid == 0) ? (unsigned)rt() : 0u;
    int b, seg, h, n, NC; dn_task_decode(task, b, seg, h, n, NC);
    const int seglo = b * TPB + (seg ? 256 : 0), seghi = seglo + NC * 64, rowbase = seglo + 64 * n;
    const bf16* PDN = (const bf16*)a->out;
    LAS float* QS = (LAS float*)(lds + L_QS); LAS float* KS = (LAS float*)(lds + L_KS); LAS bf16* VSb = (LAS bf16*)(lds + L_VS);
    LAS float* KK = (LAS float*)(lds + L_KK); LAS float* QK = (LAS float*)(lds + L_QK);
    LAS float* sBeta = (LAS float*)(lds + L_SC); LAS float* sGc = sBeta + 128; LAS float* sEg = sGc + 128; LAS float* sBe = sEg + 128;
    const int wave = __builtin_amdgcn_readfirstlane(tid >> 6), lane = tid & 63;
    if (tid < 384) { const int cgp = tid % 48, rg = tid / 48, c8 = cgp * 8, which = c8 >> 7, c = c8 & 127, col = which * 512 + h * 128 + c, r0 = rg * 8;
        const float* cw = a->in[14] + (size_t)l * 3 * 1536 + col;
        const f32x4 w0a = *(const f32x4*)cw, w0b = *(const f32x4*)(cw + 4), w1a = *(const f32x4*)(cw + 1536), w1b = *(const f32x4*)(cw + 1540), w2a = *(const f32x4*)(cw + 3072), w2b = *(const f32x4*)(cw + 3076);
        v4u rw[10];
#pragma unroll
        for (int i = 0; i < 10; ++i) { const int row = rowbase + r0 - 1 + i; rw[i] = (v4u){0u, 0u, 0u, 0u}; if (row >= seglo && row < seghi) rw[i] = *(const v4u*)(PDN + (size_t)row * PDN_LD + col); }
        LAS float* dst = (which == 0 ? QS : KS) + c;
#pragma unroll
        for (int i = 0; i < 8; ++i) { const v4u m = rw[i], z = rw[i + 1], n2 = rw[i + 2];
            f32x4 ya = w0a * (f32x4){bf_lo(m.x), bf_hi(m.x), bf_lo(m.y), bf_hi(m.y)} + w1a * (f32x4){bf_lo(z.x), bf_hi(z.x), bf_lo(z.y), bf_hi(z.y)} + w2a * (f32x4){bf_lo(n2.x), bf_hi(n2.x), bf_lo(n2.y), bf_hi(n2.y)};
            f32x4 yb = w0b * (f32x4){bf_lo(m.z), bf_hi(m.z), bf_lo(m.w), bf_hi(m.w)} + w1b * (f32x4){bf_lo(z.z), bf_hi(z.z), bf_lo(z.w), bf_hi(z.w)} + w2b * (f32x4){bf_lo(n2.z), bf_hi(n2.z), bf_lo(n2.w), bf_hi(n2.w)};
            ya = (f32x4){silu_f(ya.x), silu_f(ya.y), silu_f(ya.z), silu_f(ya.w)}; yb = (f32x4){silu_f(yb.x), silu_f(yb.y), silu_f(yb.z), silu_f(yb.w)};
            if (which == 2) { v4u pv; pv.x = pg8::pkbf(ya.x, ya.y); pv.y = pg8::pkbf(ya.z, ya.w); pv.z = pg8::pkbf(yb.x, yb.y); pv.w = pg8::pkbf(yb.z, yb.w); *(LAS v4u*)(VSb + (r0 + i) * VSS + c) = pv; }
            else { *(LAS f32x4*)(dst + (r0 + i) * PS) = ya; *(LAS f32x4*)(dst + (r0 + i) * PS + 4) = yb; } } }
    __syncthreads();
    PREP_MARK(0);
    { const int r = tid >> 3, part = tid & 7;
      LAS float* qp = QS + r * PS + 16 * part; LAS float* kp = KS + r * PS + 16 * part;
      f32x4 qv[4], kv[4]; float sq = 0.f, sk = 0.f;
#pragma unroll
      for (int q = 0; q < 4; ++q) { qv[q] = *(const LAS f32x4*)(qp + 4 * q); kv[q] = *(const LAS f32x4*)(kp + 4 * q);
          sq += (qv[q].x * qv[q].x + qv[q].y * qv[q].y) + (qv[q].z * qv[q].z + qv[q].w * qv[q].w); sk += (kv[q].x * kv[q].x + kv[q].y * kv[q].y) + (kv[q].z * kv[q].z + kv[q].w * kv[q].w); }
      sq += __shfl_xor(sq, 1); sk += __shfl_xor(sk, 1); sq += __shfl_xor(sq, 2); sk += __shfl_xor(sk, 2); sq += __shfl_xor(sq, 4); sk += __shfl_xor(sk, 4);
      const float rq = __builtin_amdgcn_rsqf(sq + NEPS), rk = __builtin_amdgcn_rsqf(sk + NEPS);
#pragma unroll
      for (int q = 0; q < 4; ++q) { *(LAS f32x4*)(qp + 4 * q) = qv[q] * rq; *(LAS f32x4*)(kp + 4 * q) = kv[q] * rk; } }
    if (wave < 2) { const int dir = wave; const int cn = dir ? 63 - lane : lane; const size_t ro = (size_t)(rowbase + cn) * PDN_LD;
        const float braw = bf_1(PDN[ro + C_BRAW + dir * 4 + h]), araw = bf_1(PDN[ro + C_ARAW + dir * 4 + h]);
        const float beta = 1.f / (1.f + expf(-braw));
        const float xs = araw + a->in[16][l * 8 + dir * 4 + h];
        const float ee = __expf(-fabsf(xs)); const float l1p = (ee < 0.03f) ? ee * (1.f - ee * (0.5f - ee * (0.33333334f - 0.25f * ee))) : __logf(1.f + ee); const float sp = fmaxf(xs, 0.f) + l1p;
        float g = -expf(a->in[15][l * 8 + dir * 4 + h]) * sp;
#pragma unroll
        for (int off = 1; off < 64; off <<= 1) { const float v = __shfl_up(g, off); if (lane >= off) g += v; }
        const float eg = expf(g);
        sBeta[dir * 64 + lane] = beta; sGc[dir * 64 + lane] = g; sEg[dir * 64 + lane] = eg; sBe[dir * 64 + lane] = beta * eg;
        if (lane == 63) ((float*)(a->ws + WS_GL))[task * 2 + dir] = eg; }
    __syncthreads();
    PREP_MARK(1);
    { const int mat = wave >> 2, bi = (wave >> 1) & 1, bj = wave & 1, r = lane & 31, hh = lane >> 5;
      const LAS float* pa = (mat ? QS : KS) + (32 * bi + r) * PS + 8 * hh; const LAS float* pb = KS + (32 * bj + r) * PS + 8 * hh;
      f32x16 acc;
#pragma unroll
      for (int q = 0; q < 16; ++q) acc[q] = 0.f;
#pragma unroll
      for (int ks = 0; ks < 8; ++ks) {
          const f32x4 a0 = *(const LAS f32x4*)(pa + 16 * ks), a1 = *(const LAS f32x4*)(pa + 16 * ks + 4), b0 = *(const LAS f32x4*)(pb + 16 * ks), b1 = *(const LAS f32x4*)(pb + 16 * ks + 4);
          bf16x8 ah, al, bh, bl; split8(a0, a1, ah, al); split8(b0, b1, bh, bl);
          acc = MFMA32(ah, bh, acc); acc = MFMA32(ah, bl, acc); acc = MFMA32(al, bh, acc); }
      LAS float* dstm = mat ? QK : KK;
#pragma unroll
      for (int q = 0; q < 16; ++q) dstm[(32 * bi + (q & 3) + 8 * (q >> 2) + 4 * hh) * 64 + 32 * bj + r] = acc[q]; }
    __syncthreads();
    PREP_MARK(2);
    unsigned char* ops0 = a->ws + WS_A + (size_t)task * 2 * OPS_BYTES;
    const float qs = 0.08838834764831845f;
    LAS float* A1m = (LAS float*)(lds + L_NR);
    for (int idx = tid; idx < 4096; idx += NTHR) { const int ip = idx >> 6, jp = idx & 63;
        A1m[idx] = (ip > jp) ? sBeta[64 + ip] * KK[(63 - ip) * 64 + (63 - jp)] * __expf(sGc[64 + ip] - sGc[64 + jp]) : 0.f; }
    __syncthreads();
    for (int idx = tid; idx < 4096; idx += NTHR) { const int ip = idx >> 6, jp = idx & 63;
        KK[idx] = (ip > jp) ? sBeta[ip] * KK[idx] * __expf(sGc[ip] - sGc[jp]) : 0.f; }
    __syncthreads();
    PREP_MARK(3);
    if (wave < 2) { unsigned adoff = wave ? (unsigned)L_NR : (unsigned)L_KK; asm volatile("" : "+v"(adoff)); LAS float* Ad = (LAS float*)(lds + adoff); float X[64];
#pragma unroll
      for (int i = 0; i < 64; ++i) X[i] = (i == lane) ? 1.f : 0.f;
      f32x4 cur[16], nxt[16];
#pragma unroll
      for (int q = 0; q < 16; ++q) { cur[q] = (f32x4){0.f, 0.f, 0.f, 0.f}; nxt[q] = (f32x4){0.f, 0.f, 0.f, 0.f}; }
      cur[0] = *(const LAS f32x4*)(Ad + 64);
#pragma unroll
      for (int i = 1; i < 64; ++i) {
          if (i + 1 < 64) {
#pragma unroll
              for (int q = 0; q < 16; ++q) if (4 * q < i + 1) nxt[q] = *(const LAS f32x4*)(Ad + (i + 1) * 64 + 4 * q); }
          __builtin_amdgcn_sched_barrier(0);
          float s0 = 0.f, s1 = 0.f;
#pragma unroll
          for (int jj = 0; jj < i; ++jj) { const float av = cur[jj >> 2][jj & 3]; if (jj & 1) s1 += av * X[jj]; else s0 += av * X[jj]; }
          X[i] -= (s0 + s1);
          __builtin_amdgcn_sched_barrier(0);
#pragma unroll
          for (int q = 0; q < 16; ++q) cur[q] = nxt[q]; }
#pragma unroll
      for (int i = 0; i < 64; ++i) Ad[i * 64 + lane] = X[i]; }
    else {
    for (int f = tid - 128; f < 2048; f += NTHR - 128) {
        const int dir = f >> 10, ff = f & 1023, mb = ff >> 9, ks = (ff >> 6) & 7, ln = ff & 63, g = ln >> 5, r = ln & 31;
        const int cp = mb * 32 + r, cn = dir ? 63 - cp : cp; const float sc = sEg[dir * 64 + cp] * qs;
        const int db = 32 * (ks >> 1) + 16 * (ks & 1) + 4 * g;
        const f32x4 v0 = *(const LAS f32x4*)(QS + cn * PS + db), v1 = *(const LAS f32x4*)(QS + cn * PS + db + 8);
        v4u o; o.x = pg8::pkbf(v0.x * sc, v0.y * sc); o.y = pg8::pkbf(v0.z * sc, v0.w * sc); o.z = pg8::pkbf(v1.x * sc, v1.y * sc); o.w = pg8::pkbf(v1.z * sc, v1.w * sc);
        *(v4u*)(ops0 + (size_t)dir * OPS_BYTES + 32768 + ff * 16) = o; }
    for (int f = tid - 128; f < 2048; f += NTHR - 128) {
        const int dir = f >> 10, ff = f & 1023, mb = ff >> 8, ks = (ff >> 6) & 3, ln = ff & 63, g = ln >> 5, r = ln & 31;
        const int d = mb * 32 + r; const float gl = sGc[dir * 64 + 63]; float v[8];
#pragma unroll
        for (int j = 0; j < 8; ++j) { const int cp = 16 * ks + 8 * (j >> 2) + 4 * g + (j & 3), cn = dir ? 63 - cp : cp; v[j] = KS[cn * PS + d] * __expf(gl - sGc[dir * 64 + cp]); }
        v4u o; o.x = pg8::pkbf(v[0], v[1]); o.y = pg8::pkbf(v[2], v[3]); o.z = pg8::pkbf(v[4], v[5]); o.w = pg8::pkbf(v[6], v[7]);
        *(v4u*)(ops0 + (size_t)dir * OPS_BYTES + 16384 + ff * 16) = o; }
    for (int f = tid - 128; f < 1024; f += NTHR - 128) {
        const int dir = f >> 9, ff = f & 511, mb = ff >> 8, ks = (ff >> 6) & 3, ln = ff & 63, g = ln >> 5, r = ln & 31;
        const int cp = mb * 32 + r, cn = dir ? 63 - cp : cp; const float gc = sGc[dir * 64 + cp]; float v[8];
#pragma unroll
        for (int j = 0; j < 8; ++j) { const int sp = 16 * ks + 8 * (j >> 2) + 4 * g + (j & 3), sn = dir ? 63 - sp : sp;
            v[j] = (cp >= sp) ? QK[cn * 64 + sn] * qs * __expf(gc - sGc[dir * 64 + sp]) : 0.f; }
        v4u o; o.x = pg8::pkbf(v[0], v[1]); o.y = pg8::pkbf(v[2], v[3]); o.z = pg8::pkbf(v[4], v[5]); o.w = pg8::pkbf(v[6], v[7]);
        *(v4u*)(ops0 + (size_t)dir * OPS_BYTES + 49152 + ff * 16) = o; }
    }
    __syncthreads();
    PREP_MARK(4);
    PREP_MARK(5);
    { const int dir = wave >> 2, wq = wave & 3, r = lane & 31, hh = lane >> 5;
      unsigned tdoff = dir ? (unsigned)L_NR : (unsigned)L_KK; asm volatile("" : "+v"(tdoff)); const LAS float* Td = (const LAS float*)(lds + tdoff); const LAS float* bet = sBeta + dir * 64; const LAS float* bee = sBe + dir * 64;
      unsigned char* opsd = ops0 + (size_t)dir * OPS_BYTES;
      f32x16 zero16;
#pragma unroll
      for (int q = 0; q < 16; ++q) zero16[q] = 0.f;
      bf16x8 bu[4], aw[4];
#pragma unroll
      for (int ks = 0; ks < 4; ++ks) { float t[8], w8[8];
#pragma unroll
        for (int q = 0; q < 8; ++q) { const int jp = 16 * ks + 8 * hh + q, jn = dir ? 63 - jp : jp; t[q] = bf_1(VSb[jn * VSS + 32 * wq + r]) * bet[jp]; w8[q] = KS[jn * PS + 32 * wq + r] * bee[jp]; }
        v4u pu; pu.x = pg8::pkbf(t[0], t[1]); pu.y = pg8::pkbf(t[2], t[3]); pu.z = pg8::pkbf(t[4], t[5]); pu.w = pg8::pkbf(t[6], t[7]); bu[ks] = __builtin_bit_cast(bf16x8, pu);
        v4u pw; pw.x = pg8::pkbf(w8[0], w8[1]); pw.y = pg8::pkbf(w8[2], w8[3]); pw.z = pg8::pkbf(w8[4], w8[5]); pw.w = pg8::pkbf(w8[6], w8[7]); aw[ks] = __builtin_bit_cast(bf16x8, pw); }
#pragma unroll
      for (int mb = 0; mb < 2; ++mb) {
        bf16x8 tf[4];
#pragma unroll
        for (int ks = 0; ks < 4; ++ks) { const f32x4 t0 = *(const LAS f32x4*)(Td + (32 * mb + r) * 64 + 16 * ks + 8 * hh), t1 = *(const LAS f32x4*)(Td + (32 * mb + r) * 64 + 16 * ks + 8 * hh + 4);
            v4u pt; pt.x = pg8::pkbf(t0.x, t0.y); pt.y = pg8::pkbf(t0.z, t0.w); pt.z = pg8::pkbf(t1.x, t1.y); pt.w = pg8::pkbf(t1.z, t1.w); tf[ks] = __builtin_bit_cast(bf16x8, pt); }
        f32x16 cu = zero16, cw = zero16;
#pragma unroll
        for (int ks = 0; ks < 4; ++ks) { cu = MFMA32(tf[ks], bu[ks], cu); cw = MFMA32(aw[ks], tf[ks], cw); }
        { v4u o0, o1; o0.x = pg8::pkbf(cu[0], cu[1]); o0.y = pg8::pkbf(cu[2], cu[3]); o0.z = pg8::pkbf(cu[4], cu[5]); o0.w = pg8::pkbf(cu[6], cu[7]);
          o1.x = pg8::pkbf(cu[8], cu[9]); o1.y = pg8::pkbf(cu[10], cu[11]); o1.z = pg8::pkbf(cu[12], cu[13]); o1.w = pg8::pkbf(cu[14], cu[15]);
          unsigned char* dst = opsd + 57344 + ((wq * 2 + mb) * 64 + lane) * 32; *(v4u*)dst = o0; *(v4u*)(dst + 16) = o1; }
        { v4u n0, n1; n0.x = pg8::pkbf(-cw[0], -cw[1]); n0.y = pg8::pkbf(-cw[2], -cw[3]); n0.z = pg8::pkbf(-cw[4], -cw[5]); n0.w = pg8::pkbf(-cw[6], -cw[7]);
          n1.x = pg8::pkbf(-cw[8], -cw[9]); n1.y = pg8::pkbf(-cw[10], -cw[11]); n1.z = pg8::pkbf(-cw[12], -cw[13]); n1.w = pg8::pkbf(-cw[14], -cw[15]);
          *(v4u*)(opsd + ((mb * 8 + 2 * wq) * 64 + lane) * 16) = n0; *(v4u*)(opsd + ((mb * 8 + 2 * wq + 1) * 64 + lane) * 16) = n1; }
      } }
    __syncthreads();
    PREP_MARK(6);
}

__device__ __forceinline__ const unsigned char* scan_ops(CArgsP a, int b, int h, int dir, int st, int& task, int& rowb) {
    const int seg = st >= 4, step = seg ? st - 4 : st, NC = seg ? 64 : 4, n = dir ? NC - 1 - step : step;
    task = b * 272 + (seg ? 16 + h * 64 + n : h * 4 + n); rowb = b * TPB + (seg ? 256 : 0) + 64 * n;
    return a->ws + WS_A + ((size_t)task * 2 + dir) * OPS_BYTES;
}
__device__ __forceinline__ void dn_scan_chain(CArgsP a, int chain, LAS unsigned char* lds, int tid) {
    const int wave = __builtin_amdgcn_readfirstlane(tid >> 6), lane = tid & 63;
    const int b = chain >> 3, h = (chain >> 1) & 3, dir = chain & 1;
    const int g = lane >> 5, e = lane & 31, sl = wave & 3;
    bf16* OFB = (bf16*)a->out + (size_t)dir * MROWS * 512;
    const float* GL = (const float*)(a->ws + WS_GL);
    f32x16 S[4];
#pragma unroll
    for (int i = 0; i < 4; ++i)
#pragma unroll
        for (int r = 0; r < 16; ++r) S[i][r] = 0.f;
    v4u R[7], U[4]; float gl; int task, rowb;
    { const unsigned char* ops = scan_ops(a, b, h, dir, 0, task, rowb);
#pragma unroll
      for (int i = 0; i < 7; ++i) R[i] = *(const v4u*)(ops + 16 * (tid + 512 * i));
#pragma unroll
      for (int mb = 0; mb < 2; ++mb) { const v4u* up = (const v4u*)(ops + 57344 + ((sl * 2 + mb) * 64 + lane) * 32); U[2 * mb] = up[0]; U[2 * mb + 1] = up[1]; }
      gl = GL[task * 2 + dir];
#pragma unroll
      for (int i = 0; i < 7; ++i) *(LAS v4u*)(lds + 16 * (tid + 512 * i)) = R[i]; }
    __syncthreads();
    for (int st = 0; st < 68; ++st) {
        const LAS unsigned char* buf = lds + (st & 1) * 57344;
        const int rowc = rowb; const float glc = gl; v4u Uc[4];
#pragma unroll
        for (int i = 0; i < 4; ++i) Uc[i] = U[i];
        if (st + 1 < 68) { const unsigned char* ops = scan_ops(a, b, h, dir, st + 1, task, rowb);
#pragma unroll
            for (int i = 0; i < 7; ++i) R[i] = *(const v4u*)(ops + 16 * (tid + 512 * i));
#pragma unroll
            for (int mb = 0; mb < 2; ++mb) { const v4u* up = (const v4u*)(ops + 57344 + ((sl * 2 + mb) * 64 + lane) * 32); U[2 * mb] = up[0]; U[2 * mb + 1] = up[1]; }
            gl = GL[task * 2 + dir]; }
        if (wave < 4) {
            const LAS bf16x8* NW = (const LAS bf16x8*)buf + lane; const LAS bf16x8* KT = (const LAS bf16x8*)(buf + 16384) + lane;
            const LAS bf16x8* QD = (const LAS bf16x8*)(buf + 32768) + lane; const LAS bf16x8* QKp = (const LAS bf16x8*)(buf + 49152) + lane;
            bf16x8 Sb[8];
#pragma unroll
            for (int ks = 0; ks < 8; ++ks) Sb[ks] = pack8(S[ks >> 1], ks & 1);
            f32x16 vn[2];
#pragma unroll
            for (int mb = 0; mb < 2; ++mb) {
                const v4u u0 = Uc[2 * mb], u1 = Uc[2 * mb + 1];
                f32x16 c;
                c[0] = bf_lo(u0.x); c[1] = bf_hi(u0.x); c[2] = bf_lo(u0.y); c[3] = bf_hi(u0.y); c[4] = bf_lo(u0.z); c[5] = bf_hi(u0.z); c[6] = bf_lo(u0.w); c[7] = bf_hi(u0.w);
                c[8] = bf_lo(u1.x); c[9] = bf_hi(u1.x); c[10] = bf_lo(u1.y); c[11] = bf_hi(u1.y); c[12] = bf_lo(u1.z); c[13] = bf_hi(u1.z); c[14] = bf_lo(u1.w); c[15] = bf_hi(u1.w);
#pragma unroll
                for (int ks = 0; ks < 8; ++ks) c = MFMA32(NW[(mb * 8 + ks) * 64], Sb[ks], c);
                vn[mb] = c; }
            bf16x8 Vb[4];
#pragma unroll
            for (int ks = 0; ks < 4; ++ks) Vb[ks] = pack8(vn[ks >> 1], ks & 1);
#pragma unroll
            for (int mb = 0; mb < 2; ++mb) {
                f32x16 o;
#pragma unroll
                for (int r = 0; r < 16; ++r) o[r] = 0.f;
#pragma unroll
                for (int ks = 0; ks < 8; ++ks) o = MFMA32(QD[(mb * 8 + ks) * 64], Sb[ks], o);
#pragma unroll
                for (int ks = 0; ks < 4; ++ks) o = MFMA32(QKp[(mb * 4 + ks) * 64], Vb[ks], o);
#pragma unroll
                for (int r = 0; r < 16; ++r) { const int cp = mb * 32 + (r & 3) + 8 * (r >> 2) + 4 * g; const int cn = dir ? 63 - cp : cp;
                    OFB[(size_t)(rowc + cn) * 512 + h * 128 + sl * 32 + e] = (bf16)(pg8::pkbf(o[r], 0.f) & 0xffffu); } }
#pragma unroll
            for (int mb = 0; mb < 4; ++mb) { f32x16 c = S[mb] * glc;
#pragma unroll
                for (int ks = 0; ks < 4; ++ks) c = MFMA32(KT[(mb * 4 + ks) * 64], Vb[ks], c);
                S[mb] = c; }
        }
        if (st + 1 < 68) { LAS unsigned char* nb = lds + ((st + 1) & 1) * 57344;
#pragma unroll
            for (int i = 0; i < 7; ++i) *(LAS v4u*)(nb + 16 * (tid + 512 * i)) = R[i]; }
        __syncthreads();
    }
}

__device__ __forceinline__ void unpack8(const v4u w, float (&f)[8]) { f[0] = bf_lo(w.x); f[1] = bf_hi(w.x); f[2] = bf_lo(w.y); f[3] = bf_hi(w.y); f[4] = bf_lo(w.z); f[5] = bf_hi(w.z); f[6] = bf_lo(w.w); f[7] = bf_hi(w.w); }
__device__ __forceinline__ float sum16(float v) { return row16_sum(v); }
__device__ __forceinline__ void post2_row(CArgsP a, int l, int row, int lane, float lam, float one_m_li) {
    const int h = lane >> 4, pt = lane & 15, e0 = 8 * pt;
    const bf16* od = (const bf16*)(a->ws + WS_A + A_ODA) + (size_t)row * 1024;
    bf16* oabc = (bf16*)(a->ws + WS_A + A_MRGF); bf16* oa = oabc + (size_t)row * 512;
    const bf16* of = (const bf16*)a->out + (size_t)row * 512; const bf16* ob = of + (size_t)MROWS * 512;
    bf16* oc = oabc + ((size_t)2 * MROWS + row) * 512;
    { const bf16* og = (const bf16*)(a->ws + WS_PATT) + (size_t)row * PATT_LD + C_GQQ; *(v4u*)(oabc + ((size_t)MROWS + row) * 512 + 8 * lane) = *(const v4u*)(og + 8 * lane); }
    const bf16* zr = (const bf16*)(a->ws + WS_PATT) + (size_t)row * PATT_LD + C_Z;
    float o1[8], o2[8], ff[8], fb[8], zz[8];
    unpack8(*(const v4u*)(od + (h * 2) * 128 + e0), o1); unpack8(*(const v4u*)(od + (h * 2 + 1) * 128 + e0), o2);
    unpack8(*(const v4u*)(of + h * 128 + e0), ff); unpack8(*(const v4u*)(ob + h * 128 + e0), fb); unpack8(*(const v4u*)(zr + h * 128 + e0), zz);
    const float* sg = a->in[11] + l * 128 + e0; const float* ng = a->in[17] + l * 128 + e0;
    float d[8], c[8], s1 = 0.f, s2 = 0.f;
#pragma unroll
    for (int i = 0; i < 8; ++i) { d[i] = o1[i] - lam * o2[i]; c[i] = ff[i] + fb[i]; s1 += d[i] * d[i]; s2 += c[i] * c[i]; }
    s1 = sum16(s1); s2 = sum16(s2);
    const float r1 = __builtin_amdgcn_rsqf(s1 * (1.f / 128.f) + NEPS) * one_m_li, r2 = __builtin_amdgcn_rsqf(s2 * (1.f / 128.f) + NEPS);
    float ra[8], rc[8];
#pragma unroll
    for (int i = 0; i < 8; ++i) { ra[i] = d[i] * r1 * sg[i]; rc[i] = c[i] * r2 * ng[i] * silu_f(zz[i]); }
    v4u wa, wc; wa.x = pg8::pkbf(ra[0], ra[1]); wa.y = pg8::pkbf(ra[2], ra[3]); wa.z = pg8::pkbf(ra[4], ra[5]); wa.w = pg8::pkbf(ra[6], ra[7]);
    wc.x = pg8::pkbf(rc[0], rc[1]); wc.y = pg8::pkbf(rc[2], rc[3]); wc.z = pg8::pkbf(rc[4], rc[5]); wc.w = pg8::pkbf(rc[6], rc[7]);
    *(v4u*)(oa + h * 128 + e0) = wa; *(v4u*)(oc + h * 128 + e0) = wc;
}

__device__ __forceinline__ void phase_act(CArgsP a, int l, int gtid, int nthr) {
    bf16* AU = (bf16*)(a->ws + WS_A);
    const float* cw = a->in[24] + (size_t)l * 3 * DFF; const float* cb = a->in[25] + (size_t)l * DFF;
    for (int it = gtid; it < 2176 * 352; it += nthr) {
        const int cgp = it % 352, strip = it / 352, r0 = strip * 8, p0 = r0 % TPB, col = cgp * 8;
        const bool topv = (p0 != 0 && p0 != 256), botv = (p0 + 7 != 255 && p0 + 7 != TPB - 1);
        const bf16* ap = AU + (size_t)r0 * AU_LD + col;
        v4u ar[10], ur[8];
        ar[0] = (v4u){0u, 0u, 0u, 0u}; if (topv) ar[0] = *(const v4u*)(ap - AU_LD);
#pragma unroll
        for (int i = 0; i < 8; ++i) { ar[i + 1] = *(const v4u*)(ap + (size_t)i * AU_LD); ur[i] = *(const v4u*)(ap + (size_t)i * AU_LD + DFF); }
        ar[9] = (v4u){0u, 0u, 0u, 0u}; if (botv) ar[9] = *(const v4u*)(ap + (size_t)8 * AU_LD);
        float w0[8], w1[8], w2[8], bb[8];
#pragma unroll
        for (int i = 0; i < 8; ++i) { w0[i] = cw[col + i]; w1[i] = cw[DFF + col + i]; w2[i] = cw[2 * DFF + col + i]; bb[i] = cb[col + i]; }
#pragma unroll
        for (int i = 0; i < 8; ++i) { float pm[8], pc[8], pn[8], pu[8], o[8];
            unpack8(ar[i], pm); unpack8(ar[i + 1], pc); unpack8(ar[i + 2], pn); unpack8(ur[i], pu);
#pragma unroll
            for (int k = 0; k < 8; ++k) o[k] = silu_f(w0[k] * pm[k] + w1[k] * pc[k] + w2[k] * pn[k] + bb[k]) * pu[k];
            v4u w; w.x = pg8::pkbf(o[0], o[1]); w.y = pg8::pkbf(o[2], o[3]); w.z = pg8::pkbf(o[4], o[5]); w.w = pg8::pkbf(o[6], o[7]);
            *(v4u*)(AU + (size_t)(r0 + i) * AU_LD + DFF + col) = w; }
    }
}

constexpr size_t WS_EP = WS_END, WS_EA = WS_END + 6127616, WS_EU = WS_EA + 3063808, WS_END2 = WS_EU + 3063808;
__device__ __forceinline__ void phase_act_fix(CArgsP a, int l, int gtid, int nthr) {
    bf16* ACT = (bf16*)(a->ws + WS_A); const float* EP = (const float*)(a->ws + WS_EP); const bf16* EA = (const bf16*)(a->ws + WS_EA); const bf16* EU = (const bf16*)(a->ws + WS_EU);
    const float* cw = a->in[24] + (size_t)l * 3 * DFF;
    for (int it = gtid; it < 544 * 352; it += nthr) {
        const int cgp = it % 352, e = it / 352, col = cgp * 8, bot = e & 1, row = (e >> 1) * 64 + (bot ? 63 : 0), p = row % TPB;
        const bool nbv = bot ? (p != 255 && p != TPB - 1) : (p != 0 && p != 256);
        float nb[8] = {0.f, 0.f, 0.f, 0.f, 0.f, 0.f, 0.f, 0.f}, uu[8];
        if (nbv) unpack8(*(const v4u*)(EA + (size_t)(bot ? e + 1 : e - 1) * DFF + col), nb);
        unpack8(*(const v4u*)(EU + (size_t)e * DFF + col), uu);
        const f32x4 p0 = *(const f32x4*)(EP + (size_t)e * DFF + col), p1 = *(const f32x4*)(EP + (size_t)e * DFF + col + 4);
        const float* wm = cw + (bot ? 2 * DFF : 0) + col;
        const float pp[8] = {p0.x, p0.y, p0.z, p0.w, p1.x, p1.y, p1.z, p1.w}; float o[8];
#pragma unroll
        for (int k = 0; k < 8; ++k) o[k] = silu_f(pp[k] + wm[k] * nb[k]) * uu[k];
        v4u w; w.x = pg8::pkbf(o[0], o[1]); w.y = pg8::pkbf(o[2], o[3]); w.z = pg8::pkbf(o[4], o[5]); w.w = pg8::pkbf(o[6], o[7]);
        *(v4u*)(ACT + (size_t)row * DFF + col) = w; }
}

typedef pg8::Epi<1, 0> EpiIn; typedef pg8::Epi<2, 0> EpiGate; typedef pg8::Epi<0, 0> EpiSt;
__global__ void __launch_bounds__(NTHR, 2) mk_fwd(Args args_unused) {
    extern __shared__ __attribute__((aligned(16))) unsigned char lds_raw[];
    LAS unsigned char* lds = (LAS unsigned char*)lds_raw;
    volatile LAS unsigned* MISC = (volatile LAS unsigned*)(lds + MISC_OFF);
    const int tid = threadIdx.x, lane = tid & 63, wave = __builtin_amdgcn_readfirstlane(tid >> 6);
    const int G = gridDim.x, bid = blockIdx.x;
    const int gw = bid * NWAVES + wave, NGW = G * NWAVES;
    for (int u = tid; u < 64; u += NTHR) MISC[u] = 0u;
    __syncthreads();
    { ARGS_HERE(A); (void)xcd_barrier_post((unsigned*)(A->ws + WS_CTL) + CW_BAR, MISC); }
#ifndef DUP_MASK
#define DUP_MASK 0
#endif
#ifndef PROF_A
#define PROF_A 0
#endif
#ifndef PROF_B
#define PROF_B 0
#endif
    unsigned long long prof_a = 0ull, prof_b = 0ull, prof_last = 0ull; int prof_ph = 0;
#define GRID_BAR() do { ARGS_HERE(B_); XcdBarrier bar; bar.bar = (unsigned*)(B_->ws + WS_CTL) + CW_BAR; bar.x = xb_xcc_id(); bar.st = MISC; xcd_barrier(bar); \
    if (PROF_A | PROF_B) { const unsigned long long t_ = rt(); if ((PROF_A >> prof_ph) & 1) prof_a += t_ - prof_last; if ((PROF_B >> prof_ph) & 1) prof_b += t_ - prof_last; prof_last = t_; ++prof_ph; } } while (0)
#define PHASE_IDS() int ptid = threadIdx.x; asm volatile("" : "+v"(ptid)); const int plane = ptid & 63; const int pwave = __builtin_amdgcn_readfirstlane(ptid >> 6); const int pgw = bid * NWAVES + pwave; (void)plane; (void)pgw

    const unsigned long long prof_t0 = (PROF_A | PROF_B) ? rt() : 0ull;
    { ARGS_HERE(A); phase_mod(A, lds, tid, bid, G); phase_convert(A, 0, lds, gw, NGW, wave, lane); }
    { ARGS_HERE(A); if (A->out == nullptr) cg::this_grid().sync(); }
    GRID_BAR();
    if ((PROF_A >> 15) & 1) prof_a += rt() - prof_t0;

    for (int l = 0; l < NLAYER; ++l) {
        if (PROF_A | PROF_B) { prof_ph = 0; prof_last = rt(); }
        { ARGS_HERE(A); PHASE_IDS();
          if (l == 0) phase_norm(A, 0, 0, pgw, NGW, plane, 0);
          else { phase_convert(A, l, lds, pgw, NGW, pwave, plane, 7936, 9344); phase_norm(A, l, 0, pgw, NGW, plane, 2); } }
        GRID_BAR();
        { ARGS_HERE(A); PHASE_IDS(); unsigned char* ws = A->ws;
          pg8::Gemm g{(bf16*)(ws + WS_HN), (bf16*)(ws + WS_WT) + WT_IN, MROWS, 4608, 1024, 1024}; pg8::StaticOrder S; S.init(MROWS, 4608, G, bid);
          EpiIn E{(bf16*)(ws + WS_PATT), PATT_LD, (bf16*)A->out, nullptr, 0, 0, nullptr, nullptr, nullptr};
          pg8::gemm_phase<EpiIn, pg8::StaticOrder, true, true>(lds, g, S, E);
          if (DUP_MASK & 2) pg8::gemm_phase<EpiIn, pg8::StaticOrder, true, true>(lds, g, S, E); }
        GRID_BAR();
        { ARGS_HERE(A); PHASE_IDS();
          for (;;) {
            if (ptid == 0) MISC[8] = __hip_atomic_fetch_add((unsigned*)(A->ws + WS_CTL) + CW_Q + 64 * l + 32, 1u, __ATOMIC_RELAXED, __HIP_MEMORY_SCOPE_AGENT);
            __syncthreads();
            const int q = __builtin_amdgcn_readfirstlane((int)MISC[8]);
            __syncthreads();
            if (q >= 1088 + 272) break;
            if (q < 1088) { dn_prep_task(A, l, q, lds, ptid); continue; }
            const int r0 = (q - 1088) * 64 + pwave * 8;
            for (int r = 0; r < 8; ++r) qk_row(A, l, r0 + r, plane);
          } }
        GRID_BAR();
        for (int pass = ((DUP_MASK & 8) ? 0 : 1); pass < 2; ++pass)
        { const int nunits = 32 + 1536 + (l < NLAYER - 1 ? 96 : 0);
          for (;;) {
            ARGS_HERE(A); PHASE_IDS(); unsigned char* ws = A->ws;
            if (ptid == 0) MISC[8] = __hip_atomic_fetch_add((unsigned*)(ws + WS_CTL) + CW_Q + 64 * l + 16 * pass, 1u, __ATOMIC_RELAXED, __HIP_MEMORY_SCOPE_AGENT);
            __syncthreads();
            const int q = __builtin_amdgcn_readfirstlane((int)MISC[8]);
            __syncthreads();
            if (q >= nunits) break;
            if (q < 32) { dn_scan_chain(A, q, lds, ptid); if (DUP_MASK & 128) { __syncthreads(); dn_scan_chain(A, q, lds, ptid); } asm volatile("s_waitcnt vmcnt(0)" ::: "memory"); __syncthreads(); continue; }
            bf16* PATT = (bf16*)(ws + WS_PATT); bf16* ODA = (bf16*)(ws + WS_A + A_ODA);
            int u = q - 32, combo, qt, NT;
            if (u < 1536) { combo = u >> 4; qt = 1 + (u & 15); NT = 68; } else { combo = u - 1536; qt = 0; NT = 4; }
            const attn_body::bf16 *Qp, *Kp, *Vp; attn_body::bf16* Op; int PO;
            if (combo < 64) { const int b = combo >> 4, vh = combo & 15, hh = vh >> 1, vhalf = vh & 1, h = vh >> 2;
                const size_t r0 = (size_t)b * TPB; const size_t rq = r0 + (size_t)qt * 256;
                Qp = (const attn_body::bf16*)(PATT + rq * PATT_LD + C_DAQ + hh * 64); Kp = (const attn_body::bf16*)(PATT + r0 * PATT_LD + C_DAK + hh * 64);
                Vp = (const attn_body::bf16*)(PATT + r0 * PATT_LD + C_DAV + h * 128 + vhalf * 64); Op = (attn_body::bf16*)(ODA + rq * 1024 + hh * 128 + vhalf * 64); PO = 1024; }
            else { const int cc = combo - 64, b = cc >> 3, hq = cc & 7, kvh = hq >> 2;
                const size_t r0 = (size_t)b * TPB; const size_t rq = r0 + (size_t)qt * 256;
                Qp = (const attn_body::bf16*)(PATT + rq * PATT_LD + C_GQQ + hq * 64); Kp = (const attn_body::bf16*)(PATT + r0 * PATT_LD + C_GQK + kvh * 64);
                Vp = (const attn_body::bf16*)(PATT + r0 * PATT_LD + C_GQV + kvh * 64); Op = (attn_body::bf16*)(PATT + rq * PATT_LD + C_GQQ + hq * 64); PO = PATT_LD;
                if (pass == 0) { Op = (attn_body::bf16*)((bf16*)(ws + WS_OC) + rq * 512 + hq * 64); PO = 512; } }
            attn_body::attn_unit<8>(Qp, Kp, Vp, Op, PATT_LD, PATT_LD, PATT_LD, PO, NT, (char*)lds_raw);
          } }
        GRID_BAR();
        { ARGS_HERE(A); PHASE_IDS();
          const float lam_init = 0.8f - 0.6f * expf(-0.3f * (float)l);
          const float* lp = A->in[10] + l * 256;
          const float s01 = wave_sum(lp[plane] * lp[64 + plane]), s23 = wave_sum(lp[128 + plane] * lp[192 + plane]);
          const float lam = expf(s01) - expf(s23) + lam_init;
          for (int row = pgw; row < MROWS; row += NGW) post2_row(A, l, row, plane, lam, 1.f - lam_init);
          if (DUP_MASK & 16) for (int row = pgw; row < MROWS; row += NGW) post2_row(A, l, row, plane, lam, 1.f - lam_init); }
        { ARGS_HERE(A); PHASE_IDS(); unsigned char* ws = A->ws;
          pg8::Gemm g{(bf16*)(ws + WS_HN), (bf16*)(ws + WS_WT) + WT_IN + (size_t)4608 * 1024, MROWS, 3072, 1024, 1024}; pg8::StaticOrder S; S.init(l == NLAYER - 1 ? 16384 : MROWS, 3072, G, bid, l == NLAYER - 1);
          EpiGate E{(bf16*)(ws + WS_A), 3072, nullptr, nullptr, 0, 0, nullptr, nullptr, nullptr};
          pg8::gemm_phase<EpiGate, pg8::StaticOrder, true, true>(lds, g, S, E);
          if (DUP_MASK & 32) pg8::gemm_phase<EpiGate, pg8::StaticOrder, true, true>(lds, g, S, E); }
        GRID_BAR();
        { ARGS_HERE(A); PHASE_IDS(); unsigned char* ws = A->ws;
          pg8::ChainOrder S; S.so.init(l == NLAYER - 1 ? 16384 : MROWS, 1024, G, bid, l == NLAYER - 1);
          pg8::Gemm g{(bf16*)(ws + WS_A + A_MRGF), (bf16*)(ws + WS_WT) + WT_BRA, 3 * MROWS, 3072, 512, 512, 0};
          pg8::Epi<3, 4> E{(bf16*)A->out, 1024, nullptr, (bf16*)(ws + WS_A), 3072, 0, nullptr, nullptr, nullptr};
          pg8::gemm_phase<pg8::Epi<3, 4>, pg8::ChainOrder, true, true>(lds, g, S, E); }
        GRID_BAR();
        { const int nrnd = (l < NLAYER - 1) ? 2 : 1;
          for (int rnd = 0; rnd < nrnd; ++rnd) {
            { ARGS_HERE(A); PHASE_IDS(); unsigned char* ws = A->ws;
              const float* mp = (const float*)(ws + WS_MOD) + (size_t)l * 5 * 6144 + 2 * 1024;
              pg8::Gemm g{(bf16*)A->out, (bf16*)(ws + WS_WT) + WT_O, MROWS, 1024, 1024, 1024, 0}; pg8::StaticOrder S; S.init(rnd == 0 ? 16384 : 1024, 1024, G, bid, rnd == 0 ? 1 : 2);
              pg8::Epi<4, 0> E{nullptr, 0, nullptr, nullptr, 0, 0, (float*)(ws + WS_XS), mp, nullptr};
              pg8::gemm_phase<pg8::Epi<4, 0>, pg8::StaticOrder, true, true>(lds, g, S, E);
              if (rnd == 1 && bid >= 16) phase_norm(A, l, 1, (bid - 16) * NWAVES + pwave, (G - 16) * NWAVES, plane, 1); }
            GRID_BAR(); }
          { ARGS_HERE(A); PHASE_IDS(); phase_norm(A, l, 1, pgw, NGW, plane, (l < NLAYER - 1) ? 2 : 1); }
          GRID_BAR(); }
        { ARGS_HERE(A); PHASE_IDS(); unsigned char* ws = A->ws;
          pg8::Gemm g{(bf16*)(ws + WS_HN), (bf16*)(ws + WS_WT) + WT_1, MROWS, 5632, 1024, 1024}; pg8::StaticOrder S; S.init(l == NLAYER - 1 ? 16384 : MROWS, 5632, G, bid, l == NLAYER - 1);
          pg8::Epi<5, 0> E{(bf16*)(ws + WS_A), DFF, (bf16*)(ws + WS_EA), (const bf16*)(ws + WS_EU), 0, 0, (float*)(ws + WS_EP), A->in[24] + (size_t)l * 3 * DFF, (float*)(A->in[25] + (size_t)l * DFF)};
          pg8::gemm_phase<pg8::Epi<5, 0>, pg8::StaticOrder, true, true>(lds, g, S, E); }
        GRID_BAR();
        { ARGS_HERE(A); PHASE_IDS(); phase_act_fix(A, l, bid * NTHR + ptid, G * NTHR); }
        GRID_BAR();
        if (l < NLAYER - 1) {
          for (int rnd = 0; rnd < 2; ++rnd) {
            { ARGS_HERE(A); PHASE_IDS(); unsigned char* ws = A->ws;
              const float* mp = (const float*)(ws + WS_MOD) + (size_t)l * 5 * 6144 + 5 * 1024;
              pg8::Gemm g{(bf16*)(ws + WS_A), (bf16*)(ws + WS_WT) + WT_2, MROWS, 1024, 2816, DFF, 0}; pg8::StaticOrder S; S.init(rnd == 0 ? 16384 : 1024, 1024, G, bid, rnd == 0 ? 1 : 2);
              pg8::Epi<4, 0> E{nullptr, 0, nullptr, nullptr, 0, 0, (float*)(ws + WS_XS), mp, nullptr};
              pg8::gemm_phase<pg8::Epi<4, 0>, pg8::StaticOrder, true, true>(lds, g, S, E);
              if (rnd == 1 && bid >= 16) { const int gw2 = (bid - 16) * NWAVES + pwave, ngw2 = (G - 16) * NWAVES;
                  phase_convert(A, l + 1, lds, gw2, ngw2, pwave, plane, 0, 7936); phase_norm(A, l + 1, 0, gw2, ngw2, plane, 1); } }
            GRID_BAR(); }
        } else {
          ARGS_HERE(A); PHASE_IDS(); unsigned char* ws = A->ws;
          const float* mp = (const float*)(ws + WS_MOD) + (size_t)l * 5 * 6144 + 5 * 1024;
          pg8::Gemm g{(bf16*)(ws + WS_A), (bf16*)(ws + WS_WT) + WT_2, MROWS, 1024, 2816, DFF, 0}; pg8::StaticOrder S; S.init(16384, 1024, G, bid, 1);
          pg8::Epi<4, 1> E{nullptr, 0, nullptr, nullptr, 0, 0, (float*)(ws + WS_XS), mp, A->out};
          pg8::gemm_phase<pg8::Epi<4, 1>, pg8::StaticOrder, true, true>(lds, g, S, E);
          if (PROF_A | PROF_B) GRID_BAR();
        }
    }
    if (PREP_PROF && blockIdx.x == 0) { const unsigned long long extra = (unsigned long long)MISC[16 + PREP_SUBA] + ((unsigned long long)MISC[16 + PREP_SUBB] / 1000ull) * 100000ull, t0_ = rt(); while (rt() - t0_ < extra) __builtin_amdgcn_s_sleep(8); }
    if ((PROF_A | PROF_B) && blockIdx.x == 0) { const unsigned long long extra = prof_a + (prof_b / 1000ull) * 100000ull, t0_ = rt(); while (rt() - t0_ < extra) __builtin_amdgcn_s_sleep(8); }
}

extern "C" void kernel_launch(void* const* d_in, const int* in_sizes, int n_in, void* d_out, int out_size, void* d_ws, size_t ws_size, hipStream_t stream) {
    static int grid = 0;
    if (grid == 0) {
        if (n_in != 27 || out_size != 4 * 4096 * 1024 || ws_size < WS_END2) { fprintf(stderr, "kernel_launch: unexpected shapes (n_in %d out %d ws %zu need %zu)\n", n_in, out_size, ws_size, (size_t)WS_END2); grid = -1; return; }
        int dev = 0, cus = 0, per_cu = 0;
        hipGetDevice(&dev); hipDeviceGetAttribute(&cus, hipDeviceAttributeMultiprocessorCount, dev);
        if (hipFuncSetAttribute((const void*)mk_fwd, hipFuncAttributeMaxDynamicSharedMemorySize, LDS_BYTES) != hipSuccess) { fprintf(stderr, "kernel_launch: hipFuncSetAttribute failed\n"); grid = -1; return; }
        if (hipOccupancyMaxActiveBlocksPerMultiprocessor(&per_cu, (const void*)mk_fwd, NTHR, LDS_BYTES) != hipSuccess || per_cu < 1) { fprintf(stderr, "kernel_launch: occupancy query says %d\n", per_cu); per_cu = 1; }
        (void)hipGetLastError();
        grid = cus;
    }
    if (grid < 0) return;
    hipMemsetAsync((char*)d_ws + WS_CTL, 0, CTL_ZERO_BYTES, stream);
    Args a{};
    for (int i = 0; i < 27; ++i) a.in[i] = (const float*)d_in[i];
    a.out = (float*)d_out; a.ws = (unsigned char*)d_ws;
    void* kargs[] = {&a};
    hipError_t e = hipLaunchCooperativeKernel((const void*)mk_fwd, dim3(grid), dim3(NTHR), kargs, LDS_BYTES, stream);
    if (e != hipSuccess) fprintf(stderr, "kernel_launch: cooperative launch failed: %s (grid %d)\n", hipGetErrorString(e), grid);
}
```

```cpp
#include <hip/hip_runtime.h>
#include <hip/hip_cooperative_groups.h>
#include <hip/hip_bf16.h>
#include <cstdio>
#include <cstdint>
#include <cmath>
namespace cg = cooperative_groups;
namespace pg8 {
#define PG8_LAS __attribute__((address_space(3)))
typedef unsigned short bf16_t;
typedef short bf16x8 __attribute__((ext_vector_type(8)));
typedef float f32x4 __attribute__((ext_vector_type(4)));
typedef unsigned u32x4 __attribute__((ext_vector_type(4)));
constexpr int BM = 256, BK = 64, HALF = 128, HTB = HALF * BK * 2  , STAGE_BYTES = 8 * HTB, NXCD = 8, WGM = 8;

__host__ __device__ __forceinline__ int lds_byte(int r, int c) { const int st = (r >> 4) * 2 + (c >> 5), rr = r & 15, cc = c & 31, ob = rr * 64 + cc * 2; return st * 1024 + (ob ^ (((ob >> 9) & 1) << 5)); }
__host__ __device__ __forceinline__ void stage_rc(int b, int& R, int& C) { const int st = b / 1024, sb = b % 1024, swz = sb ^ (((sb >> 9) & 1) << 5); R = (st >> 1) * 16 + swz / 64; C = (st & 1) * 32 + (swz % 64) / 2; }
__host__ __device__ __forceinline__ int perm32(int rho) { const int n = rho >> 4, i = rho & 15; return 8 * (i >> 2) + 4 * n + (i & 3); }

struct Unit { int pm, pn; };
struct Gemm { const bf16_t* A; const bf16_t* Bt; int M, N, K, lda, ldb; };
struct OneUnit { Unit u; int has; __device__ __forceinline__ bool next(int i, Unit& o) const { if (i != 0 || !has) return false; o = u; return true; } __device__ __forceinline__ void a_ready(const Unit&) const {} __device__ __forceinline__ void done(const Unit&) const {} };

struct StaticOrder {
    int nM, nN, nwg, G, c, lat;
    __host__ __device__ void init(int M, int N, int G_, int c_, int lat_ = 0) { nM = M / BM; nN = N / BM; nwg = nM * nN; G = G_; c = c_; lat = lat_; }
    __host__ __device__ bool next(int i, Unit& u) const {
        const long L = (long)i * G + c; if (L >= nwg) return false;
        int wgid = (int)L; { const int q = nwg / NXCD, r = nwg % NXCD, xcd = wgid % NXCD, off = wgid / NXCD; wgid = (xcd < r ? xcd * (q + 1) : r * (q + 1) + (xcd - r) * q) + off; }
        const int nig = WGM * nN, gid = wgid / nig, fm = gid * WGM, gsz = (nM - fm) < WGM ? (nM - fm) : WGM;
        u.pm = fm + ((wgid % nig) % gsz); u.pn = (wgid % nig) / gsz; if (lat == 1) u.pm += u.pm / 16 + 1; else if (lat == 2) u.pm *= 17; return true;
    }
    __device__ __forceinline__ void a_ready(const Unit&) const {}
    __device__ __forceinline__ void done(const Unit&) const {}
};
struct ChainOrder { StaticOrder so; __device__ __forceinline__ bool next(int i, Unit& u) const { Unit t; if (!so.next(i / 3, t)) return false; const int sel = i - (i / 3) * 3; u.pm = t.pm + sel * 68; u.pn = t.pn + sel * 4; return true; } __device__ __forceinline__ void a_ready(const Unit&) const {} __device__ __forceinline__ void done(const Unit&) const {} };
__device__ __forceinline__ unsigned pkbf(float lo, float hi) { typedef float f2_t __attribute__((ext_vector_type(2))); typedef __bf16 b2_t __attribute__((ext_vector_type(2))); f2_t v = {lo, hi}; b2_t b = __builtin_convertvector(v, b2_t); return __builtin_bit_cast(unsigned, b); }
__device__ __forceinline__ float bflo(unsigned w) { return __uint_as_float(w << 16); }
__device__ __forceinline__ float bfhi(unsigned w) { return __uint_as_float(w & 0xffff0000u); }
__device__ __forceinline__ float dpp_ror1(float v) { return __builtin_bit_cast(float, __builtin_amdgcn_update_dpp(0, __builtin_bit_cast(int, v), 0x121, 0xf, 0xf, false)); }
__device__ __forceinline__ float dpp_ror15(float v) { return __builtin_bit_cast(float, __builtin_amdgcn_update_dpp(0, __builtin_bit_cast(int, v), 0x12F, 0xf, 0xf, false)); }
__device__ __forceinline__ float sigm(float x) { return __builtin_amdgcn_rcpf(1.0f + __expf(-x)); }
template <int MODE, int SUB> struct Epi {
    static constexpr bool PERM = true, AFTER_DRAIN = false;
    bf16_t* O; int ldc; bf16_t* O1; const bf16_t* G; int ldg; int gcol; float* F; const float* mod; float* OUT;
    __device__ __forceinline__ void operator()(const f32x4 (&acc)[2][2][4][2], const Unit& u, int wr, int wc, int fr, int fq) const {
        const int rl0 = wr * 64 + fr;
        const int rt = u.pm * BM + rl0;
        const int ct = u.pn * BM + wc * 32 + 8 * fq;
        if constexpr (MODE == 0 || MODE == 1 || MODE == 2) {
            bf16_t* base = O; int ld = ldc; int c0 = ct;
            if constexpr (MODE == 1) { if (u.pn >= 11) { base = O1; ld = 1792; c0 = ct - 2816; } else { ld = 2816; } }
#pragma unroll
            for (int ai = 0; ai < 2; ++ai)
#pragma unroll
                for (int m = 0; m < 4; ++m) { bf16_t* rowp = base + (size_t)(rt + ai * HALF + m * 16) * ld + c0;
#pragma unroll
                    for (int bj = 0; bj < 2; ++bj) { f32x4 v0 = acc[ai][bj][m][0], v1 = acc[ai][bj][m][1];
                        if constexpr (MODE == 2) { v0 = (f32x4){sigm(v0[0]), sigm(v0[1]), sigm(v0[2]), sigm(v0[3])}; v1 = (f32x4){sigm(v1[0]), sigm(v1[1]), sigm(v1[2]), sigm(v1[3])}; }
                        u32x4 w; w.x = pkbf(v0[0], v0[1]); w.y = pkbf(v0[2], v0[3]); w.z = pkbf(v1[0], v1[1]); w.w = pkbf(v1[2], v1[3]);
                        *(u32x4*)(rowp + bj * HALF) = w; } }
        } else if constexpr (MODE == 3) {
            int step = SUB, rtr = rt, ctr = ct, gc = gcol;
            if constexpr (SUB == 4) { step = u.pm / 68; rtr = (u.pm - step * 68) * BM + rl0; ctr = (u.pn & 3) * BM + wc * 32 + 8 * fq; gc = step * 1024; }
#pragma unroll
            for (int ai = 0; ai < 2; ++ai)
#pragma unroll
                for (int m = 0; m < 4; ++m) { const size_t row = (size_t)(rtr + ai * HALF + m * 16);
#pragma unroll
                    for (int bj = 0; bj < 2; ++bj) { const int col = ctr + bj * HALF;
                        const u32x4 gw = *(const u32x4*)(G + row * ldg + gc + col);
                        f32x4 v0 = acc[ai][bj][m][0], v1 = acc[ai][bj][m][1];
                        v0 = v0 * (f32x4){bflo(gw.x), bfhi(gw.x), bflo(gw.y), bfhi(gw.y)}; v1 = v1 * (f32x4){bflo(gw.z), bfhi(gw.z), bflo(gw.w), bfhi(gw.w)};
                        bf16_t* op = O + row * ldc + col;
                        if (step != 0) { const u32x4 pw = *(const u32x4*)op;
                            v0 = v0 + (f32x4){bflo(pw.x), bfhi(pw.x), bflo(pw.y), bfhi(pw.y)}; v1 = v1 + (f32x4){bflo(pw.z), bfhi(pw.z), bflo(pw.w), bfhi(pw.w)}; }
                        u32x4 w; w.x = pkbf(v0[0], v0[1]); w.y = pkbf(v0[2], v0[3]); w.z = pkbf(v1[0], v1[1]); w.w = pkbf(v1[2], v1[3]); *(u32x4*)op = w; } }
        } else if constexpr (MODE == 5) {
            const int j0 = u.pn * 128 + wc * 32 + 8 * fq;
            float w0[8], w1[8], w2[8], bb[8];
            { const f32x4 t0 = *(const f32x4*)(mod + j0), t1 = *(const f32x4*)(mod + j0 + 4), t2 = *(const f32x4*)(mod + 2816 + j0), t3 = *(const f32x4*)(mod + 2816 + j0 + 4),
                          t4 = *(const f32x4*)(mod + 5632 + j0), t5 = *(const f32x4*)(mod + 5632 + j0 + 4), t6 = *(const f32x4*)(OUT + j0), t7 = *(const f32x4*)(OUT + j0 + 4);
#pragma unroll
              for (int k = 0; k < 4; ++k) { w0[k] = t0[k]; w0[k + 4] = t1[k]; w1[k] = t2[k]; w1[k + 4] = t3[k]; w2[k] = t4[k]; w2[k + 4] = t5[k]; bb[k] = t6[k]; bb[k + 4] = t7[k]; } }
#pragma unroll
            for (int ai = 0; ai < 2; ++ai)
#pragma unroll
                for (int m = 0; m < 4; ++m) { const size_t row = (size_t)(rt + ai * HALF + m * 16);
                    float av[8], uv[8], pv[8], nv[8];
#pragma unroll
                    for (int k = 0; k < 8; ++k) { av[k] = acc[ai][0][m][k >> 2][k & 3]; uv[k] = acc[ai][1][m][k >> 2][k & 3];
                        const float ps = dpp_ror1(av[k]), ns = dpp_ror15(av[k]);
                        const float pc = (m > 0) ? dpp_ror1(acc[ai][0][(m > 0) ? m - 1 : 0][k >> 2][k & 3]) : 0.f;
                        const float nc = (m < 3) ? dpp_ror15(acc[ai][0][(m < 3) ? m + 1 : 3][k >> 2][k & 3]) : 0.f;
                        pv[k] = (fr == 0) ? pc : ps; nv[k] = (fr == 15) ? nc : ns; }
                    const bool top = (m == 0 && fr == 0), bot = (m == 3 && fr == 15);
                    if (!top && !bot) { float o[8];
#pragma unroll
                        for (int k = 0; k < 8; ++k) { const float pre = w0[k] * pv[k] + w1[k] * av[k] + w2[k] * nv[k] + bb[k]; o[k] = pre * __builtin_amdgcn_rcpf(1.f + __expf(-pre)) * uv[k]; }
                        u32x4 w; w.x = pkbf(o[0], o[1]); w.y = pkbf(o[2], o[3]); w.z = pkbf(o[4], o[5]); w.w = pkbf(o[6], o[7]); *(u32x4*)(O + row * ldc + j0) = w; }
                    else { const size_t eo = (size_t)((row >> 6) * 2 + (bot ? 1 : 0)) * 2816 + j0; float pp[8];
#pragma unroll
                        for (int k = 0; k < 8; ++k) pp[k] = w1[k] * av[k] + bb[k] + (top ? w2[k] * nv[k] : w0[k] * pv[k]);
                        *(f32x4*)(F + eo) = (f32x4){pp[0], pp[1], pp[2], pp[3]}; *(f32x4*)(F + eo + 4) = (f32x4){pp[4], pp[5], pp[6], pp[7]};
                        u32x4 wa, wu; wa.x = pkbf(av[0], av[1]); wa.y = pkbf(av[2], av[3]); wa.z = pkbf(av[4], av[5]); wa.w = pkbf(av[6], av[7]);
                        wu.x = pkbf(uv[0], uv[1]); wu.y = pkbf(uv[2], uv[3]); wu.z = pkbf(uv[4], uv[5]); wu.w = pkbf(uv[6], uv[7]);
                        *(u32x4*)(O1 + eo) = wa; *(u32x4*)((bf16_t*)G + eo) = wu; } }
        } else {
            const int b = u.pm / 17, ti = u.pm % 17, msel = (ti == 0) ? 4 : b;
            const float* mp = mod + msel * 6144 + ct;
            f32x4 mv[2][2];
#pragma unroll
            for (int bj = 0; bj < 2; ++bj)
#pragma unroll
                for (int n = 0; n < 2; ++n) mv[bj][n] = *(const f32x4*)(mp + bj * HALF + 4 * n);
#pragma unroll
            for (int ai = 0; ai < 2; ++ai)
#pragma unroll
                for (int m = 0; m < 4; ++m) { const int rl = rl0 + ai * HALF + m * 16; const size_t row = (size_t)(u.pm * BM + rl);
#pragma unroll
                    for (int bj = 0; bj < 2; ++bj) { const int col = ct + bj * HALF; float* xp = F + row * 1024 + col;
                        f32x4 r0 = mv[bj][0] * acc[ai][bj][m][0], r1 = mv[bj][1] * acc[ai][bj][m][1];
                        if constexpr (SUB != 2) { r0 = r0 + *(const f32x4*)xp; r1 = r1 + *(const f32x4*)(xp + 4); }
                        if constexpr (SUB == 0) { *(f32x4*)xp = r0; *(f32x4*)(xp + 4) = r1; }
                        else if constexpr (SUB == 2) { const f32x4 d0 = mv[bj][0] * acc[ai][bj][m][0], d1 = mv[bj][1] * acc[ai][bj][m][1];
                            unsafeAtomicAdd(xp + 0, d0[0]); unsafeAtomicAdd(xp + 1, d0[1]); unsafeAtomicAdd(xp + 2, d0[2]); unsafeAtomicAdd(xp + 3, d0[3]); unsafeAtomicAdd(xp + 4, d1[0]); unsafeAtomicAdd(xp + 5, d1[1]); unsafeAtomicAdd(xp + 6, d1[2]); unsafeAtomicAdd(xp + 7, d1[3]); }
                        else { if (ti != 0) { float* op = OUT + ((size_t)b * 4096 + (size_t)(ti - 1) * 256 + rl) * 1024 + col; *(f32x4*)op = r0; *(f32x4*)(op + 4) = r1; } } } }
        }
    }
};
template <class Epi, class Sched, bool ALIGN_EPI = false, bool SP2 = false>
__device__ __forceinline__ void gemm_phase(PG8_LAS unsigned char* lds, const Gemm g, const Sched& S, const Epi& E) {
    int tid = threadIdx.x; asm volatile("" : "+v"(tid)); const int wid = __builtin_amdgcn_readfirstlane(tid >> 6), lane = tid & 63, wr = wid >> 2, wc = wid & 3, fr = lane & 15, fq = lane >> 4;
    const int K = g.K, nt = K / BK;
    unsigned voffA[2], voffB[2];
#pragma unroll
    for (int i = 0; i < 2; ++i) { int R, C; stage_rc(tid * 16 + i * 8192, R, C); const int Rb = Epi::PERM ? ((R & ~31) + perm32(R & 31)) : R;
        voffA[i] = (unsigned)(R * g.lda + C) * 2u; voffB[i] = (unsigned)(Rb * (g.ldb ? g.ldb : K) + C) * 2u; }
    const size_t kstep = (size_t)(BK * 2);
    const size_t hstepA = (size_t)HALF * g.lda * 2, hstepB = (size_t)HALF * (g.ldb ? g.ldb : K) * 2;
    const size_t tstepA = 2 * hstepA, tstepB = 2 * hstepB;
    const unsigned ldsw = (unsigned)wid * 1024u;
    const int aoff = lds_byte(wr * 64 + fr, fq * 8), boff = lds_byte(wc * 32 + fr, fq * 8);
#define PG8_SA(b, h) (((b) * 2 + (h)) * HTB)
#define PG8_SB(b, h) ((4 + (b) * 2 + (h)) * HTB)
#define PG8_STAGE(bufoff, gbase, voff) do { _Pragma("unroll") for (int _i = 0; _i < 2; ++_i) \
        __builtin_amdgcn_global_load_lds((const unsigned*)((const char*)(gbase) + (voff)[_i]), (PG8_LAS unsigned*)(lds + (bufoff) + ldsw + _i * 8192), 16, 0, 0); } while (0)
#define PG8_LDA(dst, b, h) do { _Pragma("unroll") for (int m = 0; m < 4; ++m) _Pragma("unroll") for (int k = 0; k < 2; ++k) dst[m][k] = *(const PG8_LAS bf16x8*)(lds + PG8_SA(b, h) + aoff + m * 2048 + k * 1024); } while (0)
#define PG8_LDB(dst, b, h) do { _Pragma("unroll") for (int n = 0; n < 2; ++n) _Pragma("unroll") for (int k = 0; k < 2; ++k) dst[n][k] = *(const PG8_LAS bf16x8*)(lds + PG8_SB(b, h) + boff + n * 2048 + k * 1024); } while (0)
#define PG8_MMA(ai, bj, At, Bt) do { __builtin_amdgcn_s_setprio(1); _Pragma("unroll") for (int m = 0; m < 4; ++m) _Pragma("unroll") for (int n = 0; n < 2; ++n) _Pragma("unroll") for (int k = 0; k < 2; ++k) \
        acc[ai][bj][m][n] = __builtin_amdgcn_mfma_f32_16x16x32_bf16(Bt[n][k], At[m][k], acc[ai][bj][m][n], 0, 0, 0); __builtin_amdgcn_s_setprio(0); } while (0)
#define PG8_WAIT_V(n) asm volatile("s_waitcnt vmcnt(" #n ")" ::: "memory")
#define PG8_WAIT_L(n) asm volatile("s_waitcnt lgkmcnt(" #n ")" ::: "memory")
#define PG8_BAR __builtin_amdgcn_s_barrier()
#define PG8_SCHED __builtin_amdgcn_sched_barrier(0)
    Unit cur, nxt; int ui = 0;
    if (!S.next(0, cur)) return;
    f32x4 acc[2][2][4][2];
#pragma unroll
    for (int a = 0; a < 2; ++a)
#pragma unroll
        for (int b = 0; b < 2; ++b)
#pragma unroll
            for (int m = 0; m < 4; ++m)
#pragma unroll
                for (int n = 0; n < 2; ++n) acc[a][b][m][n] = (f32x4){0.f, 0.f, 0.f, 0.f};
    bf16x8 At[4][2], B0[2][2], B1[2][2];
    const char* cA = (const char*)g.A + (size_t)cur.pm * tstepA; const char* cB = (const char*)g.Bt + (size_t)cur.pn * tstepB;
    S.a_ready(cur);
    if constexpr (SP2) {
        PG8_STAGE(PG8_SB(0, 0), cB, voffB); PG8_STAGE(PG8_SB(0, 1), cB + hstepB, voffB); PG8_STAGE(PG8_SA(0, 0), cA, voffA); PG8_STAGE(PG8_SA(0, 1), cA + hstepA, voffA);
        if (wr == 1) PG8_BAR;
        PG8_WAIT_V(2); PG8_BAR;
        PG8_STAGE(PG8_SB(1, 0), cB + kstep, voffB); PG8_STAGE(PG8_SA(1, 0), cA + kstep, voffA); PG8_STAGE(PG8_SB(1, 1), cB + hstepB + kstep, voffB);
        PG8_WAIT_V(6); PG8_BAR;
    } else {
        PG8_STAGE(PG8_SB(0, 0), cB, voffB); PG8_STAGE(PG8_SA(0, 0), cA, voffA); PG8_STAGE(PG8_SB(0, 1), cB + hstepB, voffB); PG8_STAGE(PG8_SA(0, 1), cA + hstepA, voffA);
        if (wr == 1) PG8_BAR;
        PG8_WAIT_V(4); PG8_BAR;
        PG8_STAGE(PG8_SB(1, 0), cB + kstep, voffB); PG8_STAGE(PG8_SA(1, 0), cA + kstep, voffA); PG8_STAGE(PG8_SB(1, 1), cB + hstepB + kstep, voffB);
        PG8_WAIT_V(6); PG8_BAR;
    }
    for (;;) {
        const bool has_next = S.next(ui + 1, nxt);
        const char* nA = has_next ? (const char*)g.A + (size_t)nxt.pm * tstepA : cA; const char* nB = has_next ? (const char*)g.Bt + (size_t)nxt.pn * tstepB : cB;
        for (int t = 0; t < nt; t += 2) {
            const bool last = (t == nt - 2);
            const char* a1 = cA + (size_t)(t + 1) * kstep;
            const char* a2 = last ? nA : cA + (size_t)(t + 2) * kstep; const char* b2 = last ? nB : cB + (size_t)(t + 2) * kstep;
            const char* a3 = a2 + kstep; const char* b3 = b2 + kstep;
            if (last && has_next) S.a_ready(nxt);
            if constexpr (SP2) {
            PG8_LDB(B0, 0, 0); PG8_LDB(B1, 0, 1); PG8_SCHED; PG8_LDA(At, 0, 0); PG8_STAGE(PG8_SA(1, 1), a1 + hstepA, voffA);
            PG8_WAIT_V(8); PG8_WAIT_L(0); PG8_BAR; PG8_MMA(0, 0, At, B0); PG8_MMA(0, 1, At, B1); PG8_BAR; PG8_SCHED;
            PG8_LDA(At, 0, 1); PG8_STAGE(PG8_SB(0, 0), b2, voffB); PG8_STAGE(PG8_SB(0, 1), b2 + hstepB, voffB); PG8_STAGE(PG8_SA(0, 0), a2, voffA);
            PG8_WAIT_V(8); PG8_WAIT_L(0); PG8_BAR; PG8_MMA(1, 0, At, B0); PG8_MMA(1, 1, At, B1); PG8_BAR; PG8_SCHED;
            PG8_LDB(B0, 1, 0); PG8_LDB(B1, 1, 1); PG8_SCHED; PG8_LDA(At, 1, 0); PG8_STAGE(PG8_SA(0, 1), a2 + hstepA, voffA);
            PG8_WAIT_V(8); PG8_WAIT_L(0); PG8_BAR; PG8_MMA(0, 0, At, B0); PG8_MMA(0, 1, At, B1); PG8_BAR; PG8_SCHED;
            PG8_LDA(At, 1, 1); PG8_STAGE(PG8_SB(1, 0), b3, voffB); PG8_STAGE(PG8_SB(1, 1), b3 + hstepB, voffB); PG8_STAGE(PG8_SA(1, 0), a3, voffA);
            PG8_WAIT_V(8); PG8_WAIT_L(0); PG8_BAR; PG8_MMA(1, 0, At, B0); PG8_MMA(1, 1, At, B1); PG8_BAR; PG8_SCHED;
            } else {
            PG8_LDB(B0, 0, 0); PG8_SCHED; PG8_LDA(At, 0, 0); PG8_STAGE(PG8_SA(1, 1), a1 + hstepA, voffA);
            PG8_WAIT_L(8); PG8_BAR; PG8_WAIT_L(0); PG8_MMA(0, 0, At, B0); PG8_BAR; PG8_SCHED;
            PG8_LDB(B1, 0, 1); PG8_STAGE(PG8_SB(0, 0), b2, voffB);
            PG8_BAR; PG8_WAIT_L(0); PG8_MMA(0, 1, At, B1); PG8_BAR;
            PG8_LDA(At, 0, 1); PG8_STAGE(PG8_SA(0, 0), a2, voffA);
            PG8_BAR; PG8_WAIT_L(0); PG8_MMA(1, 0, At, B0); PG8_BAR; PG8_SCHED;
            PG8_STAGE(PG8_SB(0, 1), b2 + hstepB, voffB);
            PG8_WAIT_V(6); PG8_BAR; PG8_MMA(1, 1, At, B1); PG8_BAR;
            PG8_LDB(B0, 1, 0); PG8_SCHED; PG8_LDA(At, 1, 0); PG8_STAGE(PG8_SA(0, 1), a2 + hstepA, voffA);
            PG8_WAIT_L(8); PG8_BAR; PG8_WAIT_L(0); PG8_MMA(0, 0, At, B0); PG8_BAR; PG8_SCHED;
            PG8_LDB(B1, 1, 1); PG8_STAGE(PG8_SB(1, 0), b3, voffB);
            PG8_BAR; PG8_WAIT_L(0); PG8_MMA(0, 1, At, B1); PG8_BAR;
            PG8_LDA(At, 1, 1); PG8_STAGE(PG8_SA(1, 0), a3, voffA);
            PG8_BAR; PG8_WAIT_L(0); PG8_MMA(1, 0, At, B0); PG8_BAR; PG8_SCHED;
            PG8_STAGE(PG8_SB(1, 1), b3 + hstepB, voffB);
            PG8_WAIT_V(6); PG8_BAR; PG8_MMA(1, 1, At, B1); PG8_BAR;
            }
        }
        if constexpr (ALIGN_EPI) { if (wr == 0) PG8_BAR; }
        if constexpr (!Epi::AFTER_DRAIN) { E(acc, cur, wr, wc, fr, fq); S.done(cur); }
        if (!has_next) break;
#pragma unroll
        for (int a = 0; a < 2; ++a)
#pragma unroll
            for (int b = 0; b < 2; ++b)
#pragma unroll
                for (int m = 0; m < 4; ++m)
#pragma unroll
                    for (int n = 0; n < 2; ++n) acc[a][b][m][n] = (f32x4){0.f, 0.f, 0.f, 0.f};
        cur = nxt; cA = nA; cB = nB; ++ui;
        if constexpr (ALIGN_EPI) { if (wr == 1) PG8_BAR; }
    }
    PG8_WAIT_V(0);
    if constexpr (!ALIGN_EPI) { if (wr == 0) PG8_BAR; }
    PG8_BAR;
    if constexpr (Epi::AFTER_DRAIN) { E.fused(acc, cur, wr, wc, fr, fq, lds, wid, lane); S.done(cur); }
#undef PG8_SA
#undef PG8_SB
#undef PG8_STAGE
#undef PG8_LDA
#undef PG8_LDB
#undef PG8_MMA
#undef PG8_WAIT_V
#undef PG8_WAIT_L
#undef PG8_BAR
#undef PG8_SCHED
}
}
#include <hip/hip_bf16.h>
#include <cmath>
namespace attn_body {
using bf16=__hip_bfloat16;
using bf16x8=__attribute__((ext_vector_type(8)))short;
using s16x4=__attribute__((ext_vector_type(4)))short;
using f32x16=__attribute__((ext_vector_type(16)))float;
using u32x4=__attribute__((ext_vector_type(4)))unsigned;
constexpr int D=64;
constexpr int NW=8,QBLK=32,QB=QBLK*NW,KVBLK=64;
constexpr int ATTN_UNIT_ROWS=QB;
__device__ __forceinline__ int crow(int r,int hi){return (r&3)+8*(r>>2)+4*hi;}
#define SBAR() __builtin_amdgcn_sched_barrier(0)
__device__ __forceinline__ void cmask(f32x16&p0,f32x16&p1,int jb,int qrel,int hi){
  const float NEG=-INFINITY; int kb=64*jb+4*hi;
  #pragma unroll
  for(int r=0;r<16;++r){int kv=kb+(r&3)+8*(r>>2); if(kv>qrel)p0[r]=NEG; if(kv+32>qrel)p1[r]=NEG;}
}

constexpr int NSLOT=3, SLOTB=8192;
constexpr int LDS_K=0, LDS_V=NSLOT*SLOTB, LDS_WS=2*NSLOT*SLOTB, LDS_OST=LDS_WS+NW*64*4, LDS_BYTES=LDS_OST+NW*4096;
constexpr float C2=0.125f*1.4426950408889634f;
__device__ __forceinline__ void glds16(const void*gsrc,unsigned lds_dst){unsigned keep;
  asm volatile("s_mov_b32 %0, m0\n\ts_mov_b32 m0, %2\n\ts_nop 0\n\tglobal_load_lds_dwordx4 %1, off\n\ts_mov_b32 m0, %0":"=&s"(keep):"v"(gsrc),"s"(lds_dst):"memory");}
__device__ __forceinline__ float max3f(float a,float b,float c){float r;asm("v_max3_f32 %0, %1, %2, %3":"=v"(r):"v"(a),"v"(b),"v"(c));return r;}
__device__ __forceinline__ float max2f(float a,float b){float r;asm("v_max_f32_e32 %0, %1, %2":"=v"(r):"v"(a),"v"(b));return r;}
__device__ __forceinline__ float fadd_s(float a,float b){float r;asm("v_add_f32_e32 %0, %1, %2":"=v"(r):"v"(a),"v"(b));return r;}
__device__ __forceinline__ float fsub_s(float a,float b){float r;asm("v_sub_f32_e32 %0, %1, %2":"=v"(r):"v"(a),"v"(b));return r;}
typedef float f32x2_t __attribute__((ext_vector_type(2))); typedef __bf16 bf16x2_t __attribute__((ext_vector_type(2)));
__device__ __forceinline__ unsigned cvtpk_s(float lo,float hi){f32x2_t v={lo,hi};bf16x2_t b=__builtin_convertvector(v,bf16x2_t);return __builtin_bit_cast(unsigned,b);}
#define WAIT_BAR(N) asm volatile("s_waitcnt vmcnt(" #N ") lgkmcnt(0)\n\ts_barrier":::"memory")

__device__ __forceinline__ void qkt(f32x16&p0,f32x16&p1,const char*Kslot,const bf16x8*qr,const f32x16&negm,int r32,int hi){
  const char*kb=Kslot+hi*1024+r32*16;
  #pragma unroll
  for(int d0=0;d0<4;++d0){
    const bf16x8 b0=*reinterpret_cast<const bf16x8*>(kb+d0*2048);
    const bf16x8 b1=*reinterpret_cast<const bf16x8*>(kb+d0*2048+512);
    if(d0==0){p0=__builtin_amdgcn_mfma_f32_32x32x16_bf16(b0,qr[0],negm,0,0,0);p1=__builtin_amdgcn_mfma_f32_32x32x16_bf16(b1,qr[0],negm,0,0,0);}
    else{p0=__builtin_amdgcn_mfma_f32_32x32x16_bf16(b0,qr[d0],p0,0,0,0);p1=__builtin_amdgcn_mfma_f32_32x32x16_bf16(b1,qr[d0],p1,0,0,0);}}
}
typedef __attribute__((address_space(3))) const char* lds_cptr;
typedef short v4i16_t __attribute__((ext_vector_type(4)));
__device__ __forceinline__ void kload8(bf16x8*kf,lds_cptr kp){
  kf[0]=*(const __attribute__((address_space(3))) bf16x8*)(kp);      kf[1]=*(const __attribute__((address_space(3))) bf16x8*)(kp+512);
  kf[2]=*(const __attribute__((address_space(3))) bf16x8*)(kp+2048); kf[3]=*(const __attribute__((address_space(3))) bf16x8*)(kp+2560);
  kf[4]=*(const __attribute__((address_space(3))) bf16x8*)(kp+4096); kf[5]=*(const __attribute__((address_space(3))) bf16x8*)(kp+4608);
  kf[6]=*(const __attribute__((address_space(3))) bf16x8*)(kp+6144); kf[7]=*(const __attribute__((address_space(3))) bf16x8*)(kp+6656);
}
__device__ __forceinline__ void kload2(bf16x8*kf,lds_cptr kp,int j){ kf[2*j]=*(const __attribute__((address_space(3))) bf16x8*)(kp+j*2048); kf[2*j+1]=*(const __attribute__((address_space(3))) bf16x8*)(kp+j*2048+512); }
__device__ __forceinline__ s16x4 vtr(lds_cptr p){ return __builtin_bit_cast(s16x4,__builtin_amdgcn_ds_read_tr16_b64_v4i16((__attribute__((address_space(3))) v4i16_t*)p)); }
__device__ __forceinline__ float rowmax(const f32x16&p0,const f32x16&p1){
  float a=max3f(p0[0],p0[1],p1[0]),b=max3f(p0[2],p0[3],p1[1]);a=max3f(a,p1[2],p1[3]);
  #pragma unroll
  for(int r=4;r<16;r+=4){a=max3f(a,p0[r],p0[r+1]);b=max3f(b,p0[r+2],p0[r+3]);a=max3f(a,p1[r],p1[r+1]);b=max3f(b,p1[r+2],p1[r+3]);}
  const float m=max2f(a,b);
  auto rr=__builtin_amdgcn_permlane32_swap(__float_as_uint(m),__float_as_uint(m),false,false);
  return max2f(__uint_as_float(rr[0]),__uint_as_float(rr[1]));
}
__device__ __forceinline__ void pv(f32x16*o,int vb,bf16x8 pa0,bf16x8 pa1,bf16x8 pa2,bf16x8 pa3){
  #pragma unroll
  for(int d0=0;d0<2;++d0){s16x4 lo[4],hi[4];
    #pragma unroll
    for(int ks=0;ks<4;++ks){
      asm volatile("ds_read_b64_tr_b16 %0,%1 offset:%c2":"=&v"(lo[ks]):"v"(vb),"i"(d0*4096+ks*1024):"memory");
      asm volatile("ds_read_b64_tr_b16 %0,%1 offset:%c2":"=&v"(hi[ks]):"v"(vb),"i"(d0*4096+ks*1024+512):"memory");}
    asm volatile("s_waitcnt lgkmcnt(0)":::"memory");SBAR();
    #define PK(k) (bf16x8){lo[k][0],lo[k][1],lo[k][2],lo[k][3],hi[k][0],hi[k][1],hi[k][2],hi[k][3]}
    o[d0]=__builtin_amdgcn_mfma_f32_32x32x16_bf16(pa0,PK(0),o[d0],0,0,0);
    o[d0]=__builtin_amdgcn_mfma_f32_32x32x16_bf16(pa1,PK(1),o[d0],0,0,0);
    o[d0]=__builtin_amdgcn_mfma_f32_32x32x16_bf16(pa2,PK(2),o[d0],0,0,0);
    o[d0]=__builtin_amdgcn_mfma_f32_32x32x16_bf16(pa3,PK(3),o[d0],0,0,0);
    #undef PK
  }
}

#ifndef ATTN_STORE16
#define ATTN_STORE16(p,v) (*(u32x4*)(p)=(v))
#endif
template<int THRL> __device__ __forceinline__ void attn_unit(const bf16*Qb,const bf16*__restrict__ Kh,const bf16*__restrict__ Vh,bf16*Ob,const int PQ,const int PK,const int PV,const int PO,const int NT,char*shm){
  int tid=threadIdx.x; asm volatile("":"+v"(tid)); const int lane=tid&63,r32=lane&31,hi=lane>>5; const int wid=__builtin_amdgcn_readfirstlane(tid>>6);
  const bf16*Qw=Qb+(long)(wid*QBLK)*PQ;
  const unsigned lds0=(unsigned)(uintptr_t)shm;
  float*wsf=(float*)(shm+LDS_WS)+wid*64;
  const bf16*ksrc=Kh+(long)lane*PK+wid*8;
  const bf16*vsrc=Vh+(long)(16*(wid&3)+(lane>>2))*PV+(wid>>2)*32+(lane&3)*8;
  const unsigned kdst=lds0+LDS_K+wid*1024, vdst=lds0+LDS_V+wid*1024;
  #define DMA_K(t,slot) glds16(ksrc+(long)(t)*KVBLK*PK,(unsigned)__builtin_amdgcn_readfirstlane(kdst+(slot)))
  #define DMA_V(t,slot) glds16(vsrc+(long)(t)*KVBLK*PV,(unsigned)__builtin_amdgcn_readfirstlane(vdst+(slot)))
  const int vb0=(int)(lds0+LDS_V)+((lane>>4)&1)*32+(lane&3)*8+(4*hi+((lane&15)>>2))*64;
  const char*Kbase=shm+LDS_K; bf16x8 kf[8];
  const lds_cptr shm3=(lds_cptr)shm; const lds_cptr kp0=shm3+LDS_K+hi*1024+r32*16; const lds_cptr vp0=shm3+LDS_V+((lane>>4)&1)*32+(lane&3)*8+(4*hi+((lane&15)>>2))*64;
  DMA_K(0,0);DMA_V(0,0);DMA_K(1,SLOTB);
  bf16x8 qr[4];
  #pragma unroll
  for(int d0=0;d0<4;++d0)qr[d0]=*reinterpret_cast<const bf16x8*>(&Qw[(long)r32*PQ+d0*16+hi*8]);
  float mhat=0.f,l_reg=0.f;f32x16 o[2];o[0]=f32x16{};o[1]=f32x16{};f32x16 negm=f32x16{};asm volatile("":"+v"(negm));
  #define CMASK(P0,P1,t) do{}while(0)
  bool resc=false;
  #define START(P0,P1) do{ const float rm=rowmax(P0,P1); resc=false; \
    { const float dl=rm; mhat=fadd_s(mhat,dl); \
      _Pragma("unroll") for(int r=0;r<16;++r){P0[r]=fsub_s(P0[r],dl);P1[r]=fsub_s(P1[r],dl);} \
      _Pragma("unroll") for(int r=0;r<16;++r)negm[r]=-mhat; asm volatile("":"+v"(negm)); } \
    _Pragma("unroll") for(int r=0;r<16;++r)P0[r]=__builtin_amdgcn_exp2f(P0[r]); }while(0)
  #define RESC() do{ if(resc){ asm volatile("s_waitcnt lgkmcnt(0)":::"memory"); \
      _Pragma("unroll") for(int d_=0;d_<2;++d_) _Pragma("unroll") for(int r=0;r<16;++r)o[d_][r]*=wsf[crow(r,hi)]; } }while(0)
  f32x16 pA0,pA1,pB0,pB1;
  int sl_prev=0,sl_cur=0,sl_next=SLOTB;
  #define ROT() do{sl_prev=sl_cur;sl_cur=sl_next;sl_next=(sl_next==(NSLOT-1)*SLOTB)?0:sl_next+SLOTB;}while(0)
  DMA_K(2,2*SLOTB);
  WAIT_BAR(3);
  qkt(pA0,pA1,Kbase,qr,negm,r32,hi);asm volatile("s_nop 15\n\ts_nop 7":"+v"(pA0),"+v"(pA1));CMASK(pA0,pA1,0);
  START(pA0,pA1);
  _Pragma("unroll") for(int r=0;r<16;++r)pA1[r]=__builtin_amdgcn_exp2f(pA1[r]);
  WAIT_BAR(0);
  DMA_K(3,0);DMA_V(1,SLOTB);
  ROT();
  kload8(kf,kp0+sl_cur);
  WAIT_BAR(2);
  s16x4 vlo[8],vhi[8]; u32x4 pw0,pw1,pw2,pw3;
  #define PKW(P,B) cvtpk_s(P[B],P[B+1])
  #define PAF(k) __builtin_bit_cast(bf16x8,pw##k)
  #define VFR(i) (bf16x8){vlo[i][0],vlo[i][1],vlo[i][2],vlo[i][3],vhi[i][0],vhi[i][1],vhi[i][2],vhi[i][3]}
  #define PIN(x) asm volatile("":"+v"(x))
  #define MX3(a,b,c) __builtin_fmaxf(__builtin_fmaxf((a),(b)),(c))
  #define GAPA(MF,A0,A1,A2,A3,W0,W1,PW) do{ MF; sacc+=A0; sacc+=A1; sacc+=A2; sacc+=A3; PIN(sacc); W0; W1; PIN(PW); SBAR(); }while(0)
  #define EX(v) __builtin_amdgcn_exp2f(v)
  #define GAPB(MF,X,B) do{ MF; X[B]=EX(X[B]); X[B+1]=EX(X[B+1]); X[B+2]=EX(X[B+2]); X[B+3]=EX(X[B+3]); PIN(X); SBAR(); }while(0)
  #define VRD(i) do{ vlo[i]=vtr(vp_+(((i)>>2)*4096+((i)&3)*1024)); vhi[i]=vtr(vp_+(((i)>>2)*4096+((i)&3)*1024+512)); }while(0)
  #define KRD(G,j) do{ if(G){ kload2(kf,kp0+sl_next,j); SBAR(); } }while(0)
  #define STEP(C0,C1,P0,P1,t,GK,GV,GL) do{ SBAR(); \
    const lds_cptr vp_=vp0+sl_prev; \
    VRD(0); SBAR(); float sacc=(P0[0]+P0[1]); \
    GAPA(C0=__builtin_amdgcn_mfma_f32_32x32x16_bf16(kf[0],qr[0],negm,0,0,0), P0[2],P0[3],P0[4],P0[5],     pw0[0]=PKW(P0,0), pw0[1]=PKW(P0,2), pw0); \
    VRD(4); SBAR(); GAPA(C1=__builtin_amdgcn_mfma_f32_32x32x16_bf16(kf[1],qr[0],negm,0,0,0), P0[6],P0[7],P0[8],P0[9],     pw0[2]=PKW(P0,4), pw0[3]=PKW(P0,6), pw0); \
    VRD(1); SBAR(); GAPA(C0=__builtin_amdgcn_mfma_f32_32x32x16_bf16(kf[2],qr[1],C0,0,0,0),   P0[10],P0[11],P0[12],P0[13], pw1[0]=PKW(P0,8), pw1[1]=PKW(P0,10), pw1); \
    VRD(5); SBAR(); GAPA(C1=__builtin_amdgcn_mfma_f32_32x32x16_bf16(kf[3],qr[1],C1,0,0,0),   P0[14],P0[15],P1[0],P1[1],   pw1[2]=PKW(P0,12),pw1[3]=PKW(P0,14), pw1); \
    VRD(2); SBAR(); GAPA(C0=__builtin_amdgcn_mfma_f32_32x32x16_bf16(kf[4],qr[2],C0,0,0,0),   P1[2],P1[3],P1[4],P1[5],     pw2[0]=PKW(P1,0), pw2[1]=PKW(P1,2), pw2); \
    VRD(6); SBAR(); GAPA(C1=__builtin_amdgcn_mfma_f32_32x32x16_bf16(kf[5],qr[2],C1,0,0,0),   P1[6],P1[7],P1[8],P1[9],     pw2[2]=PKW(P1,4), pw2[3]=PKW(P1,6), pw2); \
    VRD(3); SBAR(); GAPA(C0=__builtin_amdgcn_mfma_f32_32x32x16_bf16(kf[6],qr[3],C0,0,0,0),   P1[10],P1[11],P1[12],P1[13], pw3[0]=PKW(P1,8), pw3[1]=PKW(P1,10), pw3); \
    VRD(7); SBAR(); GAPA(C1=__builtin_amdgcn_mfma_f32_32x32x16_bf16(kf[7],qr[3],C1,0,0,0),   P1[14],P1[15],0.f,0.f,       pw3[2]=PKW(P1,12),pw3[3]=PKW(P1,14), pw3); \
    l_reg+=sacc; \
    if(GK){DMA_K((t)+3,sl_cur);} if(GV){DMA_V((t)+1,sl_next);} \
    CMASK(C0,C1,t); \
    { float a=MX3(C0[0],C0[1],C1[0]),b=MX3(C0[2],C0[3],C1[1]); a=MX3(a,C1[2],C1[3]); \
      _Pragma("unroll") for(int r=4;r<16;r+=4){a=MX3(a,C0[r],C0[r+1]);b=MX3(b,C0[r+2],C0[r+3]);a=MX3(a,C1[r],C1[r+1]);b=MX3(b,C1[r+2],C1[r+3]);} \
      float rm=__builtin_fmaxf(a,b); { auto rr=__builtin_amdgcn_permlane32_swap(__float_as_uint(rm),__float_as_uint(rm),false,false); rm=__builtin_fmaxf(__uint_as_float(rr[0]),__uint_as_float(rr[1])); } \
      resc=false; \
      if(__builtin_expect(__any(rm>(float)THRL),0)){ const float dl=__builtin_fmaxf(rm,0.f); mhat+=dl; \
        _Pragma("unroll") for(int r=0;r<16;++r){C0[r]-=dl;C1[r]-=dl;} \
        _Pragma("unroll") for(int r=0;r<16;++r)negm[r]=-mhat; asm volatile("":"+v"(negm)); \
        const float f=__builtin_amdgcn_exp2f(-dl); l_reg*=f; if(hi==0)wsf[r32]=f; resc=true; } } \
    SBAR(); \
    GAPB(o[0]=__builtin_amdgcn_mfma_f32_32x32x16_bf16(PAF(0),VFR(0),o[0],0,0,0), C0,0); \
    GAPB(o[1]=__builtin_amdgcn_mfma_f32_32x32x16_bf16(PAF(0),VFR(4),o[1],0,0,0), C0,4); \
    KRD(GL,0); GAPB(o[0]=__builtin_amdgcn_mfma_f32_32x32x16_bf16(PAF(1),VFR(1),o[0],0,0,0), C0,8); \
    KRD(GL,1); GAPB(o[1]=__builtin_amdgcn_mfma_f32_32x32x16_bf16(PAF(1),VFR(5),o[1],0,0,0), C0,12); \
    KRD(GL,2); GAPB(o[0]=__builtin_amdgcn_mfma_f32_32x32x16_bf16(PAF(2),VFR(2),o[0],0,0,0), C1,0); \
    KRD(GL,3); GAPB(o[1]=__builtin_amdgcn_mfma_f32_32x32x16_bf16(PAF(2),VFR(6),o[1],0,0,0), C1,4); \
    GAPB(o[0]=__builtin_amdgcn_mfma_f32_32x32x16_bf16(PAF(3),VFR(3),o[0],0,0,0), C1,8); \
    GAPB(o[1]=__builtin_amdgcn_mfma_f32_32x32x16_bf16(PAF(3),VFR(7),o[1],0,0,0), C1,12); \
    }while(0)
  int t=1;
  #undef CMASK
  #define CMASK(P0,P1,t) do{}while(0)
  for(;t+5<NT;t+=2){
    STEP(pB0,pB1,pA0,pA1,t,true,true,true);     WAIT_BAR(2); RESC(); ROT();
    STEP(pA0,pA1,pB0,pB1,t+1,true,true,true);   WAIT_BAR(2); RESC(); ROT();
  }
  #undef CMASK
  #define CMASK(P0,P1,t) do{}while(0)
  #define ENDW(tt) do{ if((tt)+3<NT){WAIT_BAR(2);} else if((tt)+2<NT){WAIT_BAR(1);} else {WAIT_BAR(0);} }while(0)
  for(;t+1<NT;t+=2){
    STEP(pB0,pB1,pA0,pA1,t,(t+3<NT),(t+1<NT),(t+1<NT));       ENDW(t);   RESC(); ROT();
    STEP(pA0,pA1,pB0,pB1,t+1,(t+4<NT),(t+2<NT),(t+2<NT));     ENDW(t+1); RESC(); ROT();
  }
  STEP(pB0,pB1,pA0,pA1,NT-1,false,false,false); RESC();
  { float sacc=pB0[0]+pB0[1]; _Pragma("unroll") for(int r=2;r<16;++r)sacc+=pB0[r]; _Pragma("unroll") for(int r=0;r<16;++r)sacc+=pB1[r]; l_reg+=sacc;
    pw0=(u32x4){PKW(pB0,0),PKW(pB0,2),PKW(pB0,4),PKW(pB0,6)};pw1=(u32x4){PKW(pB0,8),PKW(pB0,10),PKW(pB0,12),PKW(pB0,14)};pw2=(u32x4){PKW(pB1,0),PKW(pB1,2),PKW(pB1,4),PKW(pB1,6)};pw3=(u32x4){PKW(pB1,8),PKW(pB1,10),PKW(pB1,12),PKW(pB1,14)};
    SBAR(); pv(o,vb0+sl_cur,PAF(0),PAF(1),PAF(2),PAF(3)); }
  #undef PKW
  #undef PAF
  #undef VFR
  #undef PIN
  #undef MX3
  #undef GAPA
  #undef GAPB
  #undef EX
  #undef VRD
  #undef KRD
  #undef STEP
  #undef ENDW
  {auto rr=__builtin_amdgcn_permlane32_swap(__float_as_uint(l_reg),__float_as_uint(l_reg),false,false);l_reg=__uint_as_float(rr[0])+__uint_as_float(rr[1]);}
  if(hi==0)wsf[32+r32]=l_reg;asm volatile("s_waitcnt lgkmcnt(0)":::"memory");
  float rli[16];
  #pragma unroll
  for(int r=0;r<16;++r)rli[r]=__builtin_amdgcn_rcpf(wsf[32+crow(r,hi)]);
  bf16*Ow=Ob+(long)(wid*QBLK)*PO;
  { bf16*stg=(bf16*)(shm+LDS_OST)+wid*2048;
    #pragma unroll
    for(int r=0;r<16;++r){const int orow=crow(r,hi);
      #pragma unroll
      for(int d0=0;d0<2;++d0)stg[orow*64+d0*32+r32]=__float2bfloat16(o[d0][r]*rli[r]);}
    asm volatile("s_waitcnt lgkmcnt(0)":::"memory");
    #pragma unroll
    for(int i=0;i<4;++i){const int row=i*8+(lane>>3),ch=lane&7; const u32x4 v=*(const u32x4*)(stg+row*64+ch*8); ATTN_STORE16(Ow+(long)row*PO+ch*8,v);} }
  asm volatile("s_waitcnt lgkmcnt(0)\n\ts_barrier":::"memory");
  #undef DMA_K
  #undef DMA_V
  #undef CMASK
  #undef START
  #undef RESC
  #undef ROT
}
constexpr int ATTN_LDS_BYTES=LDS_BYTES;
#undef SBAR
#undef WAIT_BAR
}
#define GAS __attribute__((address_space(1)))
#define LAS __attribute__((address_space(3)))
typedef unsigned short bf16;
typedef unsigned v4u __attribute__((ext_vector_type(4)));
typedef float f32x4 __attribute__((ext_vector_type(4)));
typedef short bf16x8 __attribute__((ext_vector_type(8)));
typedef GAS unsigned gu32;
typedef GAS unsigned long long gu64;
#define RLX_AGENT __ATOMIC_RELAXED, __HIP_MEMORY_SCOPE_AGENT
#define LDS_WAIT() asm volatile("s_waitcnt lgkmcnt(0)" ::: "memory")
#define VM_WAIT() asm volatile("s_waitcnt vmcnt(0)" ::: "memory")
__device__ __forceinline__ unsigned long long rt() { return __builtin_amdgcn_s_memrealtime(); }
__device__ __forceinline__ unsigned f2bf(float f) { unsigned u = __builtin_bit_cast(unsigned, f); return (u + 0x7fffu + ((u >> 16) & 1u)) >> 16; }
__device__ __forceinline__ unsigned pk2(float lo, float hi) { return f2bf(lo) | (f2bf(hi) << 16); }

#define XB_TMO      128
#define XB_XCNT(j)  (256  + 64 * (j))
#define XB_XSUB(j)  (1280 + 64 * (j))
#define XB_XGEN(j)  (2304 + 64 * (j))
#define XB_TOP      3328
#define XB_TOPGEN   3392
#define XCD_BAR_WORDS 3456
#define XB_SPIN_CAP (1u << 22)

__device__ __forceinline__ unsigned xb_ld(unsigned* p)              { return __hip_atomic_load(p, __ATOMIC_RELAXED, __HIP_MEMORY_SCOPE_AGENT); }
__device__ __forceinline__ unsigned xb_add(unsigned* p, unsigned v) { return __hip_atomic_fetch_add(p, v, __ATOMIC_RELAXED, __HIP_MEMORY_SCOPE_AGENT); }
__device__ __forceinline__ unsigned xb_xcc_id() { return (unsigned)__builtin_amdgcn_s_getreg((3 << 11) | 20) & 0xFu; }
#define XB_SPIN(cond, bar) do { unsigned _sp = 0; while (cond) { __builtin_amdgcn_s_sleep(1); \
    if ((++_sp & 255u) == 0u) { if (xb_ld(&(bar)[XB_TMO])) break; if (_sp > XB_SPIN_CAP) { atomicAdd(&(bar)[XB_TMO], 1u); break; } } } } while (0)

struct XcdBarrier {
    unsigned* bar; unsigned x;
    volatile LAS unsigned* st;
};

__device__ __forceinline__ XcdBarrier xcd_barrier_post(unsigned* bar, volatile LAS unsigned* st) {
    XcdBarrier b; b.bar = bar; b.x = xb_xcc_id(); b.st = st;
    if (threadIdx.x == 0) (void)xb_add(&bar[XB_XCNT(b.x)], 1u);
    return b;
}
__device__ __forceinline__ void xcd_barrier_complete(unsigned* bar, unsigned x, unsigned& nloc, unsigned& nx) {
    const unsigned G = gridDim.x * gridDim.y * gridDim.z;
    unsigned sum, cnt, mine, sp = 0u;
    for (;;) {
        sum = 0u; cnt = 0u; mine = 0u;
#pragma unroll
        for (unsigned j = 0; j < 16; ++j) { const unsigned c = xb_ld(&bar[XB_XCNT(j)]); sum += c; cnt += (c > 0u) ? 1u : 0u; mine = (j == x) ? c : mine; }
        if (sum == G) break;
        __builtin_amdgcn_s_sleep(1);
        if ((++sp & 255u) == 0u) { if (xb_ld(&bar[XB_TMO])) break; if (sp > XB_SPIN_CAP) { atomicAdd(&bar[XB_TMO], 1u); break; } }
    }
    nloc = mine > 0u ? mine : 1u; nx = cnt > 0u ? cnt : 1u;
}

__device__ __forceinline__ void xcd_barrier(const XcdBarrier& b) {
    asm volatile("s_waitcnt vmcnt(0)" ::: "memory");
    __syncthreads();
    if (threadIdx.x == 0) {
        unsigned* bar = b.bar;
        __builtin_amdgcn_s_waitcnt(0);
        unsigned nloc = b.st[0], nx = b.st[1];
        if (nloc == 0u) { xcd_barrier_complete(bar, b.x, nloc, nx); b.st[0] = nloc; b.st[1] = nx; }
        const unsigned old = xb_add(&bar[XB_XSUB(b.x)], 1u);
        const unsigned gen = old / nloc;
        if (old + 1u == (gen + 1u) * nloc) {
            __builtin_amdgcn_fence(__ATOMIC_RELEASE, "agent");
            asm volatile("s_waitcnt vmcnt(0)" ::: "memory");
            const unsigned og = xb_add(&bar[XB_TOP], 1u);
            const unsigned tg = og / nx;
            if (og + 1u == (tg + 1u) * nx) xb_add(&bar[XB_TOPGEN], 1u);
            else XB_SPIN(xb_ld(&bar[XB_TOPGEN]) == tg, bar);
            __builtin_amdgcn_fence(__ATOMIC_ACQUIRE, "agent");
            xb_add(&bar[XB_XGEN(b.x)], 1u);
            asm volatile("s_waitcnt vmcnt(0)" ::: "memory");
        } else {
            XB_SPIN(xb_ld(&bar[XB_XGEN(b.x)]) == gen, bar);
            __builtin_amdgcn_fence(__ATOMIC_ACQUIRE, "agent");
            asm volatile("s_waitcnt vmcnt(0)" ::: "memory");
        }
    }
    __syncthreads();
}

constexpr int NWAVES = 8, NTHR = 512;
constexpr int DMODEL = 1024, TPB = 4352  , MROWS = 17408, NLAYER = 4;
constexpr int PATT_LD = 2816, PDN_LD = 1792, DFF = 2816, AU_LD = 5632;
constexpr int C_DAQ = 0, C_DAK = 512, C_DAV = 1024, C_GQQ = 1536, C_GQK = 2048, C_GQV = 2176, C_Z = 2304;
constexpr int C_DNQ = 0, C_BRAW = 1536, C_ARAW = 1544;
constexpr float NEPS = 1e-6f;
constexpr float QSCALE = 0.125f * 1.4426950408889634f;
constexpr size_t WS_CTL = 0, CTL_ZERO_BYTES = 1u << 20;
constexpr size_t WS_MOD = 1u << 20;
constexpr size_t WS_GL = (1u << 20) + (1u << 19);
constexpr size_t WS_WT = 2u << 20;
constexpr size_t WT_IN = 0, WT_BRA = 7864320, WT_BRB = WT_BRA + 524288, WT_BRC = WT_BRB + 524288, WT_O = WT_BRC + 524288, WT_1 = WT_O + 1048576, WT_2 = WT_1 + 5767168;
constexpr size_t WS_XS = 41943040;
constexpr size_t WS_HN = WS_XS + 71303168;
constexpr size_t WS_OC = WS_HN + 35651584;
constexpr size_t WS_PATT = WS_OC + 17825792;
constexpr size_t WS_A = WS_PATT + 98041856;
constexpr size_t WS_END = WS_A + 196083712;
constexpr size_t OPS_BYTES = 73728;
constexpr size_t A_ODA = 160432128;
constexpr size_t A_MRGF = 106954752;
constexpr size_t DO_OA = 35651584;
constexpr int CW_BAR = 4096, CW_Q = 1024;
constexpr int LDS_BYTES = 147456, MISC_OFF = LDS_BYTES - 256;

struct Args { const float* in[27]; float* out; unsigned char* ws; };
typedef const __attribute__((address_space(4))) Args* CArgsP;
#define ARGS_HERE(nm) CArgsP nm = (CArgsP)__builtin_amdgcn_kernarg_segment_ptr(); asm volatile("" : "+s"(nm))

__device__ __forceinline__ float dpp_ror(float v, const int n) { return n == 8 ? __builtin_bit_cast(float, __builtin_amdgcn_update_dpp(0, __builtin_bit_cast(int, v), 0x128, 0xf, 0xf, false))
                                                                        : n == 4 ? __builtin_bit_cast(float, __builtin_amdgcn_update_dpp(0, __builtin_bit_cast(int, v), 0x124, 0xf, 0xf, false))
                                                                        : n == 2 ? __builtin_bit_cast(float, __builtin_amdgcn_update_dpp(0, __builtin_bit_cast(int, v), 0x122, 0xf, 0xf, false))
                                                                                 : __builtin_bit_cast(float, __builtin_amdgcn_update_dpp(0, __builtin_bit_cast(int, v), 0x121, 0xf, 0xf, false)); }
__device__ __forceinline__ float row16_sum(float v) { v += dpp_ror(v, 8); v += dpp_ror(v, 4); v += dpp_ror(v, 2); v += dpp_ror(v, 1); return v; }
__device__ __forceinline__ float sum8(float v) {
    v += __builtin_bit_cast(float, __builtin_amdgcn_update_dpp(0, __builtin_bit_cast(int, v), 0xB1, 0xf, 0xf, false));
    v += __builtin_bit_cast(float, __builtin_amdgcn_update_dpp(0, __builtin_bit_cast(int, v), 0x4E, 0xf, 0xf, false));
    v += __builtin_bit_cast(float, __builtin_amdgcn_update_dpp(0, __builtin_bit_cast(int, v), 0x141, 0xf, 0xf, false));
    return v;
}
__device__ __forceinline__ float wave_sum(float v) {
    v = row16_sum(v);
    return __builtin_bit_cast(float, __builtin_amdgcn_readlane(__builtin_bit_cast(int, v), 0)) + __builtin_bit_cast(float, __builtin_amdgcn_readlane(__builtin_bit_cast(int, v), 16))
         + __builtin_bit_cast(float, __builtin_amdgcn_readlane(__builtin_bit_cast(int, v), 32)) + __builtin_bit_cast(float, __builtin_amdgcn_readlane(__builtin_bit_cast(int, v), 48));
}
__device__ __forceinline__ float silu_f(float v) { return v * __builtin_amdgcn_rcpf(1.f + __expf(-v)); }
__device__ __forceinline__ float bf_lo(unsigned w) { return __uint_as_float(w << 16); }
__device__ __forceinline__ float bf_hi(unsigned w) { return __uint_as_float(w & 0xffff0000u); }
__device__ __forceinline__ float bf_1(bf16 u) { return __uint_as_float((unsigned)u << 16); }

__device__ __forceinline__ void phase_mod(CArgsP a, LAS unsigned char* lds, int tid, int bid, int G) {
    LAS float* sc = (LAS float*)lds; LAS float* red = sc + 5 * 1024;
    const float* c = a->in[1]; const float* cctx = a->in[3]; float* MOD = (float*)(a->ws + WS_MOD);
    for (int i = tid; i < 5 * 1024; i += NTHR) { const float v = (i < 4096) ? c[i] : cctx[i - 4096]; sc[i] = silu_f(v); }
    __syncthreads();
    const int wave = tid >> 6, lane = tid & 63;
    for (int task = bid; task < 4 * 96; task += G) {
        const int l = task / 96, n = (task % 96) * 64 + lane;
        const float* W = a->in[4] + (size_t)l * 1024 * 6144 + n;
        float acc[5] = {0.f, 0.f, 0.f, 0.f, 0.f};
        for (int k0 = wave * 128; k0 < wave * 128 + 128; k0 += 16) { float w[16];
#pragma unroll
            for (int kk = 0; kk < 16; ++kk) w[kk] = W[(size_t)(k0 + kk) * 6144];
#pragma unroll
            for (int kk = 0; kk < 16; ++kk)
#pragma unroll
                for (int r = 0; r < 5; ++r) acc[r] += sc[r * 1024 + k0 + kk] * w[kk]; }
#pragma unroll
        for (int r = 0; r < 5; ++r) red[(wave * 5 + r) * 64 + lane] = acc[r];
        __syncthreads();
        if (tid < 320) { const int r = tid >> 6; float s = 0.f;
#pragma unroll
            for (int w = 0; w < 8; ++w) s += red[(w * 5 + r) * 64 + lane];
            MOD[(size_t)(l * 5 + r) * 6144 + n] = s + a->in[5][l * 6144 + n]; }
        __syncthreads();
    }
}

__device__ __forceinline__ int map_in(int nd) {
    if (nd < 2304) return nd;
    if (nd < 2816) return 3856 + (nd - 2304);
    if (nd < 2816 + 1536) return 2304 + (nd - 2816);
    if (nd < 2816 + 1552) return 3840 + (nd - 2816 - 1536);
    if (nd < 4608) return -1;
    return 4368 + (nd - 4608);
}
template <int MAP> __device__ __forceinline__ void tr_item(const float* W, int K, int N, bf16* WT, LAS float* scr, int item, int lane, int nblk) {
    const int kb = item / nblk, nb = item % nblk, k0 = 64 * kb, n0 = 32 * nb;
    const int nd = n0 + (lane & 31); const int ns = MAP == 1 ? map_in(nd) : MAP == 2 ? (((nd & 255) < 128) ? (nd >> 8) * 128 + (nd & 255) : 2816 + (nd >> 8) * 128 + (nd & 255) - 128) : nd;
    float tv[32];
#pragma unroll
    for (int i = 0; i < 32; ++i) { const int kk = 2 * i + (lane >> 5); tv[i] = (ns >= 0) ? W[(size_t)(k0 + kk) * N + ns] : 0.f; }
#pragma unroll
    for (int i = 0; i < 32; ++i) { const int kk = 2 * i + (lane >> 5); scr[kk * 33 + (lane & 31)] = tv[i]; }
    LDS_WAIT(); asm volatile("" ::: "memory");
    const int c = lane & 7;
#pragma unroll
    for (int j = 0; j < 4; ++j) { const int n = (lane >> 3) + 8 * j; const LAS float* s = scr + (8 * c) * 33 + n;
        v4u o; o.x = pk2(s[0 * 33], s[1 * 33]); o.y = pk2(s[2 * 33], s[3 * 33]); o.z = pk2(s[4 * 33], s[5 * 33]); o.w = pk2(s[6 * 33], s[7 * 33]);
        *(GAS v4u*)(WT + (size_t)(n0 + n) * K + k0 + 8 * c) = o; }
    LDS_WAIT(); asm volatile("" ::: "memory");
}
__device__ __forceinline__ void phase_convert(CArgsP a, int l, LAS unsigned char* lds, int gw, int NGW, int wave, int lane, int it_lo = 0, int it_hi = 9344) {
    LAS float* scr = (LAS float*)(lds + wave * 16384);
    bf16* WT = (bf16*)(a->ws + WS_WT);
    for (int it = it_lo + gw; it < it_hi; it += NGW) {
        int r = it;
        if (r < 3840) { tr_item<1>(a->in[7] + (size_t)l * 1024 * 7440, 1024, 7440, WT + WT_IN, scr, r, lane, 240); continue; } r -= 3840;
        if (r < 256) { tr_item<0>(a->in[18] + (size_t)l * 512 * 1024, 512, 1024, WT + WT_BRA, scr, r, lane, 32); continue; } r -= 256;
        if (r < 256) { tr_item<0>(a->in[19] + (size_t)l * 512 * 1024, 512, 1024, WT + WT_BRB, scr, r, lane, 32); continue; } r -= 256;
        if (r < 256) { tr_item<0>(a->in[20] + (size_t)l * 512 * 1024, 512, 1024, WT + WT_BRC, scr, r, lane, 32); continue; } r -= 256;
        if (r < 512) { tr_item<0>(a->in[21] + (size_t)l * 1024 * 1024, 1024, 1024, WT + WT_O, scr, r, lane, 32); continue; } r -= 512;
        if (r < 2816) { tr_item<2>(a->in[23] + (size_t)l * 1024 * 5632, 1024, 5632, WT + WT_1, scr, r, lane, 176); continue; } r -= 2816;
        tr_item<0>(a->in[26] + (size_t)l * 2816 * 1024, 2816, 1024, WT + WT_2, scr, r, lane, 32);
    }
}

__device__ __forceinline__ const float* norm_src(CArgsP a, bool first, int row) {
    const int b = row / TPB, p = row % TPB;
    return first ? (p < 256 ? a->in[2] + ((size_t)b * 256 + p) * 1024 : a->in[0] + ((size_t)b * 4096 + (p - 256)) * 1024) : (const float*)(a->ws + WS_XS) + (size_t)row * 1024;
}
__device__ __forceinline__ void norm_finish(CArgsP a, const float* gain, const float* modl, int shoff, int scoff, bool first, int row, int lane, const f32x4 (&v)[4]) {
    float ss = 0.f;
#pragma unroll
    for (int j = 0; j < 4; ++j) ss += (v[j].x * v[j].x + v[j].y * v[j].y) + (v[j].z * v[j].z + v[j].w * v[j].w);
    const float rstd = __builtin_amdgcn_rsqf(wave_sum(ss) * (1.f / 1024.f) + NEPS);
    const int b = row / TPB, p = row % TPB;
    const float* mrow = modl + (size_t)(p < 256 ? 4 : b) * 6144;
    float* XS = (float*)(a->ws + WS_XS); bf16* HN = (bf16*)(a->ws + WS_HN);
#pragma unroll
    for (int j = 0; j < 4; ++j) { const int col = 4 * lane + 256 * j;
        const f32x4 g4 = *(const f32x4*)(gain + col), sh = *(const f32x4*)(mrow + shoff + col), sc = *(const f32x4*)(mrow + scoff + col);
        const f32x4 h = (v[j] * rstd * g4) * (sc + 1.0f) + sh;
        *(unsigned long long*)(HN + (size_t)row * 1024 + col) = (unsigned long long)pg8::pkbf(h.x, h.y) | ((unsigned long long)pg8::pkbf(h.z, h.w) << 32);
        if (first) *(f32x4*)(XS + (size_t)row * 1024 + col) = v[j]; }
}
__device__ __forceinline__ int norm_row(int i, int mode) { return mode == 0 ? i : mode == 1 ? i + ((i >> 12) + 1) * 256 : (i >> 8) * TPB + (i & 255); }
__device__ __forceinline__ void phase_norm(CArgsP a, int l, int which, int gw, int NGW, int lane, int mode = 0) {
    const float* gain = a->in[which ? 22 : 6] + l * 1024;
    const float* modl = (const float*)(a->ws + WS_MOD) + (size_t)l * 5 * 6144;
    const int shoff = which ? 3 * 1024 : 0, scoff = which ? 4 * 1024 : 1024;
    const bool first = (which == 0 && l == 0);
    const int nrows = mode == 0 ? MROWS : mode == 1 ? 16384 : 1024;
    for (int i = gw; i < nrows; i += 2 * NGW) {
        const int i2 = i + NGW; const bool has2 = i2 < nrows;
        const int row = norm_row(i, mode), row2 = norm_row(has2 ? i2 : i, mode);
        const float* s1 = norm_src(a, first, row); const float* s2 = norm_src(a, first, row2);
        f32x4 v1[4], v2[4];
#pragma unroll
        for (int j = 0; j < 4; ++j) { v1[j] = *(const f32x4*)(s1 + 4 * lane + 256 * j); v2[j] = *(const f32x4*)(s2 + 4 * lane + 256 * j); }
        norm_finish(a, gain, modl, shoff, scoff, first, row, lane, v1);
        if (has2) norm_finish(a, gain, modl, shoff, scoff, first, row2, lane, v2);
    }
}

__device__ __forceinline__ void qk_row(CArgsP a, int l, int row, int lane) {
    bf16* prow = (bf16*)(a->ws + WS_PATT) + (size_t)row * PATT_LD;
    const int p = row % TPB; const bool lat = p >= 256; const int t = p - 256;
    const int hv = lane >> 3, t8 = lane & 7, half = t8 >> 2, tt = t8 & 3, e1 = half * 32 + 4 * tt, e2 = e1 + 16;
    float cs[4], sn[4];
    if (lat) { const float pos = (float)(half == 0 ? (t >> 6) : (t & 63));
#pragma unroll
        for (int i = 0; i < 4; ++i) { const float f = (float)(4 * tt + i); const float invf = __builtin_amdgcn_exp2f(-f * (13.287712379549449f / 16.f)); __sincosf(pos * invf, &sn[i], &cs[i]); } }
    else {
#pragma unroll
        for (int i = 0; i < 4; ++i) { cs[i] = 1.f; sn[i] = 0.f; } }
#pragma unroll
    for (int seg = 0; seg < 4; ++seg) {
        const int colbase = seg == 0 ? C_DAQ : seg == 1 ? C_DAK : seg == 2 ? C_GQQ : C_GQK;
        const float* gain = a->in[seg == 0 ? 8 : seg == 1 ? 9 : seg == 2 ? 12 : 13] + l * 64;
        const bool isq = (seg == 0 || seg == 2); const bool active = (seg == 3) ? (hv < 2) : true;
        bf16* p1 = prow + colbase + hv * 64 + e1; bf16* p2 = prow + colbase + hv * 64 + e2;
        unsigned long long r1 = 0ull, r2 = 0ull; if (active) { r1 = *(const unsigned long long*)p1; r2 = *(const unsigned long long*)p2; }
        const float x1[4] = {bf_lo((unsigned)r1), bf_hi((unsigned)r1), bf_lo((unsigned)(r1 >> 32)), bf_hi((unsigned)(r1 >> 32))};
        const float x2[4] = {bf_lo((unsigned)r2), bf_hi((unsigned)r2), bf_lo((unsigned)(r2 >> 32)), bf_hi((unsigned)(r2 >> 32))};
        float ss = 0.f;
#pragma unroll
        for (int i = 0; i < 4; ++i) ss += x1[i] * x1[i] + x2[i] * x2[i];
        ss = sum8(ss);
        const float rstd = __builtin_amdgcn_rsqf(ss * (1.f / 64.f) + NEPS) * (isq ? QSCALE : 1.f);
        float o1[4], o2[4];
#pragma unroll
        for (int i = 0; i < 4; ++i) { const float y1 = x1[i] * rstd * gain[e1 + i], y2 = x2[i] * rstd * gain[e2 + i]; o1[i] = y1 * cs[i] - y2 * sn[i]; o2[i] = y1 * sn[i] + y2 * cs[i]; }
        if (active) { *(unsigned long long*)p1 = (unsigned long long)pg8::pkbf(o1[0], o1[1]) | ((unsigned long long)pg8::pkbf(o1[2], o1[3]) << 32);
                      *(unsigned long long*)p2 = (unsigned long long)pg8::pkbf(o2[0], o2[1]) | ((unsigned long long)pg8::pkbf(o2[2], o2[3]) << 32); }
    }
}

typedef float f32x16 __attribute__((ext_vector_type(16)));
#define MFMA32(a_, b_, c_) __builtin_amdgcn_mfma_f32_32x32x16_bf16((a_), (b_), (c_), 0, 0, 0)
__device__ __forceinline__ bf16x8 pack8(const f32x16& x, int s) {
    v4u p; p.x = pg8::pkbf(x[8 * s + 0], x[8 * s + 1]); p.y = pg8::pkbf(x[8 * s + 2], x[8 * s + 3]); p.z = pg8::pkbf(x[8 * s + 4], x[8 * s + 5]); p.w = pg8::pkbf(x[8 * s + 6], x[8 * s + 7]);
    return __builtin_bit_cast(bf16x8, p);
}
__device__ __forceinline__ void split8(const f32x4 a, const f32x4 b, bf16x8& hi, bf16x8& lo) {
    const float x[8] = {a.x, a.y, a.z, a.w, b.x, b.y, b.z, b.w}; v4u h, l;
    { const unsigned p = pg8::pkbf(x[0], x[1]); h.x = p; l.x = pg8::pkbf(x[0] - bf_lo(p), x[1] - bf_hi(p)); }
    { const unsigned p = pg8::pkbf(x[2], x[3]); h.y = p; l.y = pg8::pkbf(x[2] - bf_lo(p), x[3] - bf_hi(p)); }
    { const unsigned p = pg8::pkbf(x[4], x[5]); h.z = p; l.z = pg8::pkbf(x[4] - bf_lo(p), x[5] - bf_hi(p)); }
    { const unsigned p = pg8::pkbf(x[6], x[7]); h.w = p; l.w = pg8::pkbf(x[6] - bf_lo(p), x[7] - bf_hi(p)); }
    hi = __builtin_bit_cast(bf16x8, h); lo = __builtin_bit_cast(bf16x8, l);
}
constexpr int PS = 132;
constexpr int L_QS = 0, L_KS = 33792, L_VS = 67584, L_NR = 84992, L_KK = 101376, L_QK = 117760, L_SC = 134144;
constexpr int VSS = 136;
__device__ __forceinline__ void dn_task_decode(int task, int& b, int& seg, int& h, int& n, int& NC) {
    b = task / 272; int r = task % 272;
    if (r < 16) { seg = 0; h = r >> 2; n = r & 3; NC = 4; } else { r -= 16; seg = 1; h = r >> 6; n = r & 63; NC = 64; }
}
#ifndef PREP_PROF
#define PREP_PROF 0
#define PREP_SUBA 0
#define PREP_SUBB 0
#endif
#define PREP_MARK(k) do { if (PREP_PROF && blockIdx.x == 0 && tid == 0) { const unsigned t_ = (unsigned)rt(); volatile LAS unsigned* M_ = (volatile LAS unsigned*)(lds + MISC_OFF); M_[16 + (k)] += t_ - prep_t; prep_t = t_; } } while (0)
__device__ __forceinline__ void dn_prep_task(CArgsP a, int l, int task, LAS unsigned char* lds, int tid) {
    asm volatile("" : "+v"(tid));
    unsigned prep_t = (PREP_PROF && blockIdx.x == 0 && tid == 0) ? (unsigned)rt() : 0u;
    int b, seg, h, n, NC; dn_task_decode(task, b, seg, h, n, NC);
    const int seglo = b * TPB + (seg ? 256 : 0), seghi = seglo + NC * 64, rowbase = seglo + 64 * n;
    const bf16* PDN = (const bf16*)a->out;
    LAS float* QS = (LAS float*)(lds + L_QS); LAS float* KS = (LAS float*)(lds + L_KS); LAS bf16* VSb = (LAS bf16*)(lds + L_VS);
    LAS float* KK = (LAS float*)(lds + L_KK); LAS float* QK = (LAS float*)(lds + L_QK);
    LAS float* sBeta = (LAS float*)(lds + L_SC); LAS float* sGc = sBeta + 128; LAS float* sEg = sGc + 128; LAS float* sBe = sEg + 128;
    const int wave = __builtin_amdgcn_readfirstlane(tid >> 6), lane = tid & 63;
    if (tid < 384) { const int cgp = tid % 48, rg = tid / 48, c8 = cgp * 8, which = c8 >> 7, c = c8 & 127, col = which * 512 + h * 128 + c, r0 = rg * 8;
        const float* cw = a->in[14] + (size_t)l * 3 * 1536 + col;
        const f32x4 w0a = *(const f32x4*)cw, w0b = *(const f32x4*)(cw + 4), w1a = *(const f32x4*)(cw + 1536), w1b = *(const f32x4*)(cw + 1540), w2a = *(const f32x4*)(cw + 3072), w2b = *(const f32x4*)(cw + 3076);
        v4u rw[10];
#pragma unroll
        for (int i = 0; i < 10; ++i) { const int row = rowbase + r0 - 1 + i; rw[i] = (v4u){0u, 0u, 0u, 0u}; if (row >= seglo && row < seghi) rw[i] = *(const v4u*)(PDN + (size_t)row * PDN_LD + col); }
        LAS float* dst = (which == 0 ? QS : KS) + c;
#pragma unroll
        for (int i = 0; i < 8; ++i) { const v4u m = rw[i], z = rw[i + 1], n2 = rw[i + 2];
            f32x4 ya = w0a * (f32x4){bf_lo(m.x), bf_hi(m.x), bf_lo(m.y), bf_hi(m.y)} + w1a * (f32x4){bf_lo(z.x), bf_hi(z.x), bf_lo(z.y), bf_hi(z.y)} + w2a * (f32x4){bf_lo(n2.x), bf_hi(n2.x), bf_lo(n2.y), bf_hi(n2.y)};
            f32x4 yb = w0b * (f32x4){bf_lo(m.z), bf_hi(m.z), bf_lo(m.w), bf_hi(m.w)} + w1b * (f32x4){bf_lo(z.z), bf_hi(z.z), bf_lo(z.w), bf_hi(z.w)} + w2b * (f32x4){bf_lo(n2.z), bf_hi(n2.z), bf_lo(n2.w), bf_hi(n2.w)};
            ya = (f32x4){silu_f(ya.x), silu_f(ya.y), silu_f(ya.z), silu_f(ya.w)}; yb = (f32x4){silu_f(yb.x), silu_f(yb.y), silu_f(yb.z), silu_f(yb.w)};
            if (which == 2) { v4u pv; pv.x = pg8::pkbf(ya.x, ya.y); pv.y = pg8::pkbf(ya.z, ya.w); pv.z = pg8::pkbf(yb.x, yb.y); pv.w = pg8::pkbf(yb.z, yb.w); *(LAS v4u*)(VSb + (r0 + i) * VSS + c) = pv; }
            else { *(LAS f32x4*)(dst + (r0 + i) * PS) = ya; *(LAS f32x4*)(dst + (r0 + i) * PS + 4) = yb; } } }
    __syncthreads();
    PREP_MARK(0);
    { const int r = tid >> 3, part = tid & 7;
      LAS float* qp = QS + r * PS + 16 * part; LAS float* kp = KS + r * PS + 16 * part;
      f32x4 qv[4], kv[4]; float sq = 0.f, sk = 0.f;
#pragma unroll
      for (int q = 0; q < 4; ++q) { qv[q] = *(const LAS f32x4*)(qp + 4 * q); kv[q] = *(const LAS f32x4*)(kp + 4 * q);
          sq += (qv[q].x * qv[q].x + qv[q].y * qv[q].y) + (qv[q].z * qv[q].z + qv[q].w * qv[q].w); sk += (kv[q].x * kv[q].x + kv[q].y * kv[q].y) + (kv[q].z * kv[q].z + kv[q].w * kv[q].w); }
      sq = sum8(sq); sk = sum8(sk);
      const float rq = __builtin_amdgcn_rsqf(sq + NEPS), rk = __builtin_amdgcn_rsqf(sk + NEPS);
#pragma unroll
      for (int q = 0; q < 4; ++q) { *(LAS f32x4*)(qp + 4 * q) = qv[q] * rq; *(LAS f32x4*)(kp + 4 * q) = kv[q] * rk; } }
    if (wave < 2) { const int dir = wave; const int cn = dir ? 63 - lane : lane; const size_t ro = (size_t)(rowbase + cn) * PDN_LD;
        const float braw = bf_1(PDN[ro + C_BRAW + dir * 4 + h]), araw = bf_1(PDN[ro + C_ARAW + dir * 4 + h]);
        const float beta = 1.f / (1.f + expf(-braw));
        const float xs = araw + a->in[16][l * 8 + dir * 4 + h];
        const float ee = __expf(-fabsf(xs)); const float l1p = (ee < 0.03f) ? ee * (1.f - ee * (0.5f - ee * (0.33333334f - 0.25f * ee))) : __logf(1.f + ee); const float sp = fmaxf(xs, 0.f) + l1p;
        float g = -expf(a->in[15][l * 8 + dir * 4 + h]) * sp;
#pragma unroll
        for (int off = 1; off < 64; off <<= 1) { const float v = __shfl_up(g, off); if (lane >= off) g += v; }
        const float eg = expf(g);
        sBeta[dir * 64 + lane] = beta; sGc[dir * 64 + lane] = g; sEg[dir * 64 + lane] = eg; sBe[dir * 64 + lane] = beta * eg;
        if (lane == 63) ((float*)(a->ws + WS_GL))[task * 2 + dir] = eg; }
    __syncthreads();
    PREP_MARK(1);
    { const int mat = wave >> 2, bi = (wave >> 1) & 1, bj = wave & 1, r = lane & 31, hh = lane >> 5;
      const LAS float* pa = (mat ? QS : KS) + (32 * bi + r) * PS + 8 * hh; const LAS float* pb = KS + (32 * bj + r) * PS + 8 * hh;
      f32x16 acc;
#pragma unroll
      for (int q = 0; q < 16; ++q) acc[q] = 0.f;
#pragma unroll
      for (int ks = 0; ks < 8; ++ks) {
          const f32x4 a0 = *(const LAS f32x4*)(pa + 16 * ks), a1 = *(const LAS f32x4*)(pa + 16 * ks + 4), b0 = *(const LAS f32x4*)(pb + 16 * ks), b1 = *(const LAS f32x4*)(pb + 16 * ks + 4);
          bf16x8 ah, al, bh, bl; split8(a0, a1, ah, al); split8(b0, b1, bh, bl);
          acc = MFMA32(ah, bh, acc); acc = MFMA32(ah, bl, acc); acc = MFMA32(al, bh, acc); }
      LAS float* dstm = mat ? QK : KK;
#pragma unroll
      for (int q = 0; q < 16; ++q) dstm[(32 * bi + (q & 3) + 8 * (q >> 2) + 4 * hh) * 64 + 32 * bj + r] = acc[q]; }
    __syncthreads();
    PREP_MARK(2);
    unsigned char* ops0 = a->ws + WS_A + (size_t)task * 2 * OPS_BYTES;
    const float qs = 0.08838834764831845f;
    LAS float* A1m = (LAS float*)(lds + L_NR);
    for (int idx = tid; idx < 4096; idx += NTHR) { const int ip = idx >> 6, jp = idx & 63;
        A1m[idx] = (ip > jp) ? sBeta[64 + ip] * KK[(63 - ip) * 64 + (63 - jp)] * __expf(sGc[64 + ip] - sGc[64 + jp]) : 0.f; }
    __syncthreads();
    for (int idx = tid; idx < 4096; idx += NTHR) { const int ip = idx >> 6, jp = idx & 63;
        KK[idx] = (ip > jp) ? sBeta[ip] * KK[idx] * __expf(sGc[ip] - sGc[jp]) : 0.f; }
    __syncthreads();
    PREP_MARK(3);
    if (wave < 2) { unsigned adoff = wave ? (unsigned)L_NR : (unsigned)L_KK; asm volatile("" : "+v"(adoff)); LAS float* Ad = (LAS float*)(lds + adoff); float X[64];
#pragma unroll
      for (int i = 0; i < 64; ++i) X[i] = (i == lane) ? 1.f : 0.f;
      f32x4 cur[16], nxt[16];
#pragma unroll
      for (int q = 0; q < 16; ++q) { cur[q] = (f32x4){0.f, 0.f, 0.f, 0.f}; nxt[q] = (f32x4){0.f, 0.f, 0.f, 0.f}; }
      cur[0] = *(const LAS f32x4*)(Ad + 64);
#pragma unroll
      for (int i = 1; i < 64; ++i) {
          if (i + 1 < 64) {
#pragma unroll
              for (int q = 0; q < 16; ++q) if (4 * q < i + 1) nxt[q] = *(const LAS f32x4*)(Ad + (i + 1) * 64 + 4 * q); }
          __builtin_amdgcn_sched_barrier(0);
          float s0 = 0.f, s1 = 0.f;
#pragma unroll
          for (int jj = 0; jj < i; ++jj) { const float av = cur[jj >> 2][jj & 3]; if (jj & 1) s1 += av * X[jj]; else s0 += av * X[jj]; }
          X[i] -= (s0 + s1);
          __builtin_amdgcn_sched_barrier(0);
#pragma unroll
          for (int q = 0; q < 16; ++q) cur[q] = nxt[q]; }
#pragma unroll
      for (int i = 0; i < 64; ++i) Ad[i * 64 + lane] = X[i]; }
    else {
    for (int f = tid - 128; f < 2048; f += NTHR - 128) {
        const int dir = f >> 10, ff = f & 1023, mb = ff >> 9, ks = (ff >> 6) & 7, ln = ff & 63, g = ln >> 5, r = ln & 31;
        const int cp = mb * 32 + r, cn = dir ? 63 - cp : cp; const float sc = sEg[dir * 64 + cp] * qs;
        const int db = 32 * (ks >> 1) + 16 * (ks & 1) + 4 * g;
        const f32x4 v0 = *(const LAS f32x4*)(QS + cn * PS + db), v1 = *(const LAS f32x4*)(QS + cn * PS + db + 8);
        v4u o; o.x = pg8::pkbf(v0.x * sc, v0.y * sc); o.y = pg8::pkbf(v0.z * sc, v0.w * sc); o.z = pg8::pkbf(v1.x * sc, v1.y * sc); o.w = pg8::pkbf(v1.z * sc, v1.w * sc);
        *(v4u*)(ops0 + (size_t)dir * OPS_BYTES + 32768 + ff * 16) = o; }
    for (int f = tid - 128; f < 2048; f += NTHR - 128) {
        const int dir = f >> 10, ff = f & 1023, mb = ff >> 8, ks = (ff >> 6) & 3, ln = ff & 63, g = ln >> 5, r = ln & 31;
        const int d = mb * 32 + r; const float gl = sGc[dir * 64 + 63]; float v[8];
#pragma unroll
        for (int j = 0; j < 8; ++j) { const int cp = 16 * ks + 8 * (j >> 2) + 4 * g + (j & 3), cn = dir ? 63 - cp : cp; v[j] = KS[cn * PS + d] * __expf(gl - sGc[dir * 64 + cp]); }
        v4u o; o.x = pg8::pkbf(v[0], v[1]); o.y = pg8::pkbf(v[2], v[3]); o.z = pg8::pkbf(v[4], v[5]); o.w = pg8::pkbf(v[6], v[7]);
        *(v4u*)(ops0 + (size_t)dir * OPS_BYTES + 16384 + ff * 16) = o; }
    for (int f = tid - 128; f < 1024; f += NTHR - 128) {
        const int dir = f >> 9, ff = f & 511, mb = ff >> 8, ks = (ff >> 6) & 3, ln = ff & 63, g = ln >> 5, r = ln & 31;
        const int cp = mb * 32 + r, cn = dir ? 63 - cp : cp; const float gc = sGc[dir * 64 + cp]; float v[8];
#pragma unroll
        for (int j = 0; j < 8; ++j) { const int sp = 16 * ks + 8 * (j >> 2) + 4 * g + (j & 3), sn = dir ? 63 - sp : sp;
            v[j] = (cp >= sp) ? QK[cn * 64 + sn] * qs * __expf(gc - sGc[dir * 64 + sp]) : 0.f; }
        v4u o; o.x = pg8::pkbf(v[0], v[1]); o.y = pg8::pkbf(v[2], v[3]); o.z = pg8::pkbf(v[4], v[5]); o.w = pg8::pkbf(v[6], v[7]);
        *(v4u*)(ops0 + (size_t)dir * OPS_BYTES + 49152 + ff * 16) = o; }
    }
    __syncthreads();
    PREP_MARK(4);
    PREP_MARK(5);
    { const int dir = wave >> 2, wq = wave & 3, r = lane & 31, hh = lane >> 5;
      unsigned tdoff = dir ? (unsigned)L_NR : (unsigned)L_KK; asm volatile("" : "+v"(tdoff)); const LAS float* Td = (const LAS float*)(lds + tdoff); const LAS float* bet = sBeta + dir * 64; const LAS float* bee = sBe + dir * 64;
      unsigned char* opsd = ops0 + (size_t)dir * OPS_BYTES;
      f32x16 zero16;
#pragma unroll
      for (int q = 0; q < 16; ++q) zero16[q] = 0.f;
      bf16x8 bu[4], aw[4];
#pragma unroll
      for (int ks = 0; ks < 4; ++ks) { float t[8], w8[8];
#pragma unroll
        for (int q = 0; q < 8; ++q) { const int jp = 16 * ks + 8 * hh + q, jn = dir ? 63 - jp : jp; t[q] = bf_1(VSb[jn * VSS + 32 * wq + r]) * bet[jp]; w8[q] = KS[jn * PS + 32 * wq + r] * bee[jp]; }
        v4u pu; pu.x = pg8::pkbf(t[0], t[1]); pu.y = pg8::pkbf(t[2], t[3]); pu.z = pg8::pkbf(t[4], t[5]); pu.w = pg8::pkbf(t[6], t[7]); bu[ks] = __builtin_bit_cast(bf16x8, pu);
        v4u pw; pw.x = pg8::pkbf(w8[0], w8[1]); pw.y = pg8::pkbf(w8[2], w8[3]); pw.z = pg8::pkbf(w8[4], w8[5]); pw.w = pg8::pkbf(w8[6], w8[7]); aw[ks] = __builtin_bit_cast(bf16x8, pw); }
#pragma unroll
      for (int mb = 0; mb < 2; ++mb) {
        bf16x8 tf[4];
#pragma unroll
        for (int ks = 0; ks < 4; ++ks) { const f32x4 t0 = *(const LAS f32x4*)(Td + (32 * mb + r) * 64 + 16 * ks + 8 * hh), t1 = *(const LAS f32x4*)(Td + (32 * mb + r) * 64 + 16 * ks + 8 * hh + 4);
            v4u pt; pt.x = pg8::pkbf(t0.x, t0.y); pt.y = pg8::pkbf(t0.z, t0.w); pt.z = pg8::pkbf(t1.x, t1.y); pt.w = pg8::pkbf(t1.z, t1.w); tf[ks] = __builtin_bit_cast(bf16x8, pt); }
        f32x16 cu = zero16, cw = zero16;
#pragma unroll
        for (int ks = 0; ks < 4; ++ks) { cu = MFMA32(tf[ks], bu[ks], cu); cw = MFMA32(aw[ks], tf[ks], cw); }
        { v4u o0, o1; o0.x = pg8::pkbf(cu[0], cu[1]); o0.y = pg8::pkbf(cu[2], cu[3]); o0.z = pg8::pkbf(cu[4], cu[5]); o0.w = pg8::pkbf(cu[6], cu[7]);
          o1.x = pg8::pkbf(cu[8], cu[9]); o1.y = pg8::pkbf(cu[10], cu[11]); o1.z = pg8::pkbf(cu[12], cu[13]); o1.w = pg8::pkbf(cu[14], cu[15]);
          unsigned char* dst = opsd + 57344 + ((wq * 2 + mb) * 64 + lane) * 32; *(v4u*)dst = o0; *(v4u*)(dst + 16) = o1; }
        { v4u n0, n1; n0.x = pg8::pkbf(-cw[0], -cw[1]); n0.y = pg8::pkbf(-cw[2], -cw[3]); n0.z = pg8::pkbf(-cw[4], -cw[5]); n0.w = pg8::pkbf(-cw[6], -cw[7]);
          n1.x = pg8::pkbf(-cw[8], -cw[9]); n1.y = pg8::pkbf(-cw[10], -cw[11]); n1.z = pg8::pkbf(-cw[12], -cw[13]); n1.w = pg8::pkbf(-cw[14], -cw[15]);
          *(v4u*)(opsd + ((mb * 8 + 2 * wq) * 64 + lane) * 16) = n0; *(v4u*)(opsd + ((mb * 8 + 2 * wq + 1) * 64 + lane) * 16) = n1; }
      } }
    __syncthreads();
    PREP_MARK(6);
}

__device__ __forceinline__ const unsigned char* scan_ops(CArgsP a, int b, int h, int dir, int st, int& task, int& rowb) {
    const int seg = st >= 4, step = seg ? st - 4 : st, NC = seg ? 64 : 4, n = dir ? NC - 1 - step : step;
    task = b * 272 + (seg ? 16 + h * 64 + n : h * 4 + n); rowb = b * TPB + (seg ? 256 : 0) + 64 * n;
    return a->ws + WS_A + ((size_t)task * 2 + dir) * OPS_BYTES;
}
__device__ __forceinline__ void dn_scan_chain(CArgsP a, int chain, LAS unsigned char* lds, int tid) {
    const int wave = __builtin_amdgcn_readfirstlane(tid >> 6), lane = tid & 63;
    const int b = chain >> 3, h = (chain >> 1) & 3, dir = chain & 1;
    const int g = lane >> 5, e = lane & 31, sl = wave & 3;
    bf16* OFB = (bf16*)a->out + (size_t)dir * MROWS * 512;
    const float* GL = (const float*)(a->ws + WS_GL);
    f32x16 S[4];
#pragma unroll
    for (int i = 0; i < 4; ++i)
#pragma unroll
        for (int r = 0; r < 16; ++r) S[i][r] = 0.f;
    v4u R[7], U[4]; float gl; int task, rowb;
    { const unsigned char* ops = scan_ops(a, b, h, dir, 0, task, rowb);
#pragma unroll
      for (int i = 0; i < 7; ++i) R[i] = *(const v4u*)(ops + 16 * (tid + 512 * i));
#pragma unroll
      for (int mb = 0; mb < 2; ++mb) { const v4u* up = (const v4u*)(ops + 57344 + ((sl * 2 + mb) * 64 + lane) * 32); U[2 * mb] = up[0]; U[2 * mb + 1] = up[1]; }
      gl = GL[task * 2 + dir];
#pragma unroll
      for (int i = 0; i < 7; ++i) *(LAS v4u*)(lds + 16 * (tid + 512 * i)) = R[i]; }
    __syncthreads();
    for (int st = 0; st < 68; ++st) {
        const LAS unsigned char* buf = lds + (st & 1) * 57344;
        const int rowc = rowb; const float glc = gl; v4u Uc[4];
#pragma unroll
        for (int i = 0; i < 4; ++i) Uc[i] = U[i];
        if (st + 1 < 68) { const unsigned char* ops = scan_ops(a, b, h, dir, st + 1, task, rowb);
#pragma unroll
            for (int i = 0; i < 7; ++i) R[i] = *(const v4u*)(ops + 16 * (tid + 512 * i));
#pragma unroll
            for (int mb = 0; mb < 2; ++mb) { const v4u* up = (const v4u*)(ops + 57344 + ((sl * 2 + mb) * 64 + lane) * 32); U[2 * mb] = up[0]; U[2 * mb + 1] = up[1]; }
            gl = GL[task * 2 + dir]; }
        if (wave < 4) {
            const LAS bf16x8* NW = (const LAS bf16x8*)buf + lane; const LAS bf16x8* KT = (const LAS bf16x8*)(buf + 16384) + lane;
            const LAS bf16x8* QD = (const LAS bf16x8*)(buf + 32768) + lane; const LAS bf16x8* QKp = (const LAS bf16x8*)(buf + 49152) + lane;
            bf16x8 Sb[8];
#pragma unroll
            for (int ks = 0; ks < 8; ++ks) Sb[ks] = pack8(S[ks >> 1], ks & 1);
            f32x16 vn[2];
#pragma unroll
            for (int mb = 0; mb < 2; ++mb) {
                const v4u u0 = Uc[2 * mb], u1 = Uc[2 * mb + 1];
                f32x16 c;
                c[0] = bf_lo(u0.x); c[1] = bf_hi(u0.x); c[2] = bf_lo(u0.y); c[3] = bf_hi(u0.y); c[4] = bf_lo(u0.z); c[5] = bf_hi(u0.z); c[6] = bf_lo(u0.w); c[7] = bf_hi(u0.w);
                c[8] = bf_lo(u1.x); c[9] = bf_hi(u1.x); c[10] = bf_lo(u1.y); c[11] = bf_hi(u1.y); c[12] = bf_lo(u1.z); c[13] = bf_hi(u1.z); c[14] = bf_lo(u1.w); c[15] = bf_hi(u1.w);
#pragma unroll
                for (int ks = 0; ks < 8; ++ks) c = MFMA32(NW[(mb * 8 + ks) * 64], Sb[ks], c);
                vn[mb] = c; }
            bf16x8 Vb[4];
#pragma unroll
            for (int ks = 0; ks < 4; ++ks) Vb[ks] = pack8(vn[ks >> 1], ks & 1);
#pragma unroll
            for (int mb = 0; mb < 2; ++mb) {
                f32x16 o;
#pragma unroll
                for (int r = 0; r < 16; ++r) o[r] = 0.f;
#pragma unroll
                for (int ks = 0; ks < 8; ++ks) o = MFMA32(QD[(mb * 8 + ks) * 64], Sb[ks], o);
#pragma unroll
                for (int ks = 0; ks < 4; ++ks) o = MFMA32(QKp[(mb * 4 + ks) * 64], Vb[ks], o);
#pragma unroll
                for (int r = 0; r < 16; ++r) { const int cp = mb * 32 + (r & 3) + 8 * (r >> 2) + 4 * g; const int cn = dir ? 63 - cp : cp;
                    OFB[(size_t)(rowc + cn) * 512 + h * 128 + sl * 32 + e] = (bf16)(pg8::pkbf(o[r], 0.f) & 0xffffu); } }
#pragma unroll
            for (int mb = 0; mb < 4; ++mb) { f32x16 c = S[mb] * glc;
#pragma unroll
                for (int ks = 0; ks < 4; ++ks) c = MFMA32(KT[(mb * 4 + ks) * 64], Vb[ks], c);
                S[mb] = c; }
        }
        if (st + 1 < 68) { LAS unsigned char* nb = lds + ((st + 1) & 1) * 57344;
#pragma unroll
            for (int i = 0; i < 7; ++i) *(LAS v4u*)(nb + 16 * (tid + 512 * i)) = R[i]; }
        __syncthreads();
    }
}

__device__ __forceinline__ void unpack8(const v4u w, float (&f)[8]) { f[0] = bf_lo(w.x); f[1] = bf_hi(w.x); f[2] = bf_lo(w.y); f[3] = bf_hi(w.y); f[4] = bf_lo(w.z); f[5] = bf_hi(w.z); f[6] = bf_lo(w.w); f[7] = bf_hi(w.w); }
__device__ __forceinline__ float sum16(float v) { return row16_sum(v); }
__device__ __forceinline__ void post2_row(CArgsP a, int l, int row, int lane, float lam, float one_m_li) {
    const int h = lane >> 4, pt = lane & 15, e0 = 8 * pt;
    const bf16* od = (const bf16*)(a->ws + WS_A + A_ODA) + (size_t)row * 1024;
    bf16* oabc = (bf16*)(a->ws + WS_A + A_MRGF); bf16* oa = oabc + (size_t)row * 512;
    const bf16* of = (const bf16*)a->out + (size_t)row * 512; const bf16* ob = of + (size_t)MROWS * 512;
    bf16* oc = oabc + ((size_t)2 * MROWS + row) * 512;
    { const bf16* og = (const bf16*)(a->ws + WS_PATT) + (size_t)row * PATT_LD + C_GQQ; *(v4u*)(oabc + ((size_t)MROWS + row) * 512 + 8 * lane) = *(const v4u*)(og + 8 * lane); }
    const bf16* zr = (const bf16*)(a->ws + WS_PATT) + (size_t)row * PATT_LD + C_Z;
    float o1[8], o2[8], ff[8], fb[8], zz[8];
    unpack8(*(const v4u*)(od + (h * 2) * 128 + e0), o1); unpack8(*(const v4u*)(od + (h * 2 + 1) * 128 + e0), o2);
    unpack8(*(const v4u*)(of + h * 128 + e0), ff); unpack8(*(const v4u*)(ob + h * 128 + e0), fb); unpack8(*(const v4u*)(zr + h * 128 + e0), zz);
    const float* sg = a->in[11] + l * 128 + e0; const float* ng = a->in[17] + l * 128 + e0;
    float d[8], c[8], s1 = 0.f, s2 = 0.f;
#pragma unroll
    for (int i = 0; i < 8; ++i) { d[i] = o1[i] - lam * o2[i]; c[i] = ff[i] + fb[i]; s1 += d[i] * d[i]; s2 += c[i] * c[i]; }
    s1 = sum16(s1); s2 = sum16(s2);
    const float r1 = __builtin_amdgcn_rsqf(s1 * (1.f / 128.f) + NEPS) * one_m_li, r2 = __builtin_amdgcn_rsqf(s2 * (1.f / 128.f) + NEPS);
    float ra[8], rc[8];
#pragma unroll
    for (int i = 0; i < 8; ++i) { ra[i] = d[i] * r1 * sg[i]; rc[i] = c[i] * r2 * ng[i] * silu_f(zz[i]); }
    v4u wa, wc; wa.x = pg8::pkbf(ra[0], ra[1]); wa.y = pg8::pkbf(ra[2], ra[3]); wa.z = pg8::pkbf(ra[4], ra[5]); wa.w = pg8::pkbf(ra[6], ra[7]);
    wc.x = pg8::pkbf(rc[0], rc[1]); wc.y = pg8::pkbf(rc[2], rc[3]); wc.z = pg8::pkbf(rc[4], rc[5]); wc.w = pg8::pkbf(rc[6], rc[7]);
    *(v4u*)(oa + h * 128 + e0) = wa; *(v4u*)(oc + h * 128 + e0) = wc;
}

__device__ __forceinline__ void phase_act(CArgsP a, int l, int gtid, int nthr) {
    bf16* AU = (bf16*)(a->ws + WS_A);
    const float* cw = a->in[24] + (size_t)l * 3 * DFF; const float* cb = a->in[25] + (size_t)l * DFF;
    for (int it = gtid; it < 2176 * 352; it += nthr) {
        const int cgp = it % 352, strip = it / 352, r0 = strip * 8, p0 = r0 % TPB, col = cgp * 8;
        const bool topv = (p0 != 0 && p0 != 256), botv = (p0 + 7 != 255 && p0 + 7 != TPB - 1);
        const bf16* ap = AU + (size_t)r0 * AU_LD + col;
        v4u ar[10], ur[8];
        ar[0] = (v4u){0u, 0u, 0u, 0u}; if (topv) ar[0] = *(const v4u*)(ap - AU_LD);
#pragma unroll
        for (int i = 0; i < 8; ++i) { ar[i + 1] = *(const v4u*)(ap + (size_t)i * AU_LD); ur[i] = *(const v4u*)(ap + (size_t)i * AU_LD + DFF); }
        ar[9] = (v4u){0u, 0u, 0u, 0u}; if (botv) ar[9] = *(const v4u*)(ap + (size_t)8 * AU_LD);
        float w0[8], w1[8], w2[8], bb[8];
#pragma unroll
        for (int i = 0; i < 8; ++i) { w0[i] = cw[col + i]; w1[i] = cw[DFF + col + i]; w2[i] = cw[2 * DFF + col + i]; bb[i] = cb[col + i]; }
#pragma unroll
        for (int i = 0; i < 8; ++i) { float pm[8], pc[8], pn[8], pu[8], o[8];
            unpack8(ar[i], pm); unpack8(ar[i + 1], pc); unpack8(ar[i + 2], pn); unpack8(ur[i], pu);
#pragma unroll
            for (int k = 0; k < 8; ++k) o[k] = silu_f(w0[k] * pm[k] + w1[k] * pc[k] + w2[k] * pn[k] + bb[k]) * pu[k];
            v4u w; w.x = pg8::pkbf(o[0], o[1]); w.y = pg8::pkbf(o[2], o[3]); w.z = pg8::pkbf(o[4], o[5]); w.w = pg8::pkbf(o[6], o[7]);
            *(v4u*)(AU + (size_t)(r0 + i) * AU_LD + DFF + col) = w; }
    }
}

constexpr size_t WS_EP = WS_END, WS_EA = WS_END + 6127616, WS_EU = WS_EA + 3063808, WS_END2 = WS_EU + 3063808;
__device__ __forceinline__ void phase_act_fix(CArgsP a, int l, int gtid, int nthr) {
    bf16* ACT = (bf16*)(a->ws + WS_A); const float* EP = (const float*)(a->ws + WS_EP); const bf16* EA = (const bf16*)(a->ws + WS_EA); const bf16* EU = (const bf16*)(a->ws + WS_EU);
    const float* cw = a->in[24] + (size_t)l * 3 * DFF;
    for (int it = gtid; it < 544 * 352; it += nthr) {
        const int cgp = it % 352, e = it / 352, col = cgp * 8, bot = e & 1, row = (e >> 1) * 64 + (bot ? 63 : 0), p = row % TPB;
        const bool nbv = bot ? (p != 255 && p != TPB - 1) : (p != 0 && p != 256);
        float nb[8] = {0.f, 0.f, 0.f, 0.f, 0.f, 0.f, 0.f, 0.f}, uu[8];
        if (nbv) unpack8(*(const v4u*)(EA + (size_t)(bot ? e + 1 : e - 1) * DFF + col), nb);
        unpack8(*(const v4u*)(EU + (size_t)e * DFF + col), uu);
        const f32x4 p0 = *(const f32x4*)(EP + (size_t)e * DFF + col), p1 = *(const f32x4*)(EP + (size_t)e * DFF + col + 4);
        const float* wm = cw + (bot ? 2 * DFF : 0) + col;
        const float pp[8] = {p0.x, p0.y, p0.z, p0.w, p1.x, p1.y, p1.z, p1.w}; float o[8];
#pragma unroll
        for (int k = 0; k < 8; ++k) o[k] = silu_f(pp[k] + wm[k] * nb[k]) * uu[k];
        v4u w; w.x = pg8::pkbf(o[0], o[1]); w.y = pg8::pkbf(o[2], o[3]); w.z = pg8::pkbf(o[4], o[5]); w.w = pg8::pkbf(o[6], o[7]);
        *(v4u*)(ACT + (size_t)row * DFF + col) = w; }
}

typedef pg8::Epi<1, 0> EpiIn; typedef pg8::Epi<2, 0> EpiGate; typedef pg8::Epi<0, 0> EpiSt;
__global__ void __launch_bounds__(NTHR, 2) mk_fwd(Args args_unused) {
    extern __shared__ __attribute__((aligned(16))) unsigned char lds_raw[];
    LAS unsigned char* lds = (LAS unsigned char*)lds_raw;
    volatile LAS unsigned* MISC = (volatile LAS unsigned*)(lds + MISC_OFF);
    const int tid = threadIdx.x, lane = tid & 63, wave = __builtin_amdgcn_readfirstlane(tid >> 6);
    const int G = gridDim.x, bid = blockIdx.x;
    const int gw = bid * NWAVES + wave, NGW = G * NWAVES;
    for (int u = tid; u < 64; u += NTHR) MISC[u] = 0u;
    __syncthreads();
    { ARGS_HERE(A); (void)xcd_barrier_post((unsigned*)(A->ws + WS_CTL) + CW_BAR, MISC); }
#ifndef DUP_MASK
#define DUP_MASK 0
#endif
#ifndef PROF_A
#define PROF_A 0
#endif
#ifndef PROF_B
#define PROF_B 0
#endif
    unsigned long long prof_a = 0ull, prof_b = 0ull, prof_last = 0ull; int prof_ph = 0;
#define GRID_BAR() do { ARGS_HERE(B_); XcdBarrier bar; bar.bar = (unsigned*)(B_->ws + WS_CTL) + CW_BAR; bar.x = xb_xcc_id(); bar.st = MISC; xcd_barrier(bar); \
    if (PROF_A | PROF_B) { const unsigned long long t_ = rt(); if ((PROF_A >> prof_ph) & 1) prof_a += t_ - prof_last; if ((PROF_B >> prof_ph) & 1) prof_b += t_ - prof_last; prof_last = t_; ++prof_ph; } } while (0)
#define PHASE_IDS() int ptid = threadIdx.x; asm volatile("" : "+v"(ptid)); const int plane = ptid & 63; const int pwave = __builtin_amdgcn_readfirstlane(ptid >> 6); const int pgw = bid * NWAVES + pwave; (void)plane; (void)pgw

    const unsigned long long prof_t0 = (PROF_A | PROF_B) ? rt() : 0ull;
    { ARGS_HERE(A); phase_mod(A, lds, tid, bid, G); phase_convert(A, 0, lds, gw, NGW, wave, lane); }
    { ARGS_HERE(A); if (A->out == nullptr) cg::this_grid().sync(); }
    GRID_BAR();
    if ((PROF_A >> 15) & 1) prof_a += rt() - prof_t0;

    for (int l = 0; l < NLAYER; ++l) {
        if (PROF_A | PROF_B) { prof_ph = 0; prof_last = rt(); }
        { ARGS_HERE(A); PHASE_IDS();
          if (l == 0) phase_norm(A, 0, 0, pgw, NGW, plane, 0);
          else { phase_convert(A, l, lds, pgw, NGW, pwave, plane, 7936, 9344); phase_norm(A, l, 0, pgw, NGW, plane, 2); } }
        GRID_BAR();
        { ARGS_HERE(A); PHASE_IDS(); unsigned char* ws = A->ws;
          pg8::Gemm g{(bf16*)(ws + WS_HN), (bf16*)(ws + WS_WT) + WT_IN, MROWS, 4608, 1024, 1024}; pg8::StaticOrder S; S.init(MROWS, 4608, G, bid);
          EpiIn E{(bf16*)(ws + WS_PATT), PATT_LD, (bf16*)A->out, nullptr, 0, 0, nullptr, nullptr, nullptr};
          pg8::gemm_phase<EpiIn, pg8::StaticOrder, true, true>(lds, g, S, E);
          if (DUP_MASK & 2) pg8::gemm_phase<EpiIn, pg8::StaticOrder, true, true>(lds, g, S, E); }
        GRID_BAR();
        { ARGS_HERE(A); PHASE_IDS();
          for (;;) {
            if (ptid == 0) MISC[8] = __hip_atomic_fetch_add((unsigned*)(A->ws + WS_CTL) + CW_Q + 64 * l + 32, 1u, __ATOMIC_RELAXED, __HIP_MEMORY_SCOPE_AGENT);
            __syncthreads();
            const int q = __builtin_amdgcn_readfirstlane((int)MISC[8]);
            __syncthreads();
            if (q >= 1088 + 272) break;
            if (q < 1088) { dn_prep_task(A, l, q, lds, ptid); continue; }
            const int r0 = (q - 1088) * 64 + pwave * 8;
            for (int r = 0; r < 8; ++r) qk_row(A, l, r0 + r, plane);
          } }
        GRID_BAR();
        for (int pass = ((DUP_MASK & 8) ? 0 : 1); pass < 2; ++pass)
        { const int nunits = 32 + 1536 + (l < NLAYER - 1 ? 96 : 0);
          for (;;) {
            ARGS_HERE(A); PHASE_IDS(); unsigned char* ws = A->ws;
            if (ptid == 0) MISC[8] = __hip_atomic_fetch_add((unsigned*)(ws + WS_CTL) + CW_Q + 64 * l + 16 * pass, 1u, __ATOMIC_RELAXED, __HIP_MEMORY_SCOPE_AGENT);
            __syncthreads();
            const int q = __builtin_amdgcn_readfirstlane((int)MISC[8]);
            __syncthreads();
            if (q >= nunits) break;
            if (q < 32) { dn_scan_chain(A, q, lds, ptid); if (DUP_MASK & 128) { __syncthreads(); dn_scan_chain(A, q, lds, ptid); } asm volatile("s_waitcnt vmcnt(0)" ::: "memory"); __syncthreads(); continue; }
            bf16* PATT = (bf16*)(ws + WS_PATT); bf16* ODA = (bf16*)(ws + WS_A + A_ODA);
            int u = q - 32, combo, qt, NT;
            if (u < 1536) { combo = u >> 4; qt = 1 + (u & 15); NT = 68; } else { combo = u - 1536; qt = 0; NT = 4; }
            const attn_body::bf16 *Qp, *Kp, *Vp; attn_body::bf16* Op; int PO;
            if (combo < 64) { const int b = combo >> 4, vh = combo & 15, hh = vh >> 1, vhalf = vh & 1, h = vh >> 2;
                const size_t r0 = (size_t)b * TPB; const size_t rq = r0 + (size_t)qt * 256;
                Qp = (const attn_body::bf16*)(PATT + rq * PATT_LD + C_DAQ + hh * 64); Kp = (const attn_body::bf16*)(PATT + r0 * PATT_LD + C_DAK + hh * 64);
                Vp = (const attn_body::bf16*)(PATT + r0 * PATT_LD + C_DAV + h * 128 + vhalf * 64); Op = (attn_body::bf16*)(ODA + rq * 1024 + hh * 128 + vhalf * 64); PO = 1024; }
            else { const int cc = combo - 64, b = cc >> 3, hq = cc & 7, kvh = hq >> 2;
                const size_t r0 = (size_t)b * TPB; const size_t rq = r0 + (size_t)qt * 256;
                Qp = (const attn_body::bf16*)(PATT + rq * PATT_LD + C_GQQ + hq * 64); Kp = (const attn_body::bf16*)(PATT + r0 * PATT_LD + C_GQK + kvh * 64);
                Vp = (const attn_body::bf16*)(PATT + r0 * PATT_LD + C_GQV + kvh * 64); Op = (attn_body::bf16*)(PATT + rq * PATT_LD + C_GQQ + hq * 64); PO = PATT_LD;
                if (pass == 0) { Op = (attn_body::bf16*)((bf16*)(ws + WS_OC) + rq * 512 + hq * 64); PO = 512; } }
            attn_body::attn_unit<8>(Qp, Kp, Vp, Op, PATT_LD, PATT_LD, PATT_LD, PO, NT, (char*)lds_raw);
          } }
        GRID_BAR();
        { ARGS_HERE(A); PHASE_IDS();
          const float lam_init = 0.8f - 0.6f * expf(-0.3f * (float)l);
          const float* lp = A->in[10] + l * 256;
          const float s01 = wave_sum(lp[plane] * lp[64 + plane]), s23 = wave_sum(lp[128 + plane] * lp[192 + plane]);
          const float lam = expf(s01) - expf(s23) + lam_init;
          for (int row = pgw; row < MROWS; row += NGW) post2_row(A, l, row, plane, lam, 1.f - lam_init);
          if (DUP_MASK & 16) for (int row = pgw; row < MROWS; row += NGW) post2_row(A, l, row, plane, lam, 1.f - lam_init); }
        { ARGS_HERE(A); PHASE_IDS(); unsigned char* ws = A->ws;
          pg8::Gemm g{(bf16*)(ws + WS_HN), (bf16*)(ws + WS_WT) + WT_IN + (size_t)4608 * 1024, MROWS, 3072, 1024, 1024}; pg8::StaticOrder S; S.init(l == NLAYER - 1 ? 16384 : MROWS, 3072, G, bid, l == NLAYER - 1);
          EpiGate E{(bf16*)(ws + WS_A), 3072, nullptr, nullptr, 0, 0, nullptr, nullptr, nullptr};
          pg8::gemm_phase<EpiGate, pg8::StaticOrder, true, true>(lds, g, S, E);
          if (DUP_MASK & 32) pg8::gemm_phase<EpiGate, pg8::StaticOrder, true, true>(lds, g, S, E); }
        GRID_BAR();
        { ARGS_HERE(A); PHASE_IDS(); unsigned char* ws = A->ws;
          pg8::ChainOrder S; S.so.init(l == NLAYER - 1 ? 16384 : MROWS, 1024, G, bid, l == NLAYER - 1);
          pg8::Gemm g{(bf16*)(ws + WS_A + A_MRGF), (bf16*)(ws + WS_WT) + WT_BRA, 3 * MROWS, 3072, 512, 512, 0};
          pg8::Epi<3, 4> E{(bf16*)A->out, 1024, nullptr, (bf16*)(ws + WS_A), 3072, 0, nullptr, nullptr, nullptr};
          pg8::gemm_phase<pg8::Epi<3, 4>, pg8::ChainOrder, true, true>(lds, g, S, E); }
        GRID_BAR();
        { const int nrnd = (l < NLAYER - 1) ? 2 : 1;
          for (int rnd = 0; rnd < nrnd; ++rnd) {
            { ARGS_HERE(A); PHASE_IDS(); unsigned char* ws = A->ws;
              const float* mp = (const float*)(ws + WS_MOD) + (size_t)l * 5 * 6144 + 2 * 1024;
              pg8::Gemm g{(bf16*)A->out, (bf16*)(ws + WS_WT) + WT_O, MROWS, 1024, 1024, 1024, 0}; pg8::StaticOrder S; S.init(rnd == 0 ? 16384 : 1024, 1024, G, bid, rnd == 0 ? 1 : 2);
              pg8::Epi<4, 0> E{nullptr, 0, nullptr, nullptr, 0, 0, (float*)(ws + WS_XS), mp, nullptr};
              pg8::gemm_phase<pg8::Epi<4, 0>, pg8::StaticOrder, true, true>(lds, g, S, E);
              if (rnd == 1 && bid >= 16) phase_norm(A, l, 1, (bid - 16) * NWAVES + pwave, (G - 16) * NWAVES, plane, 1); }
            GRID_BAR(); }
          { ARGS_HERE(A); PHASE_IDS(); phase_norm(A, l, 1, pgw, NGW, plane, (l < NLAYER - 1) ? 2 : 1); }
          GRID_BAR(); }
        { ARGS_HERE(A); PHASE_IDS(); unsigned char* ws = A->ws;
          pg8::Gemm g{(bf16*)(ws + WS_HN), (bf16*)(ws + WS_WT) + WT_1, MROWS, 5632, 1024, 1024}; pg8::StaticOrder S; S.init(l == NLAYER - 1 ? 16384 : MROWS, 5632, G, bid, l == NLAYER - 1);
          pg8::Epi<5, 0> E{(bf16*)(ws + WS_A), DFF, (bf16*)(ws + WS_EA), (const bf16*)(ws + WS_EU), 0, 0, (float*)(ws + WS_EP), A->in[24] + (size_t)l * 3 * DFF, (float*)(A->in[25] + (size_t)l * DFF)};
          pg8::gemm_phase<pg8::Epi<5, 0>, pg8::StaticOrder, true, true>(lds, g, S, E); }
        GRID_BAR();
        { ARGS_HERE(A); PHASE_IDS(); phase_act_fix(A, l, bid * NTHR + ptid, G * NTHR); }
        GRID_BAR();
        if (l < NLAYER - 1) {
          for (int rnd = 0; rnd < 2; ++rnd) {
            { ARGS_HERE(A); PHASE_IDS(); unsigned char* ws = A->ws;
              const float* mp = (const float*)(ws + WS_MOD) + (size_t)l * 5 * 6144 + 5 * 1024;
              pg8::Gemm g{(bf16*)(ws + WS_A), (bf16*)(ws + WS_WT) + WT_2, MROWS, 1024, 2816, DFF, 0}; pg8::StaticOrder S; S.init(rnd == 0 ? 16384 : 1024, 1024, G, bid, rnd == 0 ? 1 : 2);
              pg8::Epi<4, 0> E{nullptr, 0, nullptr, nullptr, 0, 0, (float*)(ws + WS_XS), mp, nullptr};
              pg8::gemm_phase<pg8::Epi<4, 0>, pg8::StaticOrder, true, true>(lds, g, S, E);
              if (rnd == 1 && bid >= 16) { const int gw2 = (bid - 16) * NWAVES + pwave, ngw2 = (G - 16) * NWAVES;
                  phase_convert(A, l + 1, lds, gw2, ngw2, pwave, plane, 0, 7936); phase_norm(A, l + 1, 0, gw2, ngw2, plane, 1); } }
            GRID_BAR(); }
        } else {
          ARGS_HERE(A); PHASE_IDS(); unsigned char* ws = A->ws;
          const float* mp = (const float*)(ws + WS_MOD) + (size_t)l * 5 * 6144 + 5 * 1024;
          pg8::Gemm g{(bf16*)(ws + WS_A), (bf16*)(ws + WS_WT) + WT_2, MROWS, 1024, 2816, DFF, 0}; pg8::StaticOrder S; S.init(16384, 1024, G, bid, 1);
          pg8::Epi<4, 1> E{nullptr, 0, nullptr, nullptr, 0, 0, (float*)(ws + WS_XS), mp, A->out};
          pg8::gemm_phase<pg8::Epi<4, 1>, pg8::StaticOrder, true, true>(lds, g, S, E);
          if (PROF_A | PROF_B) GRID_BAR();
        }
    }
    if (PREP_PROF && blockIdx.x == 0) { const unsigned long long extra = (unsigned long long)MISC[16 + PREP_SUBA] + ((unsigned long long)MISC[16 + PREP_SUBB] / 1000ull) * 100000ull, t0_ = rt(); while (rt() - t0_ < extra) __builtin_amdgcn_s_sleep(8); }
    if ((PROF_A | PROF_B) && blockIdx.x == 0) { const unsigned long long extra = prof_a + (prof_b / 1000ull) * 100000ull, t0_ = rt(); while (rt() - t0_ < extra) __builtin_amdgcn_s_sleep(8); }
}

extern "C" void kernel_launch(void* const* d_in, const int* in_sizes, int n_in, void* d_out, int out_size, void* d_ws, size_t ws_size, hipStream_t stream) {
    static int grid = 0;
    if (grid == 0) {
        if (n_in != 27 || out_size != 4 * 4096 * 1024 || ws_size < WS_END2) { fprintf(stderr, "kernel_launch: unexpected shapes (n_in %d out %d ws %zu need %zu)\n", n_in, out_size, ws_size, (size_t)WS_END2); grid = -1; return; }
        int dev = 0, cus = 0, per_cu = 0;
        hipGetDevice(&dev); hipDeviceGetAttribute(&cus, hipDeviceAttributeMultiprocessorCount, dev);
        if (hipFuncSetAttribute((const void*)mk_fwd, hipFuncAttributeMaxDynamicSharedMemorySize, LDS_BYTES) != hipSuccess) { fprintf(stderr, "kernel_launch: hipFuncSetAttribute failed\n"); grid = -1; return; }
        if (hipOccupancyMaxActiveBlocksPerMultiprocessor(&per_cu, (const void*)mk_fwd, NTHR, LDS_BYTES) != hipSuccess || per_cu < 1) { fprintf(stderr, "kernel_launch: occupancy query says %d\n", per_cu); per_cu = 1; }
        (void)hipGetLastError();
        grid = cus;
    }
    if (grid < 0) return;
    hipMemsetAsync((char*)d_ws + WS_CTL, 0, CTL_ZERO_BYTES, stream);
    Args a{};
    for (int i = 0; i < 27; ++i) a.in[i] = (const float*)d_in[i];
    a.out = (float*)d_out; a.ws = (unsigned char*)d_ws;
    void* kargs[] = {&a};
    hipError_t e = hipLaunchCooperativeKernel((const void*)mk_fwd, dim3(grid), dim3(NTHR), kargs, LDS_BYTES, stream);
    if (e != hipSuccess) fprintf(stderr, "kernel_launch: cooperative launch failed: %s (grid %d)\n", hipGetErrorString(e), grid);
}
```
